# Optimizing an MI355X kernel written in HIP

```python
import math
import jax, jax.numpy as jnp
from jax import lax
import numpy as np

D_MODEL = 2048
BATCH = 2
SEQ = 4096
DEPTH = 2

EPS = 1e-6
GLA_HEADS = 4
GLA_DK = D_MODEL // 16
GLA_DV = D_MODEL // 8
GLA_LOWRANK = 16
GLA_TAU = 16.0
GLA_CHUNK = 64
FOX_HEADS = 8
FOX_DH = D_MODEL // 16
FOX_W = FOX_HEADS * FOX_DH
FOX_BLOCK = 128
S5_WIDTH = D_MODEL
S5_GROUP_CH = 16
S5_GROUPS = S5_WIDTH // S5_GROUP_CH
S5_STATE = 64
N_EVEN = (DEPTH + 1) // 2
N_ODD = DEPTH // 2
AB_SIZES = (GLA_HEADS * GLA_DK, GLA_HEADS * GLA_DK, GLA_HEADS * GLA_DV, GLA_LOWRANK, GLA_HEADS * GLA_DV,
            FOX_W, FOX_W, FOX_W, FOX_HEADS, FOX_W)
AB_IN = sum(AB_SIZES)
MIX_W = GLA_HEADS * GLA_DV + FOX_W

kernel_name = "hybrid_gla_fox_s5_trunk"


def rms_norm(x, g):
    xf = x.astype(jnp.float32)
    y = xf * lax.rsqrt(jnp.mean(xf * xf, axis=-1, keepdims=True) + EPS)
    return (y * g.astype(jnp.float32)).astype(x.dtype)


def gla_chunked(q, k, v, log_a):
    Bsz, H, L, dk = q.shape
    dv = v.shape[-1]
    n = L // GLA_CHUNK

    def to_chunks(t):
        t = t.astype(jnp.float32).reshape(Bsz, H, n, GLA_CHUNK, t.shape[-1])
        return jnp.moveaxis(t, 2, 0)

    qc, kc, vc, gc = (to_chunks(q * (dk ** -0.5)), to_chunks(k), to_chunks(v), to_chunks(log_a))
    mask = jnp.tril(jnp.ones((GLA_CHUNK, GLA_CHUNK), dtype=bool))[:, :, None]

    def step(S, inp):
        qi, ki, vi, gi = inp
        b = jnp.cumsum(gi, axis=-2)
        o_inter = jnp.einsum('bhck,bhkv->bhcv', qi * jnp.exp(b), S)
        rel = b[..., :, None, :] - b[..., None, :, :]
        decay = jnp.exp(jnp.where(mask, rel, -jnp.inf))
        attn = jnp.einsum('bhik,bhjk,bhijk->bhij', qi, ki, decay)
        o_intra = jnp.einsum('bhij,bhjv->bhiv', attn, vi)
        b_last = b[..., -1:, :]
        S = jnp.exp(b_last[..., 0, :])[..., None] * S + jnp.einsum(
            'bhck,bhcv->bhkv', ki * jnp.exp(b_last - b), vi)
        return S, o_inter + o_intra

    S0 = jnp.zeros((Bsz, H, dk, dv), jnp.float32)
    _, out = lax.scan(step, S0, (qc, kc, vc, gc))
    return jnp.moveaxis(out, 0, 2).reshape(Bsz, H, L, dv)


def forgetting_attention(q, k, v, log_f):
    L, d = q.shape[2], q.shape[3]
    scale = d ** -0.5
    c = jnp.cumsum(log_f, axis=-1)
    outs = []
    for blk in range(L // FOX_BLOCK):
        s0, s1 = blk * FOX_BLOCK, (blk + 1) * FOX_BLOCK
        qb, kb, vb = q[:, :, s0:s1], k[:, :, :s1], v[:, :, :s1]
        logits = (jnp.einsum('bhqd,bhkd->bhqk', qb, kb).astype(jnp.float32) * scale
                  + c[:, :, s0:s1, None] - c[:, :, None, :s1])
        causal = jnp.arange(s0, s1)[:, None] >= jnp.arange(s1)[None, :]
        p = jax.nn.softmax(jnp.where(causal, logits, -jnp.inf), axis=-1)
        outs.append(jnp.einsum('bhqk,bhkd->bhqd', p.astype(v.dtype), vb))
    return jnp.concatenate(outs, axis=2)


def _complex_combine(e1, e2):
    a1r, a1i, b1r, b1i = e1
    a2r, a2i, b2r, b2i = e2
    ar = a2r * a1r - a2i * a1i
    ai = a2r * a1i + a2i * a1r
    br = a2r * b1r - a2i * b1i + b2r
    bi = a2r * b1i + a2i * b1r + b2i
    return ar, ai, br, bi


def s5_ssm(u, lam_re, lam_im, log_step, b_re, b_im, c_re, c_im, d):
    Bsz, L, E = u.shape
    f32 = jnp.float32
    uf = u.astype(f32).reshape(Bsz, L, S5_GROUPS, S5_GROUP_CH)
    lr = jnp.minimum(lam_re.astype(f32), -1e-4)
    li = lam_im.astype(f32)
    step = jnp.exp(log_step.astype(f32))[:, None]
    mag = jnp.exp(lr * step)
    lb_re, lb_im = mag * jnp.cos(li * step), mag * jnp.sin(li * step)
    den = lr * lr + li * li
    nr, ni = lb_re - 1.0, lb_im
    coef_re = (nr * lr + ni * li) / den
    coef_im = (ni * lr - nr * li) / den
    br_, bi_ = b_re.astype(f32), b_im.astype(f32)
    bb_re = coef_re[..., None] * br_ - coef_im[..., None] * bi_
    bb_im = coef_re[..., None] * bi_ + coef_im[..., None] * br_
    bu_re = jnp.einsum('gpc,blgc->blgp', bb_re, uf)
    bu_im = jnp.einsum('gpc,blgc->blgp', bb_im, uf)
    a_re = jnp.broadcast_to(lb_re, (1, L, S5_GROUPS, S5_STATE))
    a_im = jnp.broadcast_to(lb_im, (1, L, S5_GROUPS, S5_STATE))
    _, _, x_re, x_im = lax.associative_scan(_complex_combine, (a_re, a_im, bu_re, bu_im), axis=1)
    y = (jnp.einsum('gcp,blgp->blgc', c_re.astype(f32), x_re)
         - jnp.einsum('gcp,blgp->blgc', c_im.astype(f32), x_im))
    return y.reshape(Bsz, L, E) + d.astype(f32) * uf.reshape(Bsz, L, E)


def layer_ab(x, norm_g, w_in, alpha_up, alpha_b, head_g, f_b, w_out):
    Bsz, L, _ = x.shape
    h = rms_norm(x, norm_g)
    split_idx = np.cumsum(AB_SIZES)[:-1].tolist()
    g_q, g_k, g_v, g_lr, g_gate, f_q, f_k, f_v, f_f, f_gate = jnp.split(h @ w_in, split_idx, axis=-1)

    def heads(t, nh):
        return t.reshape(Bsz, L, nh, -1).transpose(0, 2, 1, 3)

    log_a = jax.nn.log_sigmoid((g_lr @ alpha_up + alpha_b).astype(jnp.float32)) / GLA_TAU
    o = gla_chunked(heads(g_q, GLA_HEADS), heads(g_k, GLA_HEADS), heads(g_v, GLA_HEADS),
                    heads(log_a, GLA_HEADS))
    o = o * lax.rsqrt(jnp.mean(o * o, axis=-1, keepdims=True) + EPS)
    o = o * head_g.astype(jnp.float32).reshape(GLA_HEADS, 1, GLA_DV)
    o_gla = o.transpose(0, 2, 1, 3).reshape(Bsz, L, -1).astype(x.dtype) * jax.nn.silu(g_gate)

    log_f = jax.nn.log_sigmoid((f_f + f_b).astype(jnp.float32)).transpose(0, 2, 1)
    o_fox = forgetting_attention(heads(f_q, FOX_HEADS), heads(f_k, FOX_HEADS), heads(f_v, FOX_HEADS), log_f)
    o_fox = o_fox.transpose(0, 2, 1, 3).reshape(Bsz, L, -1) * jax.nn.silu(f_gate)

    return x + jnp.concatenate([o_gla, o_fox], axis=-1) @ w_out


def layer_c(x, norm_g, w_in, lam_re, lam_im, log_step, b_re, b_im, c_re, c_im, d, glu_w, glu_b, w_out):
    h = rms_norm(x, norm_g)
    u, gate = jnp.split(h @ w_in, 2, axis=-1)
    y = s5_ssm(u, lam_re, lam_im, log_step, b_re, b_im, c_re, c_im, d).astype(x.dtype)
    z = jax.nn.gelu(y)
    z = z * jax.nn.sigmoid(z @ glu_w + glu_b)
    return x + (z * jax.nn.silu(gate)) @ w_out


def setup_inputs(seed: int = 0) -> dict:
    key = jax.random.key(seed)
    ks = jax.random.split(key, 24)
    nrm = jax.random.normal
    f32 = jnp.float32
    D, E, G, P, Cg = D_MODEL, S5_WIDTH, S5_GROUPS, S5_STATE, S5_GROUP_CH
    x = nrm(ks[0], (BATCH, SEQ, D), f32)
    ab_norm_g = 1.0 + 0.01 * nrm(ks[1], (N_EVEN, D), f32)
    ab_w_in = nrm(ks[2], (N_EVEN, D, AB_IN), f32) * D ** -0.5
    gla_alpha_up = nrm(ks[3], (N_EVEN, GLA_LOWRANK, GLA_HEADS * GLA_DK), f32) * GLA_LOWRANK ** -0.5
    gla_alpha_b = 0.01 * nrm(ks[4], (N_EVEN, GLA_HEADS * GLA_DK), f32)
    gla_head_g = 1.0 + 0.01 * nrm(ks[5], (N_EVEN, GLA_HEADS * GLA_DV), f32)
    fox_f_b = 1.0 + 0.1 * nrm(ks[6], (N_EVEN, FOX_HEADS), f32)
    ab_w_out = nrm(ks[7], (N_EVEN, MIX_W, D), f32) * MIX_W ** -0.5
    c_norm_g = 1.0 + 0.01 * nrm(ks[8], (N_ODD, D), f32)
    c_w_in = nrm(ks[9], (N_ODD, D, 2 * E), f32) * D ** -0.5
    n_idx = jnp.arange(P, dtype=f32)
    s5_lambda_re = -0.5 + 0.01 * nrm(ks[10], (N_ODD, G, P), f32)
    s5_lambda_im = math.pi * n_idx + 0.01 * nrm(ks[11], (N_ODD, G, P), f32)
    s5_log_step = jax.random.uniform(ks[12], (N_ODD, G), f32, math.log(1e-3), math.log(1e-1))
    s5_b_re = nrm(ks[13], (N_ODD, G, P, Cg), f32) * (2.0 * Cg) ** -0.5
    s5_b_im = nrm(ks[14], (N_ODD, G, P, Cg), f32) * (2.0 * Cg) ** -0.5
    s5_c_re = nrm(ks[15], (N_ODD, G, Cg, P), f32) * (2.0 * P) ** -0.5
    s5_c_im = nrm(ks[16], (N_ODD, G, Cg, P), f32) * (2.0 * P) ** -0.5
    s5_d = nrm(ks[17], (N_ODD, E), f32)
    glu_w = nrm(ks[18], (N_ODD, E, E), f32) * E ** -0.5
    glu_b = 0.01 * nrm(ks[19], (N_ODD, E), f32)
    c_w_out = nrm(ks[20], (N_ODD, E, D), f32) * E ** -0.5
    final_norm_g = 1.0 + 0.01 * nrm(ks[21], (D,), f32)
    return {"x": x, "ab_norm_g": ab_norm_g, "ab_w_in": ab_w_in, "gla_alpha_up": gla_alpha_up,
            "gla_alpha_b": gla_alpha_b, "gla_head_g": gla_head_g, "fox_f_b": fox_f_b,
            "ab_w_out": ab_w_out, "c_norm_g": c_norm_g, "c_w_in": c_w_in,
            "s5_lambda_re": s5_lambda_re, "s5_lambda_im": s5_lambda_im, "s5_log_step": s5_log_step,
            "s5_b_re": s5_b_re, "s5_b_im": s5_b_im, "s5_c_re": s5_c_re, "s5_c_im": s5_c_im,
            "s5_d": s5_d, "glu_w": glu_w, "glu_b": glu_b, "c_w_out": c_w_out,
            "final_norm_g": final_norm_g}


def reference(x, ab_norm_g, ab_w_in, gla_alpha_up, gla_alpha_b, gla_head_g, fox_f_b, ab_w_out,
              c_norm_g, c_w_in, s5_lambda_re, s5_lambda_im, s5_log_step, s5_b_re, s5_b_im,
              s5_c_re, s5_c_im, s5_d, glu_w, glu_b, c_w_out, final_norm_g):
    for layer in range(DEPTH):
        i = layer // 2
        if layer % 2 == 0:
            x = layer_ab(x, ab_norm_g[i], ab_w_in[i], gla_alpha_up[i], gla_alpha_b[i],
                         gla_head_g[i], fox_f_b[i], ab_w_out[i])
        else:
            x = layer_c(x, c_norm_g[i], c_w_in[i], s5_lambda_re[i], s5_lambda_im[i], s5_log_step[i],
                        s5_b_re[i], s5_b_im[i], s5_c_re[i], s5_c_im[i], s5_d[i], glu_w[i], glu_b[i],
                        c_w_out[i])
    return rms_norm(x, final_norm_g)
```

```cpp
#include <hip/hip_runtime.h>
#include <hip/hip_cooperative_groups.h>
#include <cstdio>
#include <cstdint>
namespace cg = cooperative_groups;
namespace pg8 {
#define PG8_LAS __attribute__((address_space(3)))
typedef unsigned short bf16_t;
typedef short bf16x8 __attribute__((ext_vector_type(8)));
typedef float f32x4 __attribute__((ext_vector_type(4)));
typedef unsigned u32x4 __attribute__((ext_vector_type(4)));
constexpr int BM = 256, BK = 64, HALF = 128, HTB = HALF * BK * 2  , STAGE_BYTES = 8 * HTB, NXCD = 8, WGM = 8;

__host__ __device__ __forceinline__ int lds_byte(int r, int c) { const int st = (r >> 4) * 2 + (c >> 5), rr = r & 15, cc = c & 31, ob = rr * 64 + cc * 2; return st * 1024 + (ob ^ (((ob >> 9) & 1) << 5)); }
__host__ __device__ __forceinline__ void stage_rc(int b, int& R, int& C) { const int st = b / 1024, sb = b % 1024, swz = sb ^ (((sb >> 9) & 1) << 5); R = (st >> 1) * 16 + swz / 64; C = (st & 1) * 32 + (swz % 64) / 2; }
__host__ __device__ __forceinline__ int perm32(int rho) { const int n = rho >> 4, i = rho & 15; return 8 * (i >> 2) + 4 * n + (i & 3); }

struct Unit { int pm, pn; };
struct Gemm { const bf16_t* A; const bf16_t* Bt; int M, N, K; };

struct StaticOrder {
    int nM, nN, nwg, G, c;
    __host__ __device__ void init(int M, int N, int G_, int c_) { nM = M / BM; nN = N / BM; nwg = nM * nN; G = G_; c = c_; }
    __host__ __device__ bool next(int i, Unit& u) const {
        const long L = (long)i * G + c; if (L >= nwg) return false;
        int wgid = (int)L; { const int q = nwg / NXCD, r = nwg % NXCD, xcd = wgid % NXCD, off = wgid / NXCD; wgid = (xcd < r ? xcd * (q + 1) : r * (q + 1) + (xcd - r) * q) + off; }
        const int nig = WGM * nN, gid = wgid / nig, fm = gid * WGM, gsz = (nM - fm) < WGM ? (nM - fm) : WGM;
        u.pm = fm + ((wgid % nig) % gsz); u.pn = (wgid % nig) / gsz; return true;
    }
    __device__ __forceinline__ void a_ready(const Unit&) const {}
    __device__ __forceinline__ void done(const Unit&) const {}
};

__device__ __forceinline__ unsigned cvt_pk_bf16(float lo, float hi) { unsigned r; asm volatile("v_cvt_pk_bf16_f32 %0, %1, %2" : "=v"(r) : "v"(lo), "v"(hi)); return r; }
typedef float f32x2 __attribute__((ext_vector_type(2)));
__device__ __forceinline__ float sigmoid_f(float x) { return __builtin_amdgcn_rcpf(1.0f + __expf(-x)); }
__device__ __forceinline__ float silu_f(float x) { return x * __builtin_amdgcn_rcpf(1.0f + __expf(-x)); }
__device__ __forceinline__ float bf2f(unsigned short b) { return __uint_as_float(((unsigned)b) << 16); }
struct EpiScaleBf16 {
    static constexpr bool PERM = true, AFTER_DRAIN = false;
    bf16_t* O; int ldc; const float* rstd; const float* part; int small_pn; float* smallbuf; float* nmax; int q_pn0;
    __device__ __forceinline__ void operator()(const f32x4 (&acc)[2][2][4][2], const Unit& u, int wr, int wc, int fr, int fq) const {
        const int row0 = u.pm * BM + wr * 64 + fr, col0 = u.pn * BM + wc * 32 + 8 * fq;
        const bool nrm = nmax != nullptr && u.pn >= q_pn0 && u.pn < q_pn0 + 8; float rmx[2] = {0.f, 0.f};
#pragma unroll
        for (int ai = 0; ai < 2; ++ai)
#pragma unroll
            for (int m = 0; m < 4; ++m) {
                const int row = row0 + ai * HALF + m * 16; float s;
                if (rstd) s = rstd[row];
                else { const f32x4 a = *(const f32x4*)(part + (size_t)row * 32 + 8 * fq), b = *(const f32x4*)(part + (size_t)row * 32 + 8 * fq + 4);
                    float t = ((a[0] + a[1]) + (a[2] + a[3])) + ((b[0] + b[1]) + (b[2] + b[3])); t += __shfl_xor(t, 16); t += __shfl_xor(t, 32); s = rsqrtf(t * (1.0f / 2048.0f) + 1e-6f); }
                bf16_t* rowp = O + (size_t)row * ldc + col0;
#pragma unroll
                for (int bj = 0; bj < 2; ++bj) { const f32x4 v0 = acc[ai][bj][m][0] * s, v1 = acc[ai][bj][m][1] * s;
                    u32x4 w; w.x = cvt_pk_bf16(v0[0], v0[1]); w.y = cvt_pk_bf16(v0[2], v0[3]); w.z = cvt_pk_bf16(v1[0], v1[1]); w.w = cvt_pk_bf16(v1[2], v1[3]);
                    *(u32x4*)(rowp + bj * HALF) = w;
                    if (nrm) { float ss = ((v0[0] * v0[0] + v0[1] * v0[1]) + (v0[2] * v0[2] + v0[3] * v0[3])) + ((v1[0] * v1[0] + v1[1] * v1[1]) + (v1[2] * v1[2] + v1[3] * v1[3])); ss += __shfl_xor(ss, 16); ss += __shfl_xor(ss, 32); rmx[bj] = fmaxf(rmx[bj], ss); }
                    if (u.pn == small_pn && bj == 0 && wc == 0) { *(f32x4*)(smallbuf + (size_t)row * 32 + 8 * fq) = v0; *(f32x4*)(smallbuf + (size_t)row * 32 + 8 * fq + 4) = v1; } }
            }
        if (nrm) { const int t = u.pn - q_pn0;
#pragma unroll
            for (int bj = 0; bj < 2; ++bj) { float r = rmx[bj]; r = fmaxf(r, __shfl_xor(r, 1)); r = fmaxf(r, __shfl_xor(r, 2)); r = fmaxf(r, __shfl_xor(r, 4)); r = fmaxf(r, __shfl_xor(r, 8));
                if (fr == 0 && fq == 0) __hip_atomic_fetch_max((unsigned*)nmax + ((((u.pm >> 4) * 8 + 2 * (t & 3) + bj) * 2 + (t >> 2)) * 4 + wc), __float_as_uint(r), __ATOMIC_RELAXED, __HIP_MEMORY_SCOPE_AGENT); } }
    }
};
struct EpiResid {
    static constexpr bool PERM = false, AFTER_DRAIN = false;
    const float* base; float* out; bf16_t* outb; float* part; int ldc;
    __device__ __forceinline__ void operator()(const f32x4 (&acc)[2][2][4][2], const Unit& u, int wr, int wc, int fr, int fq) const {
        typedef unsigned u32x2v __attribute__((ext_vector_type(2)));
        const int row0 = u.pm * BM + wr * 64 + fr, col0 = u.pn * BM + wc * 32 + 4 * fq;
#pragma unroll
        for (int ai = 0; ai < 2; ++ai)
#pragma unroll
            for (int m = 0; m < 4; ++m) {
                const int row = row0 + ai * HALF + m * 16; const size_t off = (size_t)row * ldc + col0; float ss = 0.f;
#pragma unroll
                for (int bj = 0; bj < 2; ++bj)
#pragma unroll
                    for (int n = 0; n < 2; ++n) { const size_t o = off + bj * HALF + n * 16; const f32x4 v = acc[ai][bj][m][n] + __builtin_nontemporal_load((const f32x4*)(base + o));
                        if (out) *(f32x4*)(out + o) = v; ss += (v[0] * v[0] + v[1] * v[1]) + (v[2] * v[2] + v[3] * v[3]);
                        if (outb) { u32x2v w; w.x = cvt_pk_bf16(v[0], v[1]); w.y = cvt_pk_bf16(v[2], v[3]); *(u32x2v*)(outb + o) = w; } }
                ss += __shfl_xor(ss, 16); ss += __shfl_xor(ss, 32);
                if (fq == 0) part[(size_t)row * 32 + u.pn * 4 + wc] = ss;
            }
    }
};
struct EpiGlu {
    static constexpr bool PERM = true, AFTER_DRAIN = false;
    const bf16_t* zb; const bf16_t* ug; const float* bias; bf16_t* tb;
    __device__ __forceinline__ void operator()(const f32x4 (&acc)[2][2][4][2], const Unit& u, int wr, int wc, int fr, int fq) const {
        const int row0 = u.pm * BM + wr * 64 + fr, col0 = u.pn * BM + wc * 32 + 8 * fq;
#pragma unroll
        for (int ai = 0; ai < 2; ++ai)
#pragma unroll
            for (int m = 0; m < 4; ++m) {
                const int row = row0 + ai * HALF + m * 16;
#pragma unroll
                for (int bj = 0; bj < 2; ++bj) { const int col = col0 + bj * HALF;
                    const f32x4 b0 = *(const f32x4*)(bias + col), b1 = *(const f32x4*)(bias + col + 4);
                    const u32x4 zz = __builtin_nontemporal_load((const u32x4*)(zb + (size_t)row * 2048 + col)), gg = __builtin_nontemporal_load((const u32x4*)(ug + (size_t)row * 4096 + 2048 + col));
                    float r[8];
#pragma unroll
                    for (int e = 0; e < 8; ++e) { const float a = (e < 4 ? acc[ai][bj][m][0][e] : acc[ai][bj][m][1][e - 4]) + (e < 4 ? b0[e] : b1[e - 4]);
                        const unsigned zw = zz[e >> 1], gw = gg[e >> 1];
                        const float z = (e & 1) ? __uint_as_float(zw & 0xffff0000u) : __uint_as_float(zw << 16), g = (e & 1) ? __uint_as_float(gw & 0xffff0000u) : __uint_as_float(gw << 16);
                        r[e] = z * sigmoid_f(a) * silu_f(g); }
                    u32x4 w; w.x = cvt_pk_bf16(r[0], r[1]); w.y = cvt_pk_bf16(r[2], r[3]); w.z = cvt_pk_bf16(r[4], r[5]); w.w = cvt_pk_bf16(r[6], r[7]);
                    *(u32x4*)(tb + (size_t)row * 2048 + col) = w; }
            }
    }
};

struct EpiFinalNorm {
    static constexpr bool PERM = false, AFTER_DRAIN = true;
    const bf16_t* base; float* out; float* part; unsigned* cnt; const float* g; int ldc;
    __device__ __forceinline__ void fused(f32x4 (&acc)[2][2][4][2], const Unit& u, int wr, int wc, int fr, int fq, PG8_LAS unsigned char* lds, int wid, int lane) const {
        const int row0 = u.pm * BM + wr * 64 + fr, col0 = u.pn * BM + wc * 32 + 4 * fq;
#pragma unroll
        for (int ai = 0; ai < 2; ++ai)
#pragma unroll
            for (int m = 0; m < 4; ++m) { const int row = row0 + ai * HALF + m * 16; const size_t off = (size_t)row * ldc + col0; float ss = 0.f;
#pragma unroll
                for (int bj = 0; bj < 2; ++bj)
#pragma unroll
                    for (int n = 0; n < 2; ++n) { typedef unsigned u32x2v __attribute__((ext_vector_type(2))); const u32x2v bw = __builtin_nontemporal_load((const u32x2v*)(base + off + bj * HALF + n * 16));
                        const f32x4 bv = {__uint_as_float(bw.x << 16), __uint_as_float(bw.x & 0xffff0000u), __uint_as_float(bw.y << 16), __uint_as_float(bw.y & 0xffff0000u)}; const f32x4 v = acc[ai][bj][m][n] + bv; acc[ai][bj][m][n] = v; ss += (v[0] * v[0] + v[1] * v[1]) + (v[2] * v[2] + v[3] * v[3]); }
                ss += __shfl_xor(ss, 16); ss += __shfl_xor(ss, 32);
                if (fq == 0) __hip_atomic_store((unsigned*)part + (size_t)row * 32 + u.pn * 4 + wc, __float_as_uint(ss), __ATOMIC_RELAXED, __HIP_MEMORY_SCOPE_AGENT); }
        asm volatile("s_waitcnt vmcnt(0)" ::: "memory");
        unsigned* c = cnt + 16 * u.pm;
        if (lane == 0) __hip_atomic_fetch_add(c, 1u, __ATOMIC_RELAXED, __HIP_MEMORY_SCOPE_AGENT);
        { unsigned sp = 0; while ((unsigned)__builtin_amdgcn_readfirstlane(__hip_atomic_load(c, __ATOMIC_RELAXED, __HIP_MEMORY_SCOPE_AGENT)) < 64u) { __builtin_amdgcn_s_sleep(2); if (++sp > (1u << 20)) break; } }
        asm volatile("" ::: "memory");
        f32x4 gv[2][2];
#pragma unroll
        for (int bj = 0; bj < 2; ++bj)
#pragma unroll
            for (int n = 0; n < 2; ++n) gv[bj][n] = *(const f32x4*)(g + col0 + bj * HALF + n * 16);
#pragma unroll
        for (int ai = 0; ai < 2; ++ai)
#pragma unroll
            for (int m = 0; m < 4; ++m) { const int row = row0 + ai * HALF + m * 16; const size_t off = (size_t)row * ldc + col0;
                const unsigned long long* pp = (const unsigned long long*)part + (size_t)row * 16 + 4 * fq; float t = 0.f;
#pragma unroll
                for (int q = 0; q < 4; ++q) { const unsigned long long w2 = __hip_atomic_load(pp + q, __ATOMIC_RELAXED, __HIP_MEMORY_SCOPE_AGENT); t += __uint_as_float((unsigned)w2) + __uint_as_float((unsigned)(w2 >> 32)); }
                t += __shfl_xor(t, 16); t += __shfl_xor(t, 32);
                const float s = rsqrtf(t * (1.0f / 2048.0f) + 1e-6f);
#pragma unroll
                for (int bj = 0; bj < 2; ++bj)
#pragma unroll
                    for (int n = 0; n < 2; ++n) __builtin_nontemporal_store(acc[ai][bj][m][n] * s * gv[bj][n], (f32x4*)(out + off + bj * HALF + n * 16)); }
    }
};
template <class Epi, class Sched, bool ALIGN_EPI = false, bool SP2 = false>
__device__ __forceinline__ void gemm_phase(PG8_LAS unsigned char* lds, const Gemm g, const Sched& S, const Epi& E) {
    const int tid = threadIdx.x, wid = __builtin_amdgcn_readfirstlane(tid >> 6), lane = tid & 63, wr = wid >> 2, wc = wid & 3, fr = lane & 15, fq = lane >> 4;
    const int K = g.K, nt = K / BK;
    unsigned voffA[2], voffB[2];
#pragma unroll
    for (int i = 0; i < 2; ++i) { int R, C; stage_rc(tid * 16 + i * 8192, R, C); const int Rb = Epi::PERM ? ((R & ~31) + perm32(R & 31)) : R;
        voffA[i] = (unsigned)(R * K + C) * 2u; voffB[i] = (unsigned)(Rb * K + C) * 2u; }
    const size_t kstep = (size_t)(BK * 2);
    const size_t hstep = (size_t)HALF * K * 2;
    const size_t tstep = 2 * hstep;
    const unsigned ldsw = (unsigned)wid * 1024u;
    const int aoff = lds_byte(wr * 64 + fr, fq * 8), boff = lds_byte(wc * 32 + fr, fq * 8);
#define PG8_SA(b, h) (((b) * 2 + (h)) * HTB)
#define PG8_SB(b, h) ((4 + (b) * 2 + (h)) * HTB)
#define PG8_STAGE(bufoff, gbase, voff) do { _Pragma("unroll") for (int _i = 0; _i < 2; ++_i) \
        __builtin_amdgcn_global_load_lds((const unsigned*)((const char*)(gbase) + (voff)[_i]), (PG8_LAS unsigned*)(lds + (bufoff) + ldsw + _i * 8192), 16, 0, 0); } while (0)
#define PG8_LDA(dst, b, h) do { _Pragma("unroll") for (int m = 0; m < 4; ++m) _Pragma("unroll") for (int k = 0; k < 2; ++k) dst[m][k] = *(const PG8_LAS bf16x8*)(lds + PG8_SA(b, h) + aoff + m * 2048 + k * 1024); } while (0)
#define PG8_LDB(dst, b, h) do { _Pragma("unroll") for (int n = 0; n < 2; ++n) _Pragma("unroll") for (int k = 0; k < 2; ++k) dst[n][k] = *(const PG8_LAS bf16x8*)(lds + PG8_SB(b, h) + boff + n * 2048 + k * 1024); } while (0)
#define PG8_MMA(ai, bj, At, Bt) do { __builtin_amdgcn_s_setprio(1); _Pragma("unroll") for (int m = 0; m < 4; ++m) _Pragma("unroll") for (int n = 0; n < 2; ++n) _Pragma("unroll") for (int k = 0; k < 2; ++k) \
        acc[ai][bj][m][n] = __builtin_amdgcn_mfma_f32_16x16x32_bf16(Bt[n][k], At[m][k], acc[ai][bj][m][n], 0, 0, 0); __builtin_amdgcn_s_setprio(0); } while (0)
#define PG8_WAIT_V(n) asm volatile("s_waitcnt vmcnt(" #n ")" ::: "memory")
#define PG8_WAIT_L(n) asm volatile("s_waitcnt lgkmcnt(" #n ")" ::: "memory")
#define PG8_BAR __builtin_amdgcn_s_barrier()
#define PG8_SCHED __builtin_amdgcn_sched_barrier(0)
    Unit cur, nxt; int ui = 0;
    if (!S.next(0, cur)) return;
    f32x4 acc[2][2][4][2];
#pragma unroll
    for (int a = 0; a < 2; ++a)
#pragma unroll
        for (int b = 0; b < 2; ++b)
#pragma unroll
            for (int m = 0; m < 4; ++m)
#pragma unroll
                for (int n = 0; n < 2; ++n) acc[a][b][m][n] = (f32x4){0.f, 0.f, 0.f, 0.f};
    bf16x8 At[4][2], B0[2][2], B1[2][2];
    const char* cA = (const char*)g.A + (size_t)cur.pm * tstep; const char* cB = (const char*)g.Bt + (size_t)cur.pn * tstep;
    S.a_ready(cur);
    if constexpr (SP2) {
        PG8_STAGE(PG8_SB(0, 0), cB, voffB); PG8_STAGE(PG8_SB(0, 1), cB + hstep, voffB); PG8_STAGE(PG8_SA(0, 0), cA, voffA); PG8_STAGE(PG8_SA(0, 1), cA + hstep, voffA);
        if (wr == 1) PG8_BAR;
        PG8_WAIT_V(2); PG8_BAR;
        PG8_STAGE(PG8_SB(1, 0), cB + kstep, voffB); PG8_STAGE(PG8_SA(1, 0), cA + kstep, voffA); PG8_STAGE(PG8_SB(1, 1), cB + hstep + kstep, voffB);
        PG8_WAIT_V(6); PG8_BAR;
    } else {
        PG8_STAGE(PG8_SB(0, 0), cB, voffB); PG8_STAGE(PG8_SA(0, 0), cA, voffA); PG8_STAGE(PG8_SB(0, 1), cB + hstep, voffB); PG8_STAGE(PG8_SA(0, 1), cA + hstep, voffA);
        if (wr == 1) PG8_BAR;
        PG8_WAIT_V(4); PG8_BAR;
        PG8_STAGE(PG8_SB(1, 0), cB + kstep, voffB); PG8_STAGE(PG8_SA(1, 0), cA + kstep, voffA); PG8_STAGE(PG8_SB(1, 1), cB + hstep + kstep, voffB);
        PG8_WAIT_V(6); PG8_BAR;
    }
    for (;;) {
        const bool has_next = S.next(ui + 1, nxt);
        const char* nA = has_next ? (const char*)g.A + (size_t)nxt.pm * tstep : cA; const char* nB = has_next ? (const char*)g.Bt + (size_t)nxt.pn * tstep : cB;
        for (int t = 0; t < nt; t += 2) {
            const bool last = (t == nt - 2);
            const char* a1 = cA + (size_t)(t + 1) * kstep;
            const char* a2 = last ? nA : cA + (size_t)(t + 2) * kstep; const char* b2 = last ? nB : cB + (size_t)(t + 2) * kstep;
            const char* a3 = a2 + kstep; const char* b3 = b2 + kstep;
            if (last && has_next) S.a_ready(nxt);
            if constexpr (SP2) {
            PG8_LDB(B0, 0, 0); PG8_LDB(B1, 0, 1); PG8_SCHED; PG8_LDA(At, 0, 0); PG8_STAGE(PG8_SA(1, 1), a1 + hstep, voffA);
            PG8_WAIT_V(8); PG8_WAIT_L(0); PG8_BAR; PG8_MMA(0, 0, At, B0); PG8_MMA(0, 1, At, B1); PG8_BAR; PG8_SCHED;
            PG8_LDA(At, 0, 1); PG8_STAGE(PG8_SB(0, 0), b2, voffB); PG8_STAGE(PG8_SB(0, 1), b2 + hstep, voffB); PG8_STAGE(PG8_SA(0, 0), a2, voffA);
            PG8_WAIT_V(8); PG8_WAIT_L(0); PG8_BAR; PG8_MMA(1, 0, At, B0); PG8_MMA(1, 1, At, B1); PG8_BAR; PG8_SCHED;
            PG8_LDB(B0, 1, 0); PG8_LDB(B1, 1, 1); PG8_SCHED; PG8_LDA(At, 1, 0); PG8_STAGE(PG8_SA(0, 1), a2 + hstep, voffA);
            PG8_WAIT_V(8); PG8_WAIT_L(0); PG8_BAR; PG8_MMA(0, 0, At, B0); PG8_MMA(0, 1, At, B1); PG8_BAR; PG8_SCHED;
            PG8_LDA(At, 1, 1); PG8_STAGE(PG8_SB(1, 0), b3, voffB); PG8_STAGE(PG8_SB(1, 1), b3 + hstep, voffB); PG8_STAGE(PG8_SA(1, 0), a3, voffA);
            PG8_WAIT_V(8); PG8_WAIT_L(0); PG8_BAR; PG8_MMA(1, 0, At, B0); PG8_MMA(1, 1, At, B1); PG8_BAR; PG8_SCHED;
            } else {
            PG8_LDB(B0, 0, 0); PG8_SCHED; PG8_LDA(At, 0, 0); PG8_STAGE(PG8_SA(1, 1), a1 + hstep, voffA);
            PG8_WAIT_L(8); PG8_BAR; PG8_WAIT_L(0); PG8_MMA(0, 0, At, B0); PG8_BAR; PG8_SCHED;
            PG8_LDB(B1, 0, 1); PG8_STAGE(PG8_SB(0, 0), b2, voffB);
            PG8_BAR; PG8_WAIT_L(0); PG8_MMA(0, 1, At, B1); PG8_BAR;
            PG8_LDA(At, 0, 1); PG8_STAGE(PG8_SA(0, 0), a2, voffA);
            PG8_BAR; PG8_WAIT_L(0); PG8_MMA(1, 0, At, B0); PG8_BAR; PG8_SCHED;
            PG8_STAGE(PG8_SB(0, 1), b2 + hstep, voffB);
            PG8_WAIT_V(6); PG8_BAR; PG8_MMA(1, 1, At, B1); PG8_BAR;
            PG8_LDB(B0, 1, 0); PG8_SCHED; PG8_LDA(At, 1, 0); PG8_STAGE(PG8_SA(0, 1), a2 + hstep, voffA);
            PG8_WAIT_L(8); PG8_BAR; PG8_WAIT_L(0); PG8_MMA(0, 0, At, B0); PG8_BAR; PG8_SCHED;
            PG8_LDB(B1, 1, 1); PG8_STAGE(PG8_SB(1, 0), b3, voffB);
            PG8_BAR; PG8_WAIT_L(0); PG8_MMA(0, 1, At, B1); PG8_BAR;
            PG8_LDA(At, 1, 1); PG8_STAGE(PG8_SA(1, 0), a3, voffA);
            PG8_BAR; PG8_WAIT_L(0); PG8_MMA(1, 0, At, B0); PG8_BAR; PG8_SCHED;
            PG8_STAGE(PG8_SB(1, 1), b3 + hstep, voffB);
            PG8_WAIT_V(6); PG8_BAR; PG8_MMA(1, 1, At, B1); PG8_BAR;
            }
        }
        if constexpr (ALIGN_EPI) { if (wr == 0) PG8_BAR; }
        if constexpr (!Epi::AFTER_DRAIN) { E(acc, cur, wr, wc, fr, fq); S.done(cur); }
        if (!has_next) break;
#pragma unroll
        for (int a = 0; a < 2; ++a)
#pragma unroll
            for (int b = 0; b < 2; ++b)
#pragma unroll
                for (int m = 0; m < 4; ++m)
#pragma unroll
                    for (int n = 0; n < 2; ++n) acc[a][b][m][n] = (f32x4){0.f, 0.f, 0.f, 0.f};
        cur = nxt; cA = nA; cB = nB; ++ui;
        if constexpr (ALIGN_EPI) { if (wr == 1) PG8_BAR; }
    }
    PG8_WAIT_V(0);
    if constexpr (!ALIGN_EPI) { if (wr == 0) PG8_BAR; }
    PG8_BAR;
    if constexpr (Epi::AFTER_DRAIN) { E.fused(acc, cur, wr, wc, fr, fq, lds, wid, lane); S.done(cur); }
#undef PG8_SA
#undef PG8_SB
#undef PG8_STAGE
#undef PG8_LDA
#undef PG8_LDB
#undef PG8_MMA
#undef PG8_WAIT_V
#undef PG8_WAIT_L
#undef PG8_BAR
#undef PG8_SCHED
}
}
#define LAS __attribute__((address_space(3)))
typedef unsigned short bf16;
typedef float f32x4 __attribute__((ext_vector_type(4)));
typedef unsigned v4u __attribute__((ext_vector_type(4)));
typedef unsigned v2u __attribute__((ext_vector_type(2)));
constexpr int NWAVES = 8, NTHR = 512;
constexpr int BATCH = 2, SEQ = 4096, DM = 2048, MROWS = BATCH * SEQ;
constexpr int NP = 7424;
constexpr int C_GQ = 0, C_GK = 512, C_GV = 1024, C_GG = 2048, C_FQ = 3072, C_FK = 4096, C_FV = 5120, C_FG = 6144, C_SMALL = 7168;
constexpr int AB_IN = 7192;
constexpr float EPS = 1e-6f;
constexpr size_t MiB = 1u << 20;
constexpr size_t WS_RSTD0 = 0, WS_PART1 = 64 * 1024, WS_PART2 = WS_PART1 + MiB, WS_CFOX = 2 * MiB + 512 * 1024, WS_SMALL = 3 * MiB  ;
constexpr size_t WS_WGLU = 4 * MiB, WS_WCOUT = 12 * MiB, WS_WCIN = 20 * MiB, WS_WOUT = 36 * MiB, WS_WIN = 44 * MiB;
constexpr size_t WS_XB = 73 * MiB, WS_MIX = 73 * MiB, WS_ZB = 73 * MiB;
constexpr size_t WS_P = 105 * MiB, WS_X1 = 105 * MiB, WS_UG = 169 * MiB;
constexpr size_t WS_ORAW = 221 * MiB;
constexpr size_t WS_TB = 20 * MiB;
constexpr int LDS_BYTES = 163840;

struct Args {
    const float* x; const float* ab_norm_g; const float* ab_w_in; const float* alpha_up; const float* alpha_b; const float* head_g; const float* fox_f_b; const float* ab_w_out;
    const float* c_norm_g; const float* c_w_in; const float* lam_re; const float* lam_im; const float* log_step; const float* b_re; const float* b_im; const float* c_re; const float* c_im;
    const float* s5_d; const float* glu_w; const float* glu_b; const float* c_w_out; const float* final_g;
    float* out; unsigned char* ws; int ph_lo, ph_hi;
};

typedef float cv_f32x2 __attribute__((ext_vector_type(2))); typedef __bf16 cv_bf16x2 __attribute__((ext_vector_type(2)));
__device__ __forceinline__ unsigned pk2(float lo, float hi) { cv_f32x2 v = {lo, hi}; cv_bf16x2 b = __builtin_convertvector(v, cv_bf16x2); return __builtin_bit_cast(unsigned, b); }
__device__ __forceinline__ unsigned f2bf(float f) { return pk2(f, f) & 0xffffu; }
__device__ __forceinline__ float bflo(unsigned w) { return __uint_as_float(w << 16); }
__device__ __forceinline__ float bfhi(unsigned w) { return __uint_as_float(w & 0xffff0000u); }
__device__ __forceinline__ float bf2f(bf16 b) { return __uint_as_float(((unsigned)b) << 16); }
__device__ __forceinline__ float wave_sum(float v) {
#pragma unroll
    for (int o = 1; o < 64; o <<= 1) v += __shfl_xor(v, o);
    return v;
}
__device__ __forceinline__ float silu_f(float x) { return x * __builtin_amdgcn_rcpf(1.0f + __expf(-x)); }
__device__ __forceinline__ float logsigmoid_f(float z) { return fminf(z, 0.f) - __logf(1.0f + __expf(-fabsf(z))); }
__device__ __forceinline__ float gelu_tanh(float y) { const float y2 = y * y; const float a2 = y * (-2.3022082f - 0.10294324f * y2); return y * __builtin_amdgcn_rcpf(1.0f + __builtin_amdgcn_exp2f(a2)); }

struct TrItem { const float* W; bf16* WT; const float* gk; int Nsrc, srcc, dstr, kb; };
__device__ __forceinline__ void tr_load(const TrItem& t, f32x4 (&v)[16], int lane) {
    const int k0 = 64 * t.kb, c4 = (lane & 15) * 4, kr = lane >> 4;
#pragma unroll
    for (int i = 0; i < 16; ++i) v[i] = __builtin_nontemporal_load((const f32x4*)(t.W + (size_t)(k0 + 4 * i + kr) * t.Nsrc + t.srcc + c4));
}
template <bool NT>
__device__ __forceinline__ void tr_store(const TrItem& t, const f32x4 (&v)[16], LAS float* scr, int lane) {
    const int K = DM, k0 = 64 * t.kb, c4 = (lane & 15) * 4, kr = lane >> 4;
#pragma unroll
    for (int i = 0; i < 16; ++i) { const int kk = 4 * i + kr; const float s = t.gk ? t.gk[k0 + kk] : 1.0f; LAS float* d = scr + kk * 65 + c4; d[0] = v[i][0] * s; d[1] = v[i][1] * s; d[2] = v[i][2] * s; d[3] = v[i][3] * s; }
    asm volatile("s_waitcnt lgkmcnt(0)" ::: "memory");
    const int c = lane & 7;
#pragma unroll
    for (int j = 0; j < 8; ++j) { const int n = (lane >> 3) + 8 * j; const LAS float* s = scr + (8 * c) * 65 + n;
        v4u o; o.x = pk2(s[0 * 65], s[1 * 65]); o.y = pk2(s[2 * 65], s[3 * 65]); o.z = pk2(s[4 * 65], s[5 * 65]); o.w = pk2(s[6 * 65], s[7 * 65]);
        if constexpr (NT) __builtin_nontemporal_store(o, (v4u*)(t.WT + (size_t)(t.dstr + n) * K + k0 + 8 * c)); else *(v4u*)(t.WT + (size_t)(t.dstr + n) * K + k0 + 8 * c) = o; }
    asm volatile("s_waitcnt lgkmcnt(0)" ::: "memory");
}
__device__ __forceinline__ TrItem tr_decode_late(const Args& a, int r) {
    constexpr int I_OUT = 32 * 32, I_CIN = 32 * 64, I_GLU = 32 * 32;
    TrItem t;
    if (r < I_OUT) { t.W = a.ab_w_out; t.WT = (bf16*)(a.ws + WS_WOUT); t.gk = nullptr; t.Nsrc = DM; t.srcc = t.dstr = 64 * (r % 32); t.kb = r / 32; return t; } r -= I_OUT;
    if (r < I_CIN) { t.W = a.c_w_in; t.WT = (bf16*)(a.ws + WS_WCIN); t.gk = a.c_norm_g; t.Nsrc = 4096; t.srcc = t.dstr = 64 * (r % 64); t.kb = r / 64; return t; } r -= I_CIN;
    if (r < I_GLU) { t.W = a.glu_w; t.WT = (bf16*)(a.ws + WS_WGLU); t.gk = nullptr; t.Nsrc = DM; t.srcc = t.dstr = 64 * (r % 32); t.kb = r / 32; return t; } r -= I_GLU;
    t.W = a.c_w_out; t.WT = (bf16*)(a.ws + WS_WCOUT); t.gk = nullptr; t.Nsrc = DM; t.srcc = t.dstr = 64 * (r % 32); t.kb = r / 32; return t;
}
__device__ __forceinline__ TrItem tr_decode_in(const Args& a, int r) {
    TrItem t; const int nb = r % 112, d0 = 64 * nb;
    t.W = a.ab_w_in; t.WT = (bf16*)(a.ws + WS_WIN); t.gk = a.ab_norm_g; t.Nsrc = AB_IN; t.srcc = d0 + (d0 < 2048 ? 0 : (d0 < 6144 ? 16 : 24)); t.dstr = d0; t.kb = r / 112; return t;
}
__device__ __forceinline__ void prologue_late(const Args& a, LAS unsigned char* lds, int tid, int widx, int nidle) {
    const int lane = tid & 63, wave = tid >> 6; LAS float* scr = (LAS float*)(lds + wave * 16640);
    constexpr int NIT = 32 * 32 * 3 + 32 * 64; const int st = nidle * NWAVES;
    int it = widx * NWAVES + wave; if (it >= NIT) return;
    TrItem cur = tr_decode_late(a, it); f32x4 v[16]; tr_load(cur, v, lane);
    for (;;) { const int nx = it + st; const bool more = nx < NIT; TrItem nt = cur; f32x4 vn[16];
        if (more) { nt = tr_decode_late(a, nx); tr_load(nt, vn, lane); }
        tr_store<false>(cur, v, scr, lane);
        if (!more) break;
#pragma unroll
        for (int i = 0; i < 16; ++i) v[i] = vn[i];
        cur = nt; it = nx; }
}
__device__ __forceinline__ void phase_prologue(const Args& a, LAS unsigned char* lds, int tid, int G) {
    const int lane = tid & 63, wave = tid >> 6;
    LAS float* scr = (LAS float*)(lds + wave * 16640);
    const int gw = blockIdx.x * NWAVES + wave, NGW = G * NWAVES;
    bf16* WinT = (bf16*)(a.ws + WS_WIN);
    constexpr int NITEMS = 32 * (7168 / 64);
    if (gw < NITEMS) { int it = gw; TrItem cur = tr_decode_in(a, it); f32x4 v[16]; tr_load(cur, v, lane);
        for (;;) { const int nx = it + NGW; const bool more = nx < NITEMS; TrItem nt = cur; f32x4 vn[16];
            if (more) { nt = tr_decode_in(a, nx); tr_load(nt, vn, lane); }
            tr_store<false>(cur, v, scr, lane);
            if (!more) break;
#pragma unroll
            for (int i = 0; i < 16; ++i) v[i] = vn[i];
            cur = nt; it = nx; } }
    for (int idx = blockIdx.x * NTHR + tid; idx < 256 * DM; idx += G * NTHR) {
        const int rr = idx / DM, k = idx % DM; float w = 0.f;
        if (rr < 16) w = a.ab_w_in[(size_t)k * AB_IN + 2048 + rr] * a.ab_norm_g[k];
        else if (rr < 24) w = a.ab_w_in[(size_t)k * AB_IN + 6160 + (rr - 16)] * a.ab_norm_g[k];
        WinT[(size_t)(C_SMALL + rr) * DM + k] = (bf16)f2bf(w);
    }
    bf16* xb = (bf16*)(a.ws + WS_XB); float* rstd0 = (float*)(a.ws + WS_RSTD0);
    for (int m0 = gw; m0 < MROWS; m0 += 2 * NGW) {
        const int m1 = m0 + NGW; const bool has1 = m1 < MROWS; const int m1c = has1 ? m1 : m0;
        const f32x4* xr0 = (const f32x4*)(a.x + (size_t)m0 * DM) + lane; const f32x4* xr1 = (const f32x4*)(a.x + (size_t)m1c * DM) + lane;
        f32x4 v0[8], v1[8];
#pragma unroll
        for (int j = 0; j < 8; ++j) v0[j] = __builtin_nontemporal_load(xr0 + 64 * j);
#pragma unroll
        for (int j = 0; j < 8; ++j) v1[j] = __builtin_nontemporal_load(xr1 + 64 * j);
        float s0 = 0.f, s1 = 0.f;
#pragma unroll
        for (int j = 0; j < 8; ++j) { s0 += (v0[j][0] * v0[j][0] + v0[j][1] * v0[j][1]) + (v0[j][2] * v0[j][2] + v0[j][3] * v0[j][3]); s1 += (v1[j][0] * v1[j][0] + v1[j][1] * v1[j][1]) + (v1[j][2] * v1[j][2] + v1[j][3] * v1[j][3]); }
        s0 = wave_sum(s0); s1 = wave_sum(s1);
        if (lane == 0) { rstd0[m0] = rsqrtf(s0 * (1.0f / DM) + EPS); if (has1) rstd0[m1] = rsqrtf(s1 * (1.0f / DM) + EPS); }
        v2u* o0 = (v2u*)(xb + (size_t)m0 * DM) + lane; v2u* o1 = (v2u*)(xb + (size_t)m1c * DM) + lane;
#pragma unroll
        for (int j = 0; j < 8; ++j) { v2u w; w.x = pk2(v0[j][0], v0[j][1]); w.y = pk2(v0[j][2], v0[j][3]); o0[64 * j] = w; }
        if (has1) {
#pragma unroll
            for (int j = 0; j < 8; ++j) { v2u w; w.x = pk2(v1[j][0], v1[j][1]); w.y = pk2(v1[j][2], v1[j][3]); o1[64 * j] = w; } }
    }
}

__device__ __forceinline__ void phase_fox_cumsum(const Args& a, LAS unsigned char* lds, int tid, int G) {
    if (blockIdx.x >= 16) return;
    const int bh = blockIdx.x, b = bh >> 3, h = bh & 7, lane = tid & 63, wave = tid >> 6; const float fb = a.fox_f_b[h];
    const float* small = (const float*)(a.ws + WS_SMALL); float* cf = (float*)(a.ws + WS_CFOX) + (size_t)bh * SEQ; LAS float* WT = (LAS float*)lds;
    float v[8]; float run = 0.f;
#pragma unroll
    for (int i = 0; i < 8; ++i) { run += logsigmoid_f(small[(size_t)(b * SEQ + tid * 8 + i) * 32 + 16 + h] + fb); v[i] = run; }
    float inc = run;
#pragma unroll
    for (int o = 1; o < 64; o <<= 1) { const float n = __shfl_up(inc, o); if (lane >= o) inc += n; }
    if (lane == 63) WT[wave] = inc;
    __syncthreads();
    float base = inc - run;
    for (int w = 0; w < wave; ++w) base += WT[w];
#pragma unroll
    for (int i = 0; i < 8; ++i) cf[tid * 8 + i] = base + v[i];
}

#define XB_TMO      128
#define XB_XCNT(j)  (256  + 64 * (j))
#define XB_XSUB(j)  (1280 + 64 * (j))
#define XB_XGEN(j)  (2304 + 64 * (j))
#define XB_TOP      3328
#define XB_TOPGEN   3392
#define XCD_BAR_WORDS 3456
#define XB_SPIN_CAP (1u << 18)

__device__ __forceinline__ unsigned xb_ld(unsigned* p)              { return __hip_atomic_load(p, __ATOMIC_RELAXED, __HIP_MEMORY_SCOPE_AGENT); }
__device__ __forceinline__ unsigned xb_add(unsigned* p, unsigned v) { return __hip_atomic_fetch_add(p, v, __ATOMIC_RELAXED, __HIP_MEMORY_SCOPE_AGENT); }
__device__ __forceinline__ unsigned xb_xcc_id() { return (unsigned)__builtin_amdgcn_s_getreg((3 << 11) | 20) & 0xFu; }
#define XB_SPIN(cond, bar) do { unsigned _sp = 0; while (cond) { __builtin_amdgcn_s_sleep(1); \
    if ((++_sp & 255u) == 0u) { if (xb_ld(&(bar)[XB_TMO])) break; if (_sp > XB_SPIN_CAP) { atomicAdd(&(bar)[XB_TMO], 1u); break; } } } } while (0)

struct XcdBarrier {
    unsigned* bar; unsigned x;
    volatile LAS unsigned* st;
};

__device__ __forceinline__ XcdBarrier xcd_barrier_post(unsigned* bar, volatile LAS unsigned* st) {
    XcdBarrier b; b.bar = bar; b.x = xb_xcc_id(); b.st = st;
    if (threadIdx.x == 0) (void)xb_add(&bar[XB_XCNT(b.x)], 1u);
    return b;
}
__device__ __forceinline__ void xcd_barrier_complete(unsigned* bar, unsigned x, unsigned& nloc, unsigned& nx) {
    const unsigned G = gridDim.x * gridDim.y * gridDim.z;
    unsigned sum, cnt, mine, sp = 0u;
    for (;;) {
        sum = 0u; cnt = 0u; mine = 0u;
#pragma unroll
        for (unsigned j = 0; j < 16; ++j) { const unsigned c = xb_ld(&bar[XB_XCNT(j)]); sum += c; cnt += (c > 0u) ? 1u : 0u; mine = (j == x) ? c : mine; }
        if (sum == G) break;
        __builtin_amdgcn_s_sleep(1);
        if ((++sp & 255u) == 0u) { if (xb_ld(&bar[XB_TMO])) break; if (sp > XB_SPIN_CAP) { atomicAdd(&bar[XB_TMO], 1u); break; } }
    }
    nloc = mine > 0u ? mine : 1u; nx = cnt > 0u ? cnt : 1u;
}

__device__ __forceinline__ void xcd_barrier(const XcdBarrier& b) {
    asm volatile("s_waitcnt vmcnt(0)" ::: "memory");
    __syncthreads();
    if (threadIdx.x == 0) {
        unsigned* bar = b.bar;
        __builtin_amdgcn_s_waitcnt(0);
        unsigned nloc = b.st[0], nx = b.st[1];
        if (nloc == 0u) { xcd_barrier_complete(bar, b.x, nloc, nx); b.st[0] = nloc; b.st[1] = nx; }
        const unsigned old = xb_add(&bar[XB_XSUB(b.x)], 1u);
        const unsigned gen = old / nloc;
        if (old + 1u == (gen + 1u) * nloc) {
            __builtin_amdgcn_fence(__ATOMIC_RELEASE, "agent");
            asm volatile("s_waitcnt vmcnt(0)" ::: "memory");
            const unsigned og = xb_add(&bar[XB_TOP], 1u);
            const unsigned tg = og / nx;
            if (og + 1u == (tg + 1u) * nx) xb_add(&bar[XB_TOPGEN], 1u);
            else XB_SPIN(xb_ld(&bar[XB_TOPGEN]) == tg, bar);
            __builtin_amdgcn_fence(__ATOMIC_ACQUIRE, "agent");
            xb_add(&bar[XB_XGEN(b.x)], 1u);
            asm volatile("s_waitcnt vmcnt(0)" ::: "memory");
        } else {
            XB_SPIN(xb_ld(&bar[XB_XGEN(b.x)]) == gen, bar);
            __builtin_amdgcn_fence(__ATOMIC_ACQUIRE, "agent");
            asm volatile("s_waitcnt vmcnt(0)" ::: "memory");
        }
    }
    __syncthreads();
}


constexpr size_t WS_BAR = 40 * 1024;
namespace fox {
constexpr int D = 128, KVS = 7424, OS = 2048, WINDOW = 4096; constexpr float THR = 8.f; constexpr bool WSKIP = false;
constexpr float SCALE = 0.08838834764831845f;
constexpr int NW = 8, QBLK = 32, KVBLK = 64, QB = NW * QBLK;
constexpr int SHM_V = KVBLK * D * 2, SHM_K = KVBLK * D * 2;
constexpr int LDS_BYTES = 2 * SHM_V + 2 * SHM_K + NW * 64 * 4;


using bf16 = unsigned short;
typedef short bf16x8 __attribute__((ext_vector_type(8)));
typedef short s16x4 __attribute__((ext_vector_type(4)));
typedef float f32x16 __attribute__((ext_vector_type(16)));
typedef float f32x4 __attribute__((ext_vector_type(4)));
typedef unsigned u32x4 __attribute__((ext_vector_type(4)));
template <class A, class Bt> struct same_t { static constexpr bool v = false; };
template <class A> struct same_t<A, A> { static constexpr bool v = true; };

#define KSWZ(row, colB) ((row) * 256 + ((colB) ^ (((row) & 7) << 4)))
#define SBAR() __builtin_amdgcn_sched_barrier(0)
__device__ __forceinline__ int v_st(int k, int c) { const int kk = (k & ~0xC) | ((k & 4) << 1) | ((k & 8) >> 1); return ((kk >> 3) * 4 + (c >> 5)) * 512 + ((kk & 7) * 32 + (c & 31)) * 2; }
__device__ __forceinline__ int v_rd_base(int lane) { return ((lane & 3) << 3) | (((lane >> 2) & 3) << 6) | (((lane >> 4) & 1) << 5) | (((lane >> 5) & 1) << 8); }
constexpr int v_rd_off(int d0, int ks, int half) { return d0 * 512 + ks * 4096 + half * 2048; }
__device__ __forceinline__ int crow(int r, int hi) { return (r & 3) + 8 * (r >> 2) + 4 * hi; }
__device__ __forceinline__ unsigned cvtpk(float lo, float hi) {
    unsigned r; asm volatile("v_cvt_pk_bf16_f32 %0, %1, %2" : "=v"(r) : "v"(lo), "v"(hi)); return r;
}
__device__ __forceinline__ bf16x8 pack8(f32x4 a, f32x4 b) {
    u32x4 w = {cvtpk(a[0], a[1]), cvtpk(a[2], a[3]), cvtpk(b[0], b[1]), cvtpk(b[2], b[3])};
    return *reinterpret_cast<bf16x8*>(&w);
}
template <class T> __device__ __forceinline__ bf16x8 load8(const T* p) {
    if constexpr (same_t<T, float>::v) { return pack8(*(const f32x4*)p, *(const f32x4*)(p + 4)); }
    else { return *reinterpret_cast<const bf16x8*>(p); }
}
typedef __attribute__((address_space(3))) float lds_f32; typedef __attribute__((address_space(3))) f32x4 lds_f32x4;
__device__ __forceinline__ void bias_tile(f32x16& p0, f32x16& p1, const lds_f32* cbk, int hi) {
    const lds_f32* cb0 = cbk + 4 * hi;
#pragma unroll
    for (int g_ = 0; g_ < 4; ++g_) { const f32x4 b0_ = *(const lds_f32x4*)(cb0 + 8 * g_), b1_ = *(const lds_f32x4*)(cb0 + 32 + 8 * g_);
        p0[4 * g_] += b0_[0]; p0[4 * g_ + 1] += b0_[1]; p0[4 * g_ + 2] += b0_[2]; p0[4 * g_ + 3] += b0_[3]; p1[4 * g_] += b1_[0]; p1[4 * g_ + 1] += b1_[1]; p1[4 * g_ + 2] += b1_[2]; p1[4 * g_ + 3] += b1_[3]; }
}
__device__ __forceinline__ void mask_tile(f32x16& p0, f32x16& p1, int dq, unsigned W) {
    const float NEG = -__builtin_inff();
#pragma unroll
    for (int r = 0; r < 16; ++r) {
        const int c = (r & 3) + 8 * (r >> 2);
        if ((unsigned)(dq - c) >= W) p0[r] = NEG;
        if ((unsigned)(dq - c - 32) >= W) p1[r] = NEG;
    }
}
__device__ __forceinline__ void partialSM(f32x16& p0, f32x16& p1, float& m_reg, float& mn, float& alpha) {
    float pmax = p0[0]; for (int r = 1; r < 16; ++r) pmax = fmaxf(pmax, p0[r]); for (int r = 0; r < 16; ++r) pmax = fmaxf(pmax, p1[r]);
    { auto rr = __builtin_amdgcn_permlane32_swap(__float_as_uint(pmax), __float_as_uint(pmax), false, false);
      pmax = fmaxf(__uint_as_float(rr[0]), __uint_as_float(rr[1])); }
    constexpr float C2 = 1.4426950408889634f * SCALE;
    if (__builtin_expect(__all((pmax - m_reg) * SCALE <= THR), 1)) { mn = m_reg; alpha = 1.f; }
    else { mn = fmaxf(m_reg, pmax); alpha = __builtin_amdgcn_exp2f((m_reg - mn) * C2); m_reg = mn; }
    const float mnL = -mn * C2;
    for (int r = 0; r < 16; ++r) p0[r] = fmaf(p0[r], C2, mnL); for (int r = 0; r < 16; ++r) p1[r] = fmaf(p1[r], C2, mnL);
    for (int r = 0; r < 16; ++r) p0[r] = __builtin_amdgcn_exp2f(p0[r]);
}
__device__ __forceinline__ void finishSM(f32x16& p0, f32x16& p1, float alpha, float& l_reg, bf16x8& pa0, bf16x8& pa1, bf16x8& pa2, bf16x8& pa3) {
    for (int r = 0; r < 16; ++r) p1[r] = __builtin_amdgcn_exp2f(p1[r]);
    float ps = 0; for (int r = 0; r < 16; ++r) ps += p0[r]; for (int r = 0; r < 16; ++r) ps += p1[r];
    { auto rr = __builtin_amdgcn_permlane32_swap(__float_as_uint(ps), __float_as_uint(ps), false, false);
      ps = __uint_as_float(rr[0]) + __uint_as_float(rr[1]); }
    l_reg = l_reg * alpha + ps;
#define PK4(P, B_, OUT) do { unsigned a0 = cvtpk(P[B_+0], P[B_+1]), a1 = cvtpk(P[B_+2], P[B_+3]);                          \
        unsigned b0 = cvtpk(P[B_+4], P[B_+5]), b1 = cvtpk(P[B_+6], P[B_+7]);                                             \
        auto r0 = __builtin_amdgcn_permlane32_swap(a0, b0, false, false); auto r1 = __builtin_amdgcn_permlane32_swap(a1, b1, false, false); \
        u32x4 w = {r0[0], r1[0], r0[1], r1[1]}; OUT = *reinterpret_cast<bf16x8*>(&w); } while (0)
    PK4(p0, 0, pa0); PK4(p0, 8, pa1); PK4(p1, 0, pa2); PK4(p1, 8, pa3);
#undef PK4
}
typedef __attribute__((address_space(3))) bf16x8 lds_bf16x8;
constexpr int QLDS_OFF = LDS_BYTES + 16384, QLDS_ROW = 272;
template <int KB, bool SK>
__device__ __forceinline__ void qkt(f32x16& p0, f32x16& p1, const char* K_lds, int r32, int hi, const lds_bf16x8* qp, bool act) {
    if (SK && !act) { const float NEG = -__builtin_inff();
#pragma unroll
        for (int r = 0; r < 16; ++r) { p0[r] = NEG; p1[r] = NEG; } return; }
    p0 = f32x16{}; p1 = f32x16{};
    const char* kb[4];
#pragma unroll
    for (int dd = 0; dd < 4; ++dd) kb[dd] = K_lds + KB * SHM_K + KSWZ(r32, (dd * 16 + hi * 8) * 2);
#pragma unroll
    for (int d0 = 0; d0 < 8; ++d0) { const char* a = kb[d0 & 3] + (d0 >> 2) * 128;
        bf16x8 b0 = *reinterpret_cast<const bf16x8*>(a);
        bf16x8 b1 = *reinterpret_cast<const bf16x8*>(a + 32 * 256); const bf16x8 qf = qp[2 * d0];
        p0 = __builtin_amdgcn_mfma_f32_32x32x16_bf16(b0, qf, p0, 0, 0, 0);
        p1 = __builtin_amdgcn_mfma_f32_32x32x16_bf16(b1, qf, p1, 0, 0, 0); }
}
template <int VB, bool SK>
__device__ __forceinline__ void pv_tile(f32x16* o, int vb0, bf16x8 pa0, bf16x8 pa1, bf16x8 pa2, bf16x8 pa3, bool act) {
    if (SK && !act) return;
#define TRRD(dst, off) asm volatile("ds_read_b64_tr_b16 %0, %1 offset:%2" : "=&v"(dst) : "v"(vb0), "i"(off) : "memory")
#define PV_D0(d0) do { s16x4 l0, l1, l2, l3, h0, h1, h2, h3; constexpr int b_ = VB * SHM_V + v_rd_off(d0, 0, 0);     \
        TRRD(l0, b_); TRRD(h0, b_ + 2048); TRRD(l1, b_ + 4096); TRRD(h1, b_ + 6144); TRRD(l2, b_ + 8192); TRRD(h2, b_ + 10240); TRRD(l3, b_ + 12288); TRRD(h3, b_ + 14336); \
        asm volatile("s_waitcnt lgkmcnt(0)" ::: "memory"); SBAR();                 \
        o[d0] = __builtin_amdgcn_mfma_f32_32x32x16_bf16(pa0, (bf16x8){l0[0], l0[1], l0[2], l0[3], h0[0], h0[1], h0[2], h0[3]}, o[d0], 0, 0, 0);   \
        o[d0] = __builtin_amdgcn_mfma_f32_32x32x16_bf16(pa1, (bf16x8){l1[0], l1[1], l1[2], l1[3], h1[0], h1[1], h1[2], h1[3]}, o[d0], 0, 0, 0);   \
        o[d0] = __builtin_amdgcn_mfma_f32_32x32x16_bf16(pa2, (bf16x8){l2[0], l2[1], l2[2], l2[3], h2[0], h2[1], h2[2], h2[3]}, o[d0], 0, 0, 0);   \
        o[d0] = __builtin_amdgcn_mfma_f32_32x32x16_bf16(pa3, (bf16x8){l3[0], l3[1], l3[2], l3[3], h3[0], h3[1], h3[2], h3[3]}, o[d0], 0, 0, 0); } while (0)
    PV_D0(0); PV_D0(1); PV_D0(2); PV_D0(3);
#undef PV_D0
#undef TRRD
}

template <class TIn, class TOut> struct BlockRef { const TIn* Q; const TIn* K; const TIn* V; TOut* O; const bf16* G; int P0; int jlo; };
template <class TIn> struct Seam {
    bf16x8 qr[8];
    bf16x8 st_v0, st_v1, st_k0, st_k1; f32x4 sf0, sf1, sf2, sf3;
    f32x4 tq[16];
};
__device__ __forceinline__ int swa_jlo(int P0, int W) { const int lowk = P0 - W + 1; return lowk > 0 ? lowk / KVBLK : 0; }
#define ROW(p, k0, rr) ((p) + (size_t)((k0) + (rr)) * KVS + sc)
#define VMW() asm volatile("s_waitcnt vmcnt(0)" ::: "memory")
#define VMWN(n) asm volatile("s_waitcnt vmcnt(%0)" :: "i"(n) : "memory")
#define SLOAD_H(Kp, Vp, k0) do { S.st_v0 = load8<TIn>(ROW(Vp, k0, sr)); S.st_v1 = load8<TIn>(ROW(Vp, k0, 32 + sr));              \
                         S.st_k0 = load8<TIn>(ROW(Kp, k0, sr)); S.st_k1 = load8<TIn>(ROW(Kp, k0, 32 + sr)); } while (0)
#define SWRITE_HK(bf) do { *(bf16x8*)(K_lds + (bf) * SHM_K + kws) = S.st_k0; *(bf16x8*)(K_lds + (bf) * SHM_K + kws + 32 * 256) = S.st_k1; } while (0)
#define SWRITE_HV(bf) do { *(bf16x8*)(V_lds + (bf) * SHM_V + vst0) = S.st_v0; *(bf16x8*)(V_lds + (bf) * SHM_V + vst1) = S.st_v1; } while (0)
#define SWRITE_H(bf) do { SWRITE_HV(bf); SWRITE_HK(bf); } while (0)
#define SLOAD_F(p, k0) do { S.sf0 = *(const f32x4*)ROW(p, k0, sr); S.sf1 = *(const f32x4*)(ROW(p, k0, sr) + 4);                \
                            S.sf2 = *(const f32x4*)ROW(p, k0, 32 + sr); S.sf3 = *(const f32x4*)(ROW(p, k0, 32 + sr) + 4); } while (0)
#define SWRITE_KF(bf) do { *(bf16x8*)(K_lds + (bf) * SHM_K + kws) = pack8(S.sf0, S.sf1); *(bf16x8*)(K_lds + (bf) * SHM_K + kws + 32 * 256) = pack8(S.sf2, S.sf3); } while (0)
#define SWRITE_VF(bf) do { *(bf16x8*)(V_lds + (bf) * SHM_V + vst0) = pack8(S.sf0, S.sf1); *(bf16x8*)(V_lds + (bf) * SHM_V + vst1) = pack8(S.sf2, S.sf3); } while (0)
template <class TIn, class TOut>
__device__ __forceinline__ void causal_swa_prime(const BlockRef<TIn, TOut>& cur, int W, char* lds, Seam<TIn>& S) {
    constexpr bool F32 = same_t<TIn, float>::v;
    const int tid = threadIdx.x, wid = __builtin_amdgcn_readfirstlane(tid >> 6), lane = tid & 63, r32 = lane & 31, hi = lane >> 5;
    const int sr = tid >> 4, sc = (tid & 15) * 8, kws = KSWZ(sr, sc * 2); char* K_lds = lds + 2 * SHM_V;
    const int kb0 = cur.jlo * KVBLK;
    for (int d0 = 0; d0 < 8; ++d0) S.qr[d0] = load8<TIn>(cur.Q + (size_t)(wid * QBLK + r32) * KVS + d0 * 16 + hi * 8);
    { lds_bf16x8* qp = (lds_bf16x8*)(lds + QLDS_OFF + (wid * QBLK + r32) * QLDS_ROW + hi * 16);
#pragma unroll
      for (int d0 = 0; d0 < 8; ++d0) qp[2 * d0] = S.qr[d0]; }
    if constexpr (F32) { SLOAD_F((const float*)cur.K, kb0); VMW(); SWRITE_KF(0); SBAR(); SLOAD_F((const float*)cur.V, kb0); }
    else { SLOAD_H(cur.K, cur.V, kb0); VMW(); SWRITE_HK(0); }
    __syncthreads();
}
template <class TIn, class TOut>
__device__ __forceinline__ void causal_swa_block(const BlockRef<TIn, TOut>& cur, const BlockRef<TIn, TOut>& nxt, int skv, int W, char* lds, Seam<TIn>& S) {
    constexpr bool F32 = same_t<TIn, float>::v;
    const int tid = threadIdx.x, wid = __builtin_amdgcn_readfirstlane(tid >> 6), lane = tid & 63, r32 = lane & 31, hi = lane >> 5;
    const int j_lo = cur.jlo;
    int j_hi = (cur.P0 + QB - 1) / KVBLK + 1; if (j_hi > skv / KVBLK) j_hi = skv / KVBLK;
    const int NT = j_hi - j_lo;
    const int kbn = nxt.jlo * KVBLK;
    const int qlo = cur.P0 + wid * QBLK, qm = qlo + r32 - 4 * hi;
    char* V_lds = lds; char* K_lds = lds + 2 * SHM_V;
    float* ws = (float*)(lds + 2 * SHM_V + 2 * SHM_K) + wid * 64; float* li_l = ws, * al_l = ws + 32;
    lds_bf16x8* qp = (lds_bf16x8*)(lds + QLDS_OFF + (wid * QBLK + r32) * QLDS_ROW + hi * 16);
    lds_f32* cb = (lds_f32*)(lds + 2 * SHM_V + 2 * SHM_K + NW * 64 * 4);
    float m_reg = -1e30f, l_reg = 0; f32x16 o[4] = {};
    const int sr = tid >> 4, sc = (tid & 15) * 8, vst0 = v_st(sr, sc), vst1 = v_st(32 + sr, sc), kws = KSWZ(sr, sc * 2);
    const int vb0 = (int)(uintptr_t)V_lds + v_rd_base(lane);
    const TIn* Kh = cur.K; const TIn* Vh = cur.V;
#define RESC(a) do { if (__any((a) < 1.f)) { if (hi == 0) al_l[r32] = (a); asm volatile("s_waitcnt lgkmcnt(0)" ::: "memory");              \
                     for (int d_ = 0; d_ < 4; ++d_) for (int r = 0; r < 16; ++r) o[d_][r] *= al_l[crow(r, hi)]; } } while (0)
#define KBASE(t) ((j_lo + (t)) * KVBLK)
#define ACT(t) (KBASE(t) <= qlo + QBLK - 1 && KBASE(t) + KVBLK - 1 >= qlo - W + 1)
#define MASKT(P0_, P1_, t) do { const int kb_ = KBASE(t); if ((!SK || ACT(t)) && (kb_ + KVBLK - 1 > qlo || kb_ <= qlo + QBLK - 1 - W)) mask_tile(P0_, P1_, qm - kb_, (unsigned)W); } while (0)
    constexpr int NQL = F32 ? 16 : 8;
    constexpr bool SK = WSKIP && !F32;
#define SEAM_K0() do { VMWN(NQL); if constexpr (F32) { SWRITE_KF(0); SBAR(); SLOAD_F((const float*)nxt.V, kbn); } else { SWRITE_HK(0); } SBAR(); } while (0)
    f32x16 pA0, pA1, pB0, pB1; float mnA, mnB, alA, alB; bf16x8 pa0, pa1, pa2, pa3;
    if constexpr (F32) { VMW(); SWRITE_VF(0); SBAR(); } else { SWRITE_HV(0); SBAR(); }
    if (NT > 1) { if constexpr (F32) SLOAD_F((const float*)Kh, KBASE(1)); else SLOAD_H(Kh, Vh, KBASE(1)); }
    SBAR(); qkt<0, SK>(pA0, pA1, K_lds, r32, hi, qp, ACT(0));
    if constexpr (F32) { if (NT > 1) { VMW(); SWRITE_KF(1); SBAR(); SLOAD_F((const float*)Vh, KBASE(1)); } }
    bias_tile(pA0, pA1, cb + KBASE(0), hi); MASKT(pA0, pA1, 0); partialSM(pA0, pA1, m_reg, mnA, alA);
    if (NT > 1) { VMW(); if constexpr (F32) { SWRITE_VF(1); SBAR(); if (NT > 2) SLOAD_F((const float*)Kh, KBASE(2)); } else SWRITE_H(1); }
    __syncthreads();
#define HALF_STEP(PX0, PX1, mnX, alX, PY0, PY1, alY, t, KB, VB, SB) do {                                                      \
        SBAR(); qkt<KB, SK>(PX0, PX1, K_lds, r32, hi, qp, ACT(t));                                             \
        finishSM(PY0, PY1, alY, l_reg, pa0, pa1, pa2, pa3); SBAR();                                                           \
        if ((t) + 1 < NT) { if constexpr (F32) { VMW(); SWRITE_KF(SB); SBAR(); SLOAD_F((const float*)Vh, KBASE((t) + 1)); }  \
                            else { SLOAD_H(Kh, Vh, KBASE((t) + 1)); } SBAR(); }                                               \
        pv_tile<VB, SK>(o, vb0, pa0, pa1, pa2, pa3, ACT((t) - 1)); bias_tile(PX0, PX1, cb + KBASE(t), hi); MASKT(PX0, PX1, (t)); partialSM(PX0, PX1, m_reg, mnX, alX);                                        \
        __syncthreads();                                                                                                      \
        if ((t) + 1 < NT) { VMW(); if constexpr (F32) { SWRITE_VF(SB); SBAR(); if ((t) + 2 < NT) SLOAD_F((const float*)Kh, KBASE((t) + 2)); } \
                            else { SWRITE_H(SB); } }                                                                          \
        RESC(alX); __syncthreads(); } while (0)
    for (int t = 1; t + 1 < NT; t += 2) {
        HALF_STEP(pB0, pB1, mnB, alB, pA0, pA1, alA, t, 1, 0, 0);
        HALF_STEP(pA0, pA1, mnA, alA, pB0, pB1, alB, t + 1, 0, 1, 1);
    }
    const bool even = (NT & 1) == 0;
    if (even) { SBAR(); qkt<1, SK>(pB0, pB1, K_lds, r32, hi, qp, ACT(NT - 1)); SBAR(); }
#define QROW(e) (nxt.Q + (size_t)(wid * QBLK + r32) * KVS + ((e) >> 1) * 16 + hi * 8 + ((e) & 1) * 4)
    if constexpr (F32) { SLOAD_F((const float*)nxt.K, kbn); SBAR();
#pragma unroll
        for (int e = 0; e < 8; ++e) S.tq[e] = *(const f32x4*)QROW(e); }
    else { SLOAD_H(nxt.K, nxt.V, kbn); SBAR();
#pragma unroll
        for (int d0 = 0; d0 < 8; ++d0) S.qr[d0] = load8<TIn>(nxt.Q + (size_t)(wid * QBLK + r32) * KVS + d0 * 16 + hi * 8); }
    SBAR();
    finishSM(pA0, pA1, alA, l_reg, pa0, pa1, pa2, pa3); SBAR();
    if constexpr (F32) {
#pragma unroll
        for (int e = 8; e < 16; ++e) S.tq[e] = *(const f32x4*)QROW(e); SBAR(); }
#undef QROW
    pv_tile<0, SK>(o, vb0, pa0, pa1, pa2, pa3, ACT(even ? NT - 2 : NT - 1));
    if (even) { bias_tile(pB0, pB1, cb + KBASE(NT - 1), hi); MASKT(pB0, pB1, NT - 1); partialSM(pB0, pB1, m_reg, mnB, alB); __syncthreads(); RESC(alB);
        finishSM(pB0, pB1, alB, l_reg, pa0, pa1, pa2, pa3); SBAR(); pv_tile<1, SK>(o, vb0, pa0, pa1, pa2, pa3, ACT(NT - 1)); }
    SBAR(); SEAM_K0();
    if (hi == 0) li_l[r32] = l_reg; asm volatile("s_waitcnt lgkmcnt(0)" ::: "memory");
    float rli[16];
#pragma unroll
    for (int r = 0; r < 16; ++r) rli[r] = __builtin_amdgcn_rcpf(li_l[crow(r, hi)]);
    TOut* Ow = cur.O + (size_t)(wid * QBLK) * OS;
    {
        typedef __attribute__((address_space(3))) unsigned short lds_u16; typedef __attribute__((address_space(3))) u32x4 lds_u32x4;
        const bf16* Gw = cur.G + (size_t)(wid * QBLK) * KVS;
        u32x4 gt[8];
#pragma unroll
        for (int i = 0; i < 8; ++i) { const int p = lane + 64 * i; gt[i] = __builtin_nontemporal_load((const u32x4*)(Gw + (size_t)(p >> 4) * KVS + (p & 15) * 8)); }
        lds_u16* st = (lds_u16*)(lds + QLDS_OFF + (wid * QBLK) * QLDS_ROW);
#pragma unroll
        for (int r = 0; r < 16; ++r) { const int orow = crow(r, hi);
#pragma unroll
            for (int d0 = 0; d0 < 4; d0 += 2) { const unsigned w2 = cvtpk(o[d0][r] * rli[r], o[d0 + 1][r] * rli[r]);
                st[orow * (QLDS_ROW / 2) + d0 * 32 + r32] = (unsigned short)w2; st[orow * (QLDS_ROW / 2) + (d0 + 1) * 32 + r32] = (unsigned short)(w2 >> 16); } }
        asm volatile("s_waitcnt lgkmcnt(0)" ::: "memory");
#pragma unroll
        for (int i = 0; i < 8; ++i) { const int p = lane + 64 * i, row = p >> 4, c8 = (p & 15) * 8;
            const u32x4 ov = *(const lds_u32x4*)(lds + QLDS_OFF + (wid * QBLK + row) * QLDS_ROW + c8 * 2); u32x4 w;
#pragma unroll
            for (int e = 0; e < 4; ++e) { const float a0 = __uint_as_float(ov[e] << 16), a1 = __uint_as_float(ov[e] & 0xffff0000u), g0 = __uint_as_float(gt[i][e] << 16), g1 = __uint_as_float(gt[i][e] & 0xffff0000u);
                w[e] = cvtpk(a0 * g0 * __builtin_amdgcn_rcpf(1.0f + __expf(-g0)), a1 * g1 * __builtin_amdgcn_rcpf(1.0f + __expf(-g1))); }
            *(u32x4*)(Ow + (size_t)row * OS + c8) = w; }
        asm volatile("s_waitcnt lgkmcnt(0)" ::: "memory");
    }
    if constexpr (F32) {
#pragma unroll
        for (int d0 = 0; d0 < 8; ++d0) S.qr[d0] = pack8(S.tq[2 * d0], S.tq[2 * d0 + 1]); }
#pragma unroll
    for (int d0 = 0; d0 < 8; ++d0) qp[2 * d0] = S.qr[d0];
    __syncthreads();
#undef RESC
#undef KBASE
#undef ACT
#undef MASKT
#undef SEAM_K0
#undef HALF_STEP
}
#undef ROW
#undef VMW
#undef VMWN
#undef SLOAD_H
#undef SWRITE_HK
#undef SWRITE_HV
#undef SWRITE_H
#undef SLOAD_F
#undef SWRITE_KF
#undef SWRITE_VF
}
__device__ __forceinline__ void fox_naive_row(const Args& a, int bh, int t, int lane) {
    const bf16* P = (const bf16*)(a.ws + WS_P); const float* cf = (const float*)(a.ws + WS_CFOX) + (size_t)bh * SEQ; bf16* mix = (bf16*)(a.ws + WS_MIX);
    const int b = bh >> 3, h = bh & 7; const size_t rowb = (size_t)b * SEQ;
    const unsigned qw = *(const unsigned*)(P + (rowb + t) * NP + C_FQ + 128 * h + 2 * lane);
    const float scale = 0.08838834764831845f; const float q0 = bflo(qw) * scale, q1 = bfhi(qw) * scale; const float ct = cf[t];
    float m = -1e30f, l = 0.f, o0 = 0.f, o1 = 0.f;
    for (int s = 0; s <= t; ++s) {
        const unsigned kw = *(const unsigned*)(P + (rowb + s) * NP + C_FK + 128 * h + 2 * lane), vw = *(const unsigned*)(P + (rowb + s) * NP + C_FV + 128 * h + 2 * lane);
        float d = q0 * bflo(kw) + q1 * bfhi(kw); d = wave_sum(d);
        const float logit = d + (ct - cf[s]);
        const float mn = fmaxf(m, logit), corr = __expf(m - mn), p = __expf(logit - mn);
        l = l * corr + p; o0 = o0 * corr + p * bflo(vw); o1 = o1 * corr + p * bfhi(vw); m = mn;
    }
    const unsigned gw_ = *(const unsigned*)(P + (rowb + t) * NP + C_FG + 128 * h + 2 * lane);
    const float inv = 1.0f / l;
    *(unsigned*)(mix + (rowb + t) * DM + 1024 + 128 * h + 2 * lane) = pk2(o0 * inv * silu_f(bflo(gw_)), o1 * inv * silu_f(bfhi(gw_)));
}
__device__ __forceinline__ void gla_naive(const Args& a, LAS unsigned char* lds, int bh, int tid) {
    const bf16* P = (const bf16*)(a.ws + WS_P); const float* small = (const float*)(a.ws + WS_SMALL); float* oraw = (float*)(a.ws + WS_ORAW);
    const int b = bh >> 2, h = bh & 3; const size_t rowb = (size_t)b * SEQ;
    LAS float* A = (LAS float*)lds; LAS float* Kk = A + 8 * 128; LAS float* Qq = Kk + 8 * 128; LAS float* Vv = Qq + 8 * 128; LAS float* OP = Vv + 8 * 256;
    const int dv = tid & 255, kh = tid >> 8;
    float S[64];
#pragma unroll
    for (int j = 0; j < 64; ++j) S[j] = 0.f;
    const float qscale = 0.08838834764831845f;
    for (int tb = 0; tb < SEQ / 8; ++tb) {
        for (int idx = tid; idx < 1024; idx += NTHR) { const int tt = idx >> 7, k = idx & 127; const size_t row = rowb + tb * 8 + tt;
            float z = a.alpha_b[128 * h + k];
#pragma unroll
            for (int r = 0; r < 16; ++r) z += small[row * 32 + r] * a.alpha_up[r * 512 + 128 * h + k];
            A[idx] = __expf(logsigmoid_f(z) * (1.0f / 16.0f)); Kk[idx] = bf2f(P[row * NP + C_GK + 128 * h + k]); Qq[idx] = bf2f(P[row * NP + C_GQ + 128 * h + k]) * qscale; }
        for (int idx = tid; idx < 2048; idx += NTHR) { const int tt = idx >> 8, d = idx & 255; Vv[idx] = bf2f(P[(rowb + tb * 8 + tt) * NP + C_GV + 256 * h + d]); }
        __syncthreads();
        for (int tt = 0; tt < 8; ++tt) { const float v = Vv[tt * 256 + dv]; float o = 0.f;
#pragma unroll
            for (int j = 0; j < 64; ++j) { const int ki = tt * 128 + kh * 64 + j; S[j] = A[ki] * S[j] + Kk[ki] * v; o += Qq[ki] * S[j]; }
            OP[(tt * 2 + kh) * 256 + dv] = o; }
        __syncthreads();
        for (int idx = tid; idx < 2048; idx += NTHR) { const int tt = idx >> 8, d = idx & 255; oraw[(rowb + tb * 8 + tt) * 1024 + 256 * h + d] = OP[(tt * 2) * 256 + d] + OP[(tt * 2 + 1) * 256 + d]; }
    }
}
__device__ __forceinline__ void gla_pass_a(const Args& a, LAS unsigned char* lds, int unit, int tid);
__device__ __forceinline__ void gla_pass_c(const Args& a, LAS unsigned char* lds, int unit, int tid);
__device__ __forceinline__ void phase_gla_b(const Args& a, int tid, int gw, int NG);
__device__ __forceinline__ void phase_gla_b2(const Args& a, int tid, int gw, int NG);
__device__ __forceinline__ void sub_barrier(unsigned* cnt, unsigned target) {
    asm volatile("s_waitcnt vmcnt(0)" ::: "memory"); __syncthreads();
    if (threadIdx.x == 0) {
        __builtin_amdgcn_fence(__ATOMIC_RELEASE, "agent"); asm volatile("s_waitcnt vmcnt(0)" ::: "memory");
        __hip_atomic_fetch_add(cnt, 1u, __ATOMIC_RELAXED, __HIP_MEMORY_SCOPE_AGENT);
        unsigned sp = 0; while (__hip_atomic_load(cnt, __ATOMIC_RELAXED, __HIP_MEMORY_SCOPE_AGENT) < target) { __builtin_amdgcn_s_sleep(2); if (++sp > (1u << 22)) break; }
        __builtin_amdgcn_fence(__ATOMIC_ACQUIRE, "agent"); asm volatile("s_waitcnt vmcnt(0)" ::: "memory");
    }
    __syncthreads();
}
__device__ __forceinline__ fox::BlockRef<bf16, bf16> fox_ref(const Args& a, int bh, int qb, int jlo) {
    const bf16* P = (const bf16*)(a.ws + WS_P); const int b = bh >> 3, h = bh & 7; const size_t row0 = (size_t)b * SEQ + (size_t)qb * 256;
    fox::BlockRef<bf16, bf16> r;
    r.Q = P + row0 * NP + C_FQ + 128 * h; r.K = P + (size_t)b * SEQ * NP + C_FK + 128 * h; r.V = P + (size_t)b * SEQ * NP + C_FV + 128 * h;
    r.O = (bf16*)(a.ws + WS_MIX) + row0 * DM + 1024 + 128 * h; r.G = P + row0 * NP + C_FG + 128 * h; r.P0 = qb * 256; r.jlo = jlo;
    return r;
}
__device__ __forceinline__ void phase_fox(const Args& a, char* lds, int w) {
    const int bh = 2 * (w & 7) + (w >> 7), qb = (w >> 3) & 15, P0 = qb * 256;
    fox::lds_f32* cb = (fox::lds_f32*)(lds + fox::LDS_BYTES);
    {   const float* cf = (const float*)(a.ws + WS_CFOX) + (size_t)bh * SEQ;
        for (int j = threadIdx.x; j < P0 + 256; j += NTHR) cb[j] = cf[j] * (-1.0f / fox::SCALE); }
    __syncthreads();
    int jl0;
    {   const float* nm = (const float*)(a.ws + WS_BAR + 20480) + (size_t)bh * 8;
        const float qn2 = (nm[0] + nm[1]) + (nm[2] + nm[3]), kn2 = (nm[4] + nm[5]) + (nm[6] + nm[7]);
        const float thr = -(50.0f / fox::SCALE) - 2.0f * 1.02f * sqrtf(qn2 * kn2);
        const int lane = threadIdx.x & 63;
        const bool skip = lane < P0 / 64 && (cb[64 * lane + 63] - cb[P0] <= thr);
        jl0 = __builtin_amdgcn_readfirstlane((int)__builtin_popcountll(__ballot(skip)));
    }
    const fox::BlockRef<bf16, bf16> cur = fox_ref(a, bh, qb, jl0);
    fox::Seam<bf16> S;
    fox::causal_swa_prime<bf16, bf16>(cur, SEQ, lds, S);
    fox::causal_swa_block<bf16, bf16>(cur, cur, SEQ, SEQ, lds, S);
}
__device__ __forceinline__ void phase_m1(const Args& a, LAS unsigned char* lds, int tid, int G) {
    for (int unit = blockIdx.x; unit < 512; unit += G) gla_pass_a(a, lds, unit, tid);
    __syncthreads();
    phase_fox_cumsum(a, lds, tid, G);
}
__device__ __forceinline__ void phase_m2(const Args& a, unsigned char* lds_raw, int tid, int G) {
    if (G * NTHR >= 131072) phase_gla_b2(a, tid, blockIdx.x, G); else phase_gla_b(a, tid, blockIdx.x, G);
    if (blockIdx.x < 256) phase_fox(a, (char*)lds_raw, blockIdx.x);
}
__device__ __forceinline__ void phase_gla_finalize(const Args& a, int tid, int G) {
    const int lane = tid & 63, wave = tid >> 6; const int gw = blockIdx.x * NWAVES + wave, NGW = G * NWAVES;
    const bf16* P = (const bf16*)(a.ws + WS_P); const float* oraw = (const float*)(a.ws + WS_ORAW); bf16* mix = (bf16*)(a.ws + WS_MIX);
    for (int it = gw; it < MROWS * 4; it += NGW) { const int row = it >> 2, h = it & 3;
        const f32x4 v = *(const f32x4*)(oraw + (size_t)row * 1024 + 256 * h + 4 * lane);
        float s = (v[0] * v[0] + v[1] * v[1]) + (v[2] * v[2] + v[3] * v[3]); s = wave_sum(s);
        const float r = rsqrtf(s * (1.0f / 256.0f) + EPS);
        const f32x4 g = *(const f32x4*)(a.head_g + 256 * h + 4 * lane);
        const v2u gt = *(const v2u*)(P + (size_t)row * NP + C_GG + 256 * h + 4 * lane);
        v2u w; w.x = pk2(v[0] * r * g[0] * silu_f(bflo(gt.x)), v[1] * r * g[1] * silu_f(bfhi(gt.x))); w.y = pk2(v[2] * r * g[2] * silu_f(bflo(gt.y)), v[3] * r * g[3] * silu_f(bfhi(gt.y)));
        *(v2u*)(mix + (size_t)row * DM + 256 * h + 4 * lane) = w; }
    for (int row0 = gw; row0 < MROWS; row0 += 4 * NGW) {
        v4u m[4][2], g[4][2];
#pragma unroll
        for (int rr = 0; rr < 4; ++rr) { const int row = row0 + rr * NGW; if (row < MROWS) { const v4u* mp = (const v4u*)(mix + (size_t)row * DM + 1024 + 16 * lane); const v4u* gp = (const v4u*)(P + (size_t)row * NP + C_FG + 16 * lane);
            m[rr][0] = mp[0]; m[rr][1] = mp[1]; g[rr][0] = gp[0]; g[rr][1] = gp[1]; } }
#pragma unroll
        for (int rr = 0; rr < 4; ++rr) { const int row = row0 + rr * NGW; if (row < MROWS) { v4u* mp = (v4u*)(mix + (size_t)row * DM + 1024 + 16 * lane);
#pragma unroll
            for (int q = 0; q < 2; ++q) { v4u o;
#pragma unroll
                for (int e = 0; e < 4; ++e) o[e] = pk2(bflo(m[rr][q][e]) * silu_f(bflo(g[rr][q][e])), bfhi(m[rr][q][e]) * silu_f(bfhi(g[rr][q][e])));
                mp[q] = o; } } }
    }
}
__device__ __forceinline__ void phase_s5_naive(const Args& a, int tid, int G) {
    const int lane = tid & 63, wave = tid >> 6; const int gw = blockIdx.x * NWAVES + wave;
    if (gw >= 256) return;
    const int b = gw >> 7, g = gw & 127, p = lane;
    const bf16* UG = (const bf16*)(a.ws + WS_UG); bf16* zb = (bf16*)(a.ws + WS_ZB);
    const float lr = fminf(a.lam_re[g * 64 + p], -1e-4f), li = a.lam_im[g * 64 + p], step = __expf(a.log_step[g]);
    const float mag = __expf(lr * step), lbr = mag * cosf(li * step), lbi = mag * sinf(li * step);
    const float den = lr * lr + li * li, nr = lbr - 1.0f, ni = lbi, cr = (nr * lr + ni * li) / den, ci = (ni * lr - nr * li) / den;
    float bbr[16], bbi[16], ccr[16], cci[16];
#pragma unroll
    for (int c = 0; c < 16; ++c) { const float br = a.b_re[(g * 64 + p) * 16 + c], bi = a.b_im[(g * 64 + p) * 16 + c]; bbr[c] = cr * br - ci * bi; bbi[c] = cr * bi + ci * br;
        ccr[c] = a.c_re[(g * 16 + c) * 64 + p]; cci[c] = a.c_im[(g * 16 + c) * 64 + p]; }
    const float dd = a.s5_d[g * 16 + (lane & 15)];
    float xr = 0.f, xi = 0.f;
    for (int t = 0; t < SEQ; ++t) { const size_t row = (size_t)b * SEQ + t;
        const v4u u0 = *(const v4u*)(UG + row * 4096 + 16 * g), u1 = *(const v4u*)(UG + row * 4096 + 16 * g + 8);
        float u[16];
#pragma unroll
        for (int e = 0; e < 4; ++e) { u[2 * e] = bflo(u0[e]); u[2 * e + 1] = bfhi(u0[e]); u[8 + 2 * e] = bflo(u1[e]); u[8 + 2 * e + 1] = bfhi(u1[e]); }
        float br = 0.f, bi = 0.f;
#pragma unroll
        for (int c = 0; c < 16; ++c) { br += bbr[c] * u[c]; bi += bbi[c] * u[c]; }
        const float nxr = lbr * xr - lbi * xi + br, nxi = lbr * xi + lbi * xr + bi; xr = nxr; xi = nxi;
        float ymine = 0.f, umine = 0.f;
#pragma unroll
        for (int c = 0; c < 16; ++c) { const float y = wave_sum(ccr[c] * xr - cci[c] * xi); if ((lane & 15) == c) { ymine = y; umine = u[c]; } }
        if (lane < 16) { const float y = ymine + dd * umine; zb[row * DM + 16 * g + lane] = (bf16)f2bf(gelu_tanh(y)); }
    }
}

typedef short s5_bf16x8 __attribute__((ext_vector_type(8)));
typedef float s5_f32x16 __attribute__((ext_vector_type(16)));
typedef float s5_f32x2 __attribute__((ext_vector_type(2)));
template <bool PASS2>
__device__ __forceinline__ void s5_pass(const bf16* UG, bf16* zb, LAS unsigned char* xl, int g, int seg0, int lane, const s5_bf16x8 (&Bf)[4], const s5_bf16x8 (&Cf)[4], f32x4 Dv,
                                        float lbr0, float lbi0, float lbr1, float lbi1, s5_f32x2& xr0, s5_f32x2& xi0, s5_f32x2& xr1, s5_f32x2& xi1, int nblk) {
    const int r = lane & 31, hl = lane >> 5, q4 = lane >> 4;
    const int rgA = 4 * (r >> 3) + (r & 3);
    const bf16* ap = UG + ((size_t)((rgA & 1) * SEQ + seg0 + 128 * ((r >> 2) & 1) + (rgA >> 1))) * 4096 + 16 * g + 8 * hl;
    s5_bf16x8 af = *(const s5_bf16x8*)ap;
    for (int blk = 0; blk < nblk; ++blk) {
        const s5_bf16x8 afn = *(const s5_bf16x8*)(ap + (size_t)((blk < nblk - 1 ? blk + 1 : blk) * 8) * 4096);
        v2u uu2[2] = {};
        if constexpr (PASS2) {
#pragma unroll
            for (int nblk = 0; nblk < 2; ++nblk) { const int i = 16 * nblk + (lane & 15), rg = 4 * (i >> 3) + (i & 3); const size_t rowg = (size_t)((rg & 1) * SEQ + seg0 + 128 * ((i >> 2) & 1) + blk * 8 + (rg >> 1));
                uu2[nblk] = *(const v2u*)(UG + rowg * 4096 + 16 * g + 4 * q4); } }
        s5_f32x16 acc[4];
#pragma unroll
        for (int nb = 0; nb < 4; ++nb) { acc[nb] = s5_f32x16{}; acc[nb] = __builtin_amdgcn_mfma_f32_32x32x16_bf16(af, Bf[nb], acc[nb], 0, 0, 0); }
#pragma unroll
        for (int k = 0; k < 8; ++k) {
            const s5_f32x2 b0r = {acc[0][2 * k], acc[0][2 * k + 1]}, b0i = {acc[2][2 * k], acc[2][2 * k + 1]}, b1r = {acc[1][2 * k], acc[1][2 * k + 1]}, b1i = {acc[3][2 * k], acc[3][2 * k + 1]};
            const s5_f32x2 n0r = lbr0 * xr0 - lbi0 * xi0 + b0r, n0i = lbr0 * xi0 + lbi0 * xr0 + b0i;
            const s5_f32x2 n1r = lbr1 * xr1 - lbi1 * xi1 + b1r, n1i = lbr1 * xi1 + lbi1 * xr1 + b1i;
            xr0 = n0r; xi0 = n0i; xr1 = n1r; xi1 = n1i;
            acc[0][2 * k] = n0r.x; acc[0][2 * k + 1] = n0r.y; acc[2][2 * k] = n0i.x; acc[2][2 * k + 1] = n0i.y; acc[1][2 * k] = n1r.x; acc[1][2 * k + 1] = n1r.y; acc[3][2 * k] = n1i.x; acc[3][2 * k + 1] = n1i.y;
        }
        if constexpr (PASS2) {
#pragma unroll
            for (int nb = 0; nb < 4; ++nb)
#pragma unroll
                for (int t = 0; t < 16; t += 2) { const int i = (t & 3) + 8 * (t >> 2) + 4 * hl; const unsigned pw = pk2(acc[nb][t], acc[nb][t + 1]);
                    *(LAS unsigned short*)(xl + i * 272 + (32 * nb + r) * 2) = (unsigned short)pw; *(LAS unsigned short*)(xl + (i + 1) * 272 + (32 * nb + r) * 2) = (unsigned short)(pw >> 16); }
            asm volatile("s_waitcnt lgkmcnt(0)" ::: "memory"); __builtin_amdgcn_wave_barrier();
#pragma unroll
            for (int nblk = 0; nblk < 2; ++nblk) {
                const int i = 16 * nblk + (lane & 15), rg = 4 * (i >> 3) + (i & 3);
                f32x4 y = {0.f, 0.f, 0.f, 0.f};
#pragma unroll
                for (int ks = 0; ks < 4; ++ks) { const s5_bf16x8 xf = *(const LAS s5_bf16x8*)(xl + i * 272 + 64 * ks + 16 * q4); y = __builtin_amdgcn_mfma_f32_16x16x32_bf16(Cf[ks], xf, y, 0, 0, 0); }
                const size_t rowg = (size_t)((rg & 1) * SEQ + seg0 + 128 * ((i >> 2) & 1) + blk * 8 + (rg >> 1));
                const v2u uu = uu2[nblk];
                const float z0 = gelu_tanh(y[0] + Dv[0] * bflo(uu.x)), z1 = gelu_tanh(y[1] + Dv[1] * bfhi(uu.x)), z2 = gelu_tanh(y[2] + Dv[2] * bflo(uu.y)), z3 = gelu_tanh(y[3] + Dv[3] * bfhi(uu.y));
                v2u w; w.x = pk2(z0, z1); w.y = pk2(z2, z3); *(v2u*)(zb + rowg * DM + 16 * g + 4 * q4) = w;
            }
            asm volatile("s_waitcnt lgkmcnt(0)" ::: "memory"); __builtin_amdgcn_wave_barrier();
        }
        af = afn;
    }
}
constexpr size_t WS_S5E = 56 * MiB;
__device__ __forceinline__ void phase_s5(const Args& a, LAS unsigned char* lds, int tid) {
    if (blockIdx.x >= 256) return;
    const int wave0 = __builtin_amdgcn_readfirstlane(tid >> 6);
    const int g = (blockIdx.x & 15) * 8 + wave0, seg_wg = blockIdx.x >> 4;
    const int lane = tid & 63, wave = wave0, r = lane & 31, hl = lane >> 5, q4 = lane >> 4, ch = lane & 15;
    const bf16* UG = (const bf16*)(a.ws + WS_UG); bf16* zb = (bf16*)(a.ws + WS_ZB);
    const float step = __expf(a.log_step[g]);
    float lbr[2], lbi[2]; s5_bf16x8 Bf[4], Cf[4];
#pragma unroll
    for (int s2 = 0; s2 < 2; ++s2) { const int p = r + 32 * s2;
        const float lr = fminf(a.lam_re[g * 64 + p], -1e-4f), li = a.lam_im[g * 64 + p];
        const float mag = __expf(lr * step); lbr[s2] = mag * cosf(li * step); lbi[s2] = mag * sinf(li * step);
        const float den = lr * lr + li * li, nr = lbr[s2] - 1.0f, ni = lbi[s2], cr = (nr * lr + ni * li) / den, ci = (ni * lr - nr * li) / den;
        const f32x4 br0 = *(const f32x4*)(a.b_re + (size_t)(g * 64 + p) * 16 + 8 * hl), br1 = *(const f32x4*)(a.b_re + (size_t)(g * 64 + p) * 16 + 8 * hl + 4);
        const f32x4 bi0 = *(const f32x4*)(a.b_im + (size_t)(g * 64 + p) * 16 + 8 * hl), bi1 = *(const f32x4*)(a.b_im + (size_t)(g * 64 + p) * 16 + 8 * hl + 4);
#pragma unroll
        for (int j = 0; j < 8; ++j) { const float br = j < 4 ? br0[j & 3] : br1[j & 3], bi = j < 4 ? bi0[j & 3] : bi1[j & 3];
            Bf[s2][j] = (short)f2bf(cr * br - ci * bi); Bf[2 + s2][j] = (short)f2bf(cr * bi + ci * br); } }
#pragma unroll
    for (int ks = 0; ks < 4; ++ks) { const int st = (ks & 1) * 32 + 8 * q4; const float* src = (ks < 2 ? a.c_re : a.c_im) + (size_t)(g * 16 + ch) * 64 + st;
        const f32x4 c0 = *(const f32x4*)src, c1 = *(const f32x4*)(src + 4);
#pragma unroll
        for (int j = 0; j < 8; ++j) { const float v = j < 4 ? c0[j & 3] : c1[j & 3]; Cf[ks][j] = (short)f2bf(ks < 2 ? v : -v); } }
    const f32x4 Dv = *(const f32x4*)(a.s5_d + g * 16 + 4 * q4);
    LAS unsigned char* xl = lds + wave * 8704; float* Ef = (float*)(a.ws + WS_S5E) + (size_t)g * 32 * 32 * 8;
    const int seg = seg_wg, subseg = 2 * seg + hl;
    s5_f32x2 xr0 = {0.f, 0.f}, xi0 = {0.f, 0.f}, xr1 = {0.f, 0.f}, xi1 = {0.f, 0.f};
    s5_pass<false>(UG, zb, xl, g, seg * 256, lane, Bf, Cf, Dv, lbr[0], lbi[0], lbr[1], lbi[1], xr0, xi0, xr1, xi1, 16);
    {   unsigned long long* E64 = (unsigned long long*)(Ef + (size_t)(subseg * 32 + r) * 8);
        __hip_atomic_store(E64, ((unsigned long long)__float_as_uint(xr0.y) << 32) | __float_as_uint(xr0.x), __ATOMIC_RELAXED, __HIP_MEMORY_SCOPE_AGENT);
        __hip_atomic_store(E64 + 1, ((unsigned long long)__float_as_uint(xi0.y) << 32) | __float_as_uint(xi0.x), __ATOMIC_RELAXED, __HIP_MEMORY_SCOPE_AGENT);
        __hip_atomic_store(E64 + 2, ((unsigned long long)__float_as_uint(xr1.y) << 32) | __float_as_uint(xr1.x), __ATOMIC_RELAXED, __HIP_MEMORY_SCOPE_AGENT);
        __hip_atomic_store(E64 + 3, ((unsigned long long)__float_as_uint(xi1.y) << 32) | __float_as_uint(xi1.x), __ATOMIC_RELAXED, __HIP_MEMORY_SCOPE_AGENT); }
    asm volatile("s_waitcnt vmcnt(0)" ::: "memory"); __syncthreads();
    unsigned* cnt = (unsigned*)(a.ws + WS_BAR + 18432) + 16 * (blockIdx.x & 15);
    if (tid == 0) { __hip_atomic_fetch_add(cnt, 1u, __ATOMIC_RELAXED, __HIP_MEMORY_SCOPE_AGENT);
        unsigned sp = 0; while (__hip_atomic_load(cnt, __ATOMIC_RELAXED, __HIP_MEMORY_SCOPE_AGENT) < 16u) { __builtin_amdgcn_s_sleep(2); if (++sp > (1u << 20)) break; }
        __builtin_amdgcn_fence(__ATOMIC_ACQUIRE, "agent"); asm volatile("s_waitcnt vmcnt(0)" ::: "memory"); }
    __syncthreads();
    {   float p0r = lbr[0], p0i = lbi[0], p1r = lbr[1], p1i = lbi[1];
#pragma unroll
        for (int s = 0; s < 7; ++s) { const float a0 = p0r * p0r - p0i * p0i, b0 = 2.f * p0r * p0i, a1 = p1r * p1r - p1i * p1i, b1 = 2.f * p1r * p1i; p0r = a0; p0i = b0; p1r = a1; p1i = b1; }
        xr0 = (s5_f32x2){0.f, 0.f}; xi0 = xr0; xr1 = xr0; xi1 = xr0;
        for (int s0 = 0; s0 < 2 * seg + 1; s0 += 8) {
            f32x4 e0[8], e1[8];
#pragma unroll
            for (int j = 0; j < 8; ++j) { const int sc = (s0 + j < subseg) ? s0 + j : 0; e0[j] = *(const f32x4*)(Ef + (size_t)(sc * 32 + r) * 8); e1[j] = *(const f32x4*)(Ef + (size_t)(sc * 32 + r) * 8 + 4); }
#pragma unroll
            for (int j = 0; j < 8; ++j) { if (s0 + j < subseg) {
                const s5_f32x2 er0 = {e0[j][0], e0[j][1]}, ei0 = {e0[j][2], e0[j][3]}, er1 = {e1[j][0], e1[j][1]}, ei1 = {e1[j][2], e1[j][3]};
                const s5_f32x2 n0r = p0r * xr0 - p0i * xi0 + er0, n0i = p0r * xi0 + p0i * xr0 + ei0, n1r = p1r * xr1 - p1i * xi1 + er1, n1i = p1r * xi1 + p1i * xr1 + ei1;
                xr0 = n0r; xi0 = n0i; xr1 = n1r; xi1 = n1i; } } }
        s5_pass<true>(UG, zb, xl, g, seg * 256, lane, Bf, Cf, Dv, lbr[0], lbi[0], lbr[1], lbi[1], xr0, xi0, xr1, xi1, 16);
    }
}
constexpr size_t WS_S5E_DUMMY = 0;

typedef short g_bf16x8 __attribute__((ext_vector_type(8)));
typedef float g_f32x16 __attribute__((ext_vector_type(16)));
constexpr size_t WS_QT = 44 * MiB, WS_OINTRA = 52 * MiB, WS_SINT = 221 * MiB, WS_DECAY = WS_PART2;
__device__ __forceinline__ int g_irow(int reg, int hl) { return (reg & 3) + 8 * (reg >> 2) + 4 * hl; }
__device__ __forceinline__ void gla_pass_a(const Args& a, LAS unsigned char* lds, int unit, int tid) {
    const bf16* P = (const bf16*)(a.ws + WS_P); const float* small = (const float*)(a.ws + WS_SMALL);
    bf16* qtg = (bf16*)(a.ws + WS_QT); unsigned* oin = (unsigned*)(a.ws + WS_OINTRA); bf16* kvt = (bf16*)a.out; float* decay = (float*)(a.ws + WS_DECAY);
    const int bh = unit >> 6, n = unit & 63, b = bh >> 2, h = bh & 3; const size_t R0 = (size_t)b * SEQ + 64 * n;
    LAS bf16* QT = (LAS bf16*)lds; LAS bf16* KT = (LAS bf16*)(lds + 17408); LAS bf16* KH = (LAS bf16*)(lds + 34816); LAS bf16* VT = (LAS bf16*)(lds + 53248); LAS bf16* AT = (LAS bf16*)(lds + 90112); LAS float* PART = (LAS float*)(lds + 99328);
    const int lane = tid & 63, w = __builtin_amdgcn_readfirstlane(tid >> 6), r = lane & 31, hl = lane >> 5;
    __syncthreads();
    {
        const int col = tid & 127, qtr = tid >> 7; const float ab = a.alpha_b[128 * h + col]; float au[16];
#pragma unroll
        for (int rr = 0; rr < 16; ++rr) au[rr] = a.alpha_up[rr * 512 + 128 * h + col];
        bf16 qraw[16], kraw[16];
#pragma unroll
        for (int t = 0; t < 16; ++t) { const size_t row = R0 + 16 * qtr + t; qraw[t] = P[row * NP + C_GQ + 128 * h + col]; kraw[t] = P[row * NP + C_GK + 128 * h + col]; }
        float cs[16]; float run = 0.f;
#pragma unroll
        for (int t = 0; t < 16; ++t) { const size_t row = R0 + 16 * qtr + t; const f32x4* sp = (const f32x4*)(small + row * 32); float z = ab;
#pragma unroll
            for (int q = 0; q < 4; ++q) { const f32x4 s4 = sp[q]; z += s4[0] * au[4 * q] + s4[1] * au[4 * q + 1] + s4[2] * au[4 * q + 2] + s4[3] * au[4 * q + 3]; }
            run += logsigmoid_f(z) * (1.0f / 16.0f); cs[t] = run; }
        PART[qtr * 128 + col] = run;
        {   const int dv = tid & 255, half = tid >> 8;
#pragma unroll 8
            for (int t = 0; t < 32; t += 2) { const int tok = 32 * half + t; const unsigned lo = P[(R0 + tok) * NP + C_GV + 256 * h + dv], hi2 = P[(R0 + tok + 1) * NP + C_GV + 256 * h + dv];
                *(LAS unsigned*)(VT + dv * 72 + tok) = lo | (hi2 << 16); } }
        __syncthreads();
        float pre = 0.f, tot = 0.f;
#pragma unroll
        for (int q = 0; q < 4; ++q) { const float v = PART[q * 128 + col]; tot += v; if (q < qtr) pre += v; }
        const float qscale = 0.08838834764831845f;
#pragma unroll
        for (int t = 0; t < 16; t += 2) { float khv[2];
#pragma unroll
            for (int u2 = 0; u2 < 2; ++u2) { const int tok = 16 * qtr + t + u2; const size_t row = R0 + tok; const float bb = pre + cs[t + u2];
                const float qv = bf2f(qraw[t + u2]) * qscale * __expf(bb), kv = bf2f(kraw[t + u2]);
                const bf16 qb = (bf16)f2bf(qv);
                QT[tok * 136 + col] = qb; KT[tok * 136 + col] = (bf16)f2bf(kv * __expf(-bb)); khv[u2] = kv * __expf(tot - bb); qtg[row * 512 + 128 * h + col] = qb; }
            *(LAS unsigned*)(KH + col * 72 + 16 * qtr + t) = pk2(khv[0], khv[1]); }
        if (qtr == 0) decay[(size_t)unit * 128 + col] = __expf(tot);
    }
    __syncthreads();
    if (w < 4) {
        const int bi = w >> 1, bj = w & 1;
        if (bi == 0 && bj == 1) {
#pragma unroll
            for (int reg = 0; reg < 16; ++reg) AT[g_irow(reg, hl) * 72 + 32 + r] = 0;
        } else {
            g_f32x16 acc = g_f32x16{};
#pragma unroll
            for (int ks = 0; ks < 8; ++ks) { const g_bf16x8 af = *(const LAS g_bf16x8*)(QT + (32 * bi + r) * 136 + 16 * ks + 8 * hl), bf = *(const LAS g_bf16x8*)(KT + (32 * bj + r) * 136 + 16 * ks + 8 * hl);
                acc = __builtin_amdgcn_mfma_f32_32x32x16_bf16(af, bf, acc, 0, 0, 0); }
#pragma unroll
            for (int reg = 0; reg < 16; ++reg) { const int i = 32 * bi + g_irow(reg, hl), j = 32 * bj + r; AT[i * 72 + j] = (bf16)f2bf(j <= i ? acc[reg] : 0.f); }
        }
    }
    __syncthreads();
    {
#pragma unroll
        for (int bi = 0; bi < 2; ++bi) { g_f32x16 acc = g_f32x16{};
#pragma unroll
            for (int ks = 0; ks < 4; ++ks) { if (bi == 0 && ks >= 2) continue;
                const g_bf16x8 af = *(const LAS g_bf16x8*)(AT + (32 * bi + r) * 72 + 16 * ks + 8 * hl), bf = *(const LAS g_bf16x8*)(VT + (32 * w + r) * 72 + 16 * ks + 8 * hl);
                acc = __builtin_amdgcn_mfma_f32_32x32x16_bf16(bf, af, acc, 0, 0, 0); }
            v4u o0, o1;
#pragma unroll
            for (int e = 0; e < 4; ++e) { o0[e] = pk2(acc[2 * e], acc[2 * e + 1]); o1[e] = pk2(acc[8 + 2 * e], acc[8 + 2 * e + 1]); }
            v4u* op = (v4u*)(oin + ((size_t)((unit * 8 + w) * 2 + bi) * 64 + lane) * 8); op[0] = o0; op[1] = o1; }
        g_bf16x8 av[4];
#pragma unroll
        for (int ks = 0; ks < 4; ++ks) av[ks] = *(const LAS g_bf16x8*)(VT + (32 * w + r) * 72 + 16 * ks + 8 * hl);
#pragma unroll
        for (int nb = 0; nb < 4; ++nb) { g_f32x16 acc = g_f32x16{};
#pragma unroll
            for (int ks = 0; ks < 4; ++ks) { const g_bf16x8 bf = *(const LAS g_bf16x8*)(KH + (32 * nb + r) * 72 + 16 * ks + 8 * hl); acc = __builtin_amdgcn_mfma_f32_32x32x16_bf16(bf, av[ks], acc, 0, 0, 0); }
#pragma unroll
            for (int g4 = 0; g4 < 4; ++g4) { v2u o; o.x = pk2(acc[4 * g4], acc[4 * g4 + 1]); o.y = pk2(acc[4 * g4 + 2], acc[4 * g4 + 3]);
                *(v2u*)(kvt + ((size_t)unit * 256 + 32 * w + r) * 128 + 32 * nb + 8 * g4 + 4 * hl) = o; } }
    }
}
__device__ __forceinline__ void phase_gla_b(const Args& a, int tid, int gw, int NG) {
    const bf16* kvt = (const bf16*)a.out; const float* decay = (const float*)(a.ws + WS_DECAY); bf16* sint = (bf16*)(a.ws + WS_SINT);
    for (size_t qi = (size_t)gw * NTHR + tid; qi < (size_t)2 * 32768; qi += (size_t)NG * NTHR) {
        const size_t idx = qi * 4; const int bh = (int)(idx >> 15), e = (int)(idx & 32767);
        float s0 = 0.f, s1 = 0.f, s2 = 0.f, s3 = 0.f;
#pragma unroll 8
        for (int n = 0; n < 64; ++n) { const size_t unit = (size_t)bh * 64 + n;
            v2u o; o.x = pk2(s0, s1); o.y = pk2(s2, s3); *(v2u*)(sint + unit * 32768 + e) = o;
            const f32x4 d = *(const f32x4*)(decay + unit * 128 + (e & 127)); const v2u kw = *(const v2u*)(kvt + unit * 32768 + e);
            s0 = d[0] * s0 + bflo(kw.x); s1 = d[1] * s1 + bfhi(kw.x); s2 = d[2] * s2 + bflo(kw.y); s3 = d[3] * s3 + bfhi(kw.y); }
    }
}
__device__ __forceinline__ void phase_gla_b2(const Args& a, int tid, int gw, int NG) {
    typedef float f32x2v __attribute__((ext_vector_type(2)));
    const bf16* kvt = (const bf16*)a.out; const float* decay = (const float*)(a.ws + WS_DECAY); bf16* sint = (bf16*)(a.ws + WS_SINT);
    for (size_t pi = (size_t)gw * NTHR + tid; pi < (size_t)4 * 32768; pi += (size_t)NG * NTHR) {
        const size_t idx = pi * 2; const int bh = (int)(idx >> 15), e = (int)(idx & 32767);
        float s0 = 0.f, s1 = 0.f;
#pragma unroll 8
        for (int n = 0; n < 64; ++n) { const size_t unit = (size_t)bh * 64 + n;
            *(unsigned*)(sint + unit * 32768 + e) = pk2(s0, s1);
            const f32x2v d = *(const f32x2v*)(decay + unit * 128 + (e & 127)); const unsigned kw = *(const unsigned*)(kvt + unit * 32768 + e);
            s0 = d.x * s0 + bflo(kw); s1 = d.y * s1 + bfhi(kw); }
    }
}
__device__ __forceinline__ void gla_pass_c(const Args& a, LAS unsigned char* lds, int unit, int tid) {
    const bf16* P = (const bf16*)(a.ws + WS_P); const bf16* qtg = (const bf16*)(a.ws + WS_QT); const unsigned* oin = (const unsigned*)(a.ws + WS_OINTRA); const bf16* sint = (const bf16*)(a.ws + WS_SINT); bf16* mix = (bf16*)(a.ws + WS_MIX);
    const int bh = unit >> 6, n = unit & 63, b = bh >> 2, h = bh & 3; const size_t R0 = (size_t)b * SEQ + 64 * n;
    const int lane = tid & 63, w = __builtin_amdgcn_readfirstlane(tid >> 6), r = lane & 31, hl = lane >> 5;
    LAS float* RED = (LAS float*)lds; LAS float* RSTD = RED + 1024;
    g_f32x16 acc[2];
#pragma unroll
    for (int bi = 0; bi < 2; ++bi) { const v4u* op = (const v4u*)(oin + ((size_t)((unit * 8 + w) * 2 + bi) * 64 + lane) * 8); const v4u o0 = op[0], o1 = op[1];
#pragma unroll
        for (int e = 0; e < 4; ++e) { acc[bi][2 * e] = bflo(o0[e]); acc[bi][2 * e + 1] = bfhi(o0[e]); acc[bi][8 + 2 * e] = bflo(o1[e]); acc[bi][8 + 2 * e + 1] = bfhi(o1[e]); } }
    v2u gtv[2][4]; f32x4 hgv[4];
#pragma unroll
    for (int g4 = 0; g4 < 4; ++g4) { const int dv0 = 32 * w + 8 * g4 + 4 * hl; hgv[g4] = *(const f32x4*)(a.head_g + 256 * h + dv0);
#pragma unroll
        for (int bi = 0; bi < 2; ++bi) gtv[bi][g4] = *(const v2u*)(P + (R0 + 32 * bi + r) * NP + C_GG + 256 * h + dv0); }
#pragma unroll
    for (int ks = 0; ks < 8; ++ks) { const g_bf16x8 sf = *(const g_bf16x8*)(sint + ((size_t)unit * 256 + 32 * w + r) * 128 + 16 * ks + 8 * hl);
#pragma unroll
        for (int bi = 0; bi < 2; ++bi) { const g_bf16x8 qf = *(const g_bf16x8*)(qtg + (R0 + 32 * bi + r) * 512 + 128 * h + 16 * ks + 8 * hl); acc[bi] = __builtin_amdgcn_mfma_f32_32x32x16_bf16(sf, qf, acc[bi], 0, 0, 0); } }
    __syncthreads();
#pragma unroll
    for (int bi = 0; bi < 2; ++bi) { float s = 0.f;
#pragma unroll
        for (int reg = 0; reg < 16; ++reg) s += acc[bi][reg] * acc[bi][reg];
        RED[(w * 2 + hl) * 64 + 32 * bi + r] = s; }
    __syncthreads();
    if (tid < 64) { float t = 0.f;
#pragma unroll
        for (int q = 0; q < 16; ++q) t += RED[q * 64 + tid];
        RSTD[tid] = rsqrtf(t * (1.0f / 256.0f) + EPS); }
    __syncthreads();
#pragma unroll
    for (int bi = 0; bi < 2; ++bi) { const size_t row = R0 + 32 * bi + r; const float rs = RSTD[32 * bi + r];
#pragma unroll
        for (int g4 = 0; g4 < 4; ++g4) { const int dv0 = 32 * w + 8 * g4 + 4 * hl;
            const v2u gt = gtv[bi][g4]; const f32x4 hg = hgv[g4];
            v2u o; o.x = pk2(acc[bi][4 * g4] * rs * hg[0] * silu_f(bflo(gt.x)), acc[bi][4 * g4 + 1] * rs * hg[1] * silu_f(bfhi(gt.x)));
            o.y = pk2(acc[bi][4 * g4 + 2] * rs * hg[2] * silu_f(bflo(gt.y)), acc[bi][4 * g4 + 3] * rs * hg[3] * silu_f(bfhi(gt.y)));
            *(v2u*)(mix + row * DM + 256 * h + dv0) = o; } }
}
__device__ __forceinline__ void phase_gla_c(const Args& a, LAS unsigned char* lds, int tid, int G) {
    for (int unit = blockIdx.x; unit < 512; unit += G) gla_pass_c(a, lds, unit, tid);
}
__device__ __forceinline__ void phase_final_norm(const Args& a, int tid, int G) {
    const int lane = tid & 63, wave = tid >> 6; const int gw = blockIdx.x * NWAVES + wave, NGW = G * NWAVES;
    const float* part2 = (const float*)(a.ws + WS_PART2);
    for (int m = gw; m < MROWS; m += NGW) {
        float s = (lane < 32) ? part2[(size_t)m * 32 + lane] : 0.f; s = wave_sum(s);
        const float r = rsqrtf(s * (1.0f / DM) + EPS);
        f32x4* xr = (f32x4*)(a.out + (size_t)m * DM) + lane; const f32x4* gr = (const f32x4*)a.final_g + lane;
#pragma unroll
        for (int j = 0; j < 8; ++j) { f32x4 v = xr[64 * j]; const f32x4 g = gr[64 * j]; v[0] *= r * g[0]; v[1] *= r * g[1]; v[2] *= r * g[2]; v[3] *= r * g[3]; xr[64 * j] = v; }
    }
}

constexpr int NPHASE = 11;
__global__ void __launch_bounds__(NTHR, 2) trunk_fwd(Args a) {
    extern __shared__ __attribute__((aligned(16))) unsigned char lds_raw[];
    LAS unsigned char* lds = (LAS unsigned char*)lds_raw;
    cg::grid_group grid = cg::this_grid();
    const int tid = threadIdx.x, G = gridDim.x;
    const int lo = a.ph_lo, hi = a.ph_hi;
#define IN(k) (lo <= (k) && (k) < hi)
#define SEAM(k) do { if (IN(k) && IN((k) + 1)) { if (hi > 1000) grid.sync();   xcd_barrier(bar); } } while (0)
    unsigned char* ws = a.ws;
    volatile LAS unsigned* bst = (volatile LAS unsigned*)(lds + LDS_BYTES - 16);
    if (tid < 4) bst[tid] = 0u;
    __syncthreads();
    XcdBarrier bar; bar.bar = (unsigned*)(ws + WS_BAR); bar.x = 0; bar.st = bst;
    if (hi - lo > 1) bar = xcd_barrier_post((unsigned*)(ws + WS_BAR), bst);
    if (IN(0)) { phase_prologue(a, lds, tid, G); } SEAM(0);
    if (IN(1)) {
        pg8::Gemm g{(const pg8::bf16_t*)(ws + WS_XB), (const pg8::bf16_t*)(ws + WS_WIN), MROWS, NP, DM}; pg8::StaticOrder S; S.init(MROWS, NP, G, (int)blockIdx.x);
        pg8::EpiScaleBf16 E{(pg8::bf16_t*)(ws + WS_P), NP, (const float*)(ws + WS_RSTD0), nullptr, C_SMALL / 256, (float*)(ws + WS_SMALL), (float*)(ws + WS_BAR + 20480), C_FQ / 256};
        pg8::gemm_phase<pg8::EpiScaleBf16, pg8::StaticOrder, true, true>(lds, g, S, E);
        { const int nwg = (MROWS / 256) * (NP / 256), rem = nwg % G, first = rem, nidle = G - first;
          if ((int)blockIdx.x >= first) { __syncthreads(); prologue_late(a, lds, tid, (int)blockIdx.x - first, nidle); } }
    } SEAM(1);
    if (IN(3)) { phase_m1(a, lds, tid, G); } SEAM(3);
    if (IN(4)) { phase_m2(a, lds_raw, tid, G); } SEAM(4);
    if (IN(5)) { phase_gla_c(a, lds, tid, G); } SEAM(5);
    if (IN(6)) {
        pg8::Gemm g{(const pg8::bf16_t*)(ws + WS_MIX), (const pg8::bf16_t*)(ws + WS_WOUT), MROWS, DM, DM}; pg8::StaticOrder S; S.init(MROWS, DM, G, (int)blockIdx.x);
        pg8::EpiResid E{a.x, nullptr, (pg8::bf16_t*)(ws + WS_X1), (float*)(ws + WS_PART1), DM};
        pg8::gemm_phase<pg8::EpiResid, pg8::StaticOrder, true, true>(lds, g, S, E);
    } SEAM(6);
    if (IN(7)) {
        pg8::Gemm g{(const pg8::bf16_t*)(ws + WS_X1), (const pg8::bf16_t*)(ws + WS_WCIN), MROWS, 4096, DM}; pg8::StaticOrder S; S.init(MROWS, 4096, G, (int)blockIdx.x);
        pg8::EpiScaleBf16 E{(pg8::bf16_t*)(ws + WS_UG), 4096, nullptr, (const float*)(ws + WS_PART1), -1, nullptr, nullptr, 0};
        pg8::gemm_phase<pg8::EpiScaleBf16, pg8::StaticOrder, true, true>(lds, g, S, E);
    } SEAM(7);
    if (IN(8)) { phase_s5(a, lds, tid); } SEAM(8);
    if (IN(9)) {
        pg8::Gemm g{(const pg8::bf16_t*)(ws + WS_ZB), (const pg8::bf16_t*)(ws + WS_WGLU), MROWS, DM, DM}; pg8::StaticOrder S; S.init(MROWS, DM, G, (int)blockIdx.x);
        pg8::EpiGlu E{(const pg8::bf16_t*)(ws + WS_ZB), (const pg8::bf16_t*)(ws + WS_UG), a.glu_b, (pg8::bf16_t*)(ws + WS_TB)};
        pg8::gemm_phase<pg8::EpiGlu, pg8::StaticOrder, true, true>(lds, g, S, E);
    } SEAM(9);
    if (IN(10)) {
        pg8::Gemm g{(const pg8::bf16_t*)(ws + WS_TB), (const pg8::bf16_t*)(ws + WS_WCOUT), MROWS, DM, DM}; pg8::StaticOrder S; S.init(MROWS, DM, G, (int)blockIdx.x);
        pg8::EpiFinalNorm E{(const pg8::bf16_t*)(ws + WS_X1), a.out, (float*)(ws + WS_PART2), (unsigned*)(ws + WS_BAR + 16384), a.final_g, DM};
        pg8::gemm_phase<pg8::EpiFinalNorm, pg8::StaticOrder, false, true>(lds, g, S, E);
    }
#undef IN
#undef SEAM
}

#ifndef MK_ONE_LAUNCH
#define MK_ONE_LAUNCH 1
#endif
extern "C" void kernel_launch(void* const* d_in, const int* in_sizes, int n_in, void* d_out, int out_size, void* d_ws, size_t ws_size, hipStream_t stream) {
    static int grid = 0;
    if (grid == 0) {
        int dev = 0, cus = 0, per_cu = 0;
        if (hipGetDevice(&dev) != hipSuccess || hipDeviceGetAttribute(&cus, hipDeviceAttributeMultiprocessorCount, dev) != hipSuccess) { fprintf(stderr, "kernel_launch: device query failed\n"); grid = -1; return; }
        if (hipFuncSetAttribute((const void*)trunk_fwd, hipFuncAttributeMaxDynamicSharedMemorySize, LDS_BYTES) != hipSuccess) { fprintf(stderr, "kernel_launch: hipFuncSetAttribute failed\n"); grid = -1; return; }
        if (hipOccupancyMaxActiveBlocksPerMultiprocessor(&per_cu, (const void*)trunk_fwd, NTHR, LDS_BYTES) != hipSuccess || per_cu < 1) { fprintf(stderr, "kernel_launch: occupancy query says %d\n", per_cu); per_cu = 1; }
        (void)hipGetLastError();
        grid = cus;
        if (ws_size < 256 * MiB) { fprintf(stderr, "kernel_launch: workspace too small (%zu)\n", ws_size); grid = -1; return; }
    }
    if (grid < 0) return;
    if (hipMemsetAsync((char*)d_ws + WS_BAR, 0, 24576, stream) != hipSuccess) { fprintf(stderr, "kernel_launch: memset of barrier words failed\n"); return; }
    Args a{};
    const float** ap = (const float**)&a;
    for (int i = 0; i < 22; ++i) ap[i] = (const float*)d_in[i];
    a.out = (float*)d_out; a.ws = (unsigned char*)d_ws;
#if MK_ONE_LAUNCH
    a.ph_lo = 0; a.ph_hi = NPHASE;
    void* args[] = {&a};
    hipError_t e = hipLaunchCooperativeKernel((const void*)trunk_fwd, dim3(grid), dim3(NTHR), args, LDS_BYTES, stream);
    if (e != hipSuccess) fprintf(stderr, "cooperative launch failed: %s (grid %d)\n", hipGetErrorString(e), grid);
#else
    for (int p = 0; p < NPHASE; ++p) { a.ph_lo = p; a.ph_hi = p + 1; hipLaunchKernelGGL(trunk_fwd, dim3(grid), dim3(NTHR), LDS_BYTES, stream, a); }
#endif
}
```

```cpp
#include <hip/hip_runtime.h>
#include <hip/hip_cooperative_groups.h>
#include <cstdio>
#include <cstdint>
namespace cg = cooperative_groups;
namespace pg8 {
#define PG8_LAS __attribute__((address_space(3)))
typedef unsigned short bf16_t;
typedef short bf16x8 __attribute__((ext_vector_type(8)));
typedef float f32x4 __attribute__((ext_vector_type(4)));
typedef unsigned u32x4 __attribute__((ext_vector_type(4)));
constexpr int BM = 256, BK = 64, HALF = 128, HTB = HALF * BK * 2  , STAGE_BYTES = 8 * HTB, NXCD = 8, WGM = 8;

__host__ __device__ __forceinline__ int lds_byte(int r, int c) { const int st = (r >> 4) * 2 + (c >> 5), rr = r & 15, cc = c & 31, ob = rr * 64 + cc * 2; return st * 1024 + (ob ^ (((ob >> 9) & 1) << 5)); }
__host__ __device__ __forceinline__ void stage_rc(int b, int& R, int& C) { const int st = b / 1024, sb = b % 1024, swz = sb ^ (((sb >> 9) & 1) << 5); R = (st >> 1) * 16 + swz / 64; C = (st & 1) * 32 + (swz % 64) / 2; }
__host__ __device__ __forceinline__ int perm32(int rho) { const int n = rho >> 4, i = rho & 15; return 8 * (i >> 2) + 4 * n + (i & 3); }

struct Unit { int pm, pn; };
struct Gemm { const bf16_t* A; const bf16_t* Bt; int M, N, K; };

struct StaticOrder {
    int nM, nN, nwg, G, c;
    __host__ __device__ void init(int M, int N, int G_, int c_) { nM = M / BM; nN = N / BM; nwg = nM * nN; G = G_; c = c_; }
    __host__ __device__ bool next(int i, Unit& u) const {
        const long L = (long)i * G + c; if (L >= nwg) return false;
        int wgid = (int)L; { const int q = nwg / NXCD, r = nwg % NXCD, xcd = wgid % NXCD, off = wgid / NXCD; wgid = (xcd < r ? xcd * (q + 1) : r * (q + 1) + (xcd - r) * q) + off; }
        const int nig = WGM * nN, gid = wgid / nig, fm = gid * WGM, gsz = (nM - fm) < WGM ? (nM - fm) : WGM;
        u.pm = fm + ((wgid % nig) % gsz); u.pn = (wgid % nig) / gsz; return true;
    }
    __device__ __forceinline__ void a_ready(const Unit&) const {}
    __device__ __forceinline__ void done(const Unit&) const {}
};

__device__ __forceinline__ unsigned cvt_pk_bf16(float lo, float hi) { unsigned r; asm volatile("v_cvt_pk_bf16_f32 %0, %1, %2" : "=v"(r) : "v"(lo), "v"(hi)); return r; }
typedef float f32x2 __attribute__((ext_vector_type(2)));
__device__ __forceinline__ float sigmoid_f(float x) { return __builtin_amdgcn_rcpf(1.0f + __expf(-x)); }
__device__ __forceinline__ float silu_f(float x) { return x * __builtin_amdgcn_rcpf(1.0f + __expf(-x)); }
__device__ __forceinline__ float bf2f(unsigned short b) { return __uint_as_float(((unsigned)b) << 16); }
struct EpiScaleBf16 {
    static constexpr bool PERM = true, AFTER_DRAIN = false;
    bf16_t* O; int ldc; const float* rstd; const float* part; int small_pn; float* smallbuf; float* nmax; int q_pn0;
    __device__ __forceinline__ void operator()(const f32x4 (&acc)[2][2][4][2], const Unit& u, int wr, int wc, int fr, int fq) const {
        const int row0 = u.pm * BM + wr * 64 + fr, col0 = u.pn * BM + wc * 32 + 8 * fq;
        const bool nrm = nmax != nullptr && u.pn >= q_pn0 && u.pn < q_pn0 + 8; float rmx[2] = {0.f, 0.f};
#pragma unroll
        for (int ai = 0; ai < 2; ++ai)
#pragma unroll
            for (int m = 0; m < 4; ++m) {
                const int row = row0 + ai * HALF + m * 16; float s;
                if (rstd) s = rstd[row];
                else { const f32x4 a = *(const f32x4*)(part + (size_t)row * 32 + 8 * fq), b = *(const f32x4*)(part + (size_t)row * 32 + 8 * fq + 4);
                    float t = ((a[0] + a[1]) + (a[2] + a[3])) + ((b[0] + b[1]) + (b[2] + b[3])); t += __shfl_xor(t, 16); t += __shfl_xor(t, 32); s = rsqrtf(t * (1.0f / 2048.0f) + 1e-6f); }
                bf16_t* rowp = O + (size_t)row * ldc + col0;
#pragma unroll
                for (int bj = 0; bj < 2; ++bj) { const f32x4 v0 = acc[ai][bj][m][0] * s, v1 = acc[ai][bj][m][1] * s;
                    u32x4 w; w.x = cvt_pk_bf16(v0[0], v0[1]); w.y = cvt_pk_bf16(v0[2], v0[3]); w.z = cvt_pk_bf16(v1[0], v1[1]); w.w = cvt_pk_bf16(v1[2], v1[3]);
                    *(u32x4*)(rowp + bj * HALF) = w;
                    if (nrm) { float ss = ((v0[0] * v0[0] + v0[1] * v0[1]) + (v0[2] * v0[2] + v0[3] * v0[3])) + ((v1[0] * v1[0] + v1[1] * v1[1]) + (v1[2] * v1[2] + v1[3] * v1[3])); ss += __shfl_xor(ss, 16); ss += __shfl_xor(ss, 32); rmx[bj] = fmaxf(rmx[bj], ss); }
                    if (u.pn == small_pn && bj == 0 && wc == 0) { *(f32x4*)(smallbuf + (size_t)row * 32 + 8 * fq) = v0; *(f32x4*)(smallbuf + (size_t)row * 32 + 8 * fq + 4) = v1; } }
            }
        if (nrm) { const int t = u.pn - q_pn0;
#pragma unroll
            for (int bj = 0; bj < 2; ++bj) { float r = rmx[bj]; r = fmaxf(r, __shfl_xor(r, 1)); r = fmaxf(r, __shfl_xor(r, 2)); r = fmaxf(r, __shfl_xor(r, 4)); r = fmaxf(r, __shfl_xor(r, 8));
                if (fr == 0 && fq == 0) __hip_atomic_fetch_max((unsigned*)nmax + ((((u.pm >> 4) * 8 + 2 * (t & 3) + bj) * 2 + (t >> 2)) * 4 + wc), __float_as_uint(r), __ATOMIC_RELAXED, __HIP_MEMORY_SCOPE_AGENT); } }
    }
};
struct EpiResid {
    static constexpr bool PERM = true, AFTER_DRAIN = false;
    const float* base; float* out; bf16_t* outb; float* part; int ldc;
    __device__ __forceinline__ void operator()(const f32x4 (&acc)[2][2][4][2], const Unit& u, int wr, int wc, int fr, int fq) const {
        const int row0 = u.pm * BM + wr * 64 + fr, col0 = u.pn * BM + wc * 32 + 8 * fq;
#pragma unroll
        for (int ai = 0; ai < 2; ++ai)
#pragma unroll
            for (int m = 0; m < 4; ++m) {
                const int row = row0 + ai * HALF + m * 16; const size_t off = (size_t)row * ldc + col0; float ss = 0.f;
#pragma unroll
                for (int bj = 0; bj < 2; ++bj) { const size_t o = off + bj * HALF;
                    const f32x4 v0 = acc[ai][bj][m][0] + __builtin_nontemporal_load((const f32x4*)(base + o)), v1 = acc[ai][bj][m][1] + __builtin_nontemporal_load((const f32x4*)(base + o + 4));
                    if (out) { *(f32x4*)(out + o) = v0; *(f32x4*)(out + o + 4) = v1; }
                    ss += ((v0[0] * v0[0] + v0[1] * v0[1]) + (v0[2] * v0[2] + v0[3] * v0[3])) + ((v1[0] * v1[0] + v1[1] * v1[1]) + (v1[2] * v1[2] + v1[3] * v1[3]));
                    if (outb) { u32x4 w; w.x = cvt_pk_bf16(v0[0], v0[1]); w.y = cvt_pk_bf16(v0[2], v0[3]); w.z = cvt_pk_bf16(v1[0], v1[1]); w.w = cvt_pk_bf16(v1[2], v1[3]); *(u32x4*)(outb + o) = w; } }
                ss += __shfl_xor(ss, 16); ss += __shfl_xor(ss, 32);
                if (fq == 0) part[(size_t)row * 32 + u.pn * 4 + wc] = ss;
            }
    }
};
struct EpiGlu {
    static constexpr bool PERM = true, AFTER_DRAIN = false;
    const bf16_t* zb; const bf16_t* ug; const float* bias; bf16_t* tb;
    __device__ __forceinline__ void operator()(const f32x4 (&acc)[2][2][4][2], const Unit& u, int wr, int wc, int fr, int fq) const {
        const int row0 = u.pm * BM + wr * 64 + fr, col0 = u.pn * BM + wc * 32 + 8 * fq;
#pragma unroll
        for (int ai = 0; ai < 2; ++ai)
#pragma unroll
            for (int m = 0; m < 4; ++m) {
                const int row = row0 + ai * HALF + m * 16;
#pragma unroll
                for (int bj = 0; bj < 2; ++bj) { const int col = col0 + bj * HALF;
                    const f32x4 b0 = *(const f32x4*)(bias + col), b1 = *(const f32x4*)(bias + col + 4);
                    const u32x4 zz = __builtin_nontemporal_load((const u32x4*)(zb + (size_t)row * 2048 + col)), gg = __builtin_nontemporal_load((const u32x4*)(ug + (size_t)row * 4096 + 2048 + col));
                    float r[8];
#pragma unroll
                    for (int e = 0; e < 8; ++e) { const float a = (e < 4 ? acc[ai][bj][m][0][e] : acc[ai][bj][m][1][e - 4]) + (e < 4 ? b0[e] : b1[e - 4]);
                        const unsigned zw = zz[e >> 1], gw = gg[e >> 1];
                        const float z = (e & 1) ? __uint_as_float(zw & 0xffff0000u) : __uint_as_float(zw << 16), g = (e & 1) ? __uint_as_float(gw & 0xffff0000u) : __uint_as_float(gw << 16);
                        r[e] = z * sigmoid_f(a) * silu_f(g); }
                    u32x4 w; w.x = cvt_pk_bf16(r[0], r[1]); w.y = cvt_pk_bf16(r[2], r[3]); w.z = cvt_pk_bf16(r[4], r[5]); w.w = cvt_pk_bf16(r[6], r[7]);
                    *(u32x4*)(tb + (size_t)row * 2048 + col) = w; }
            }
    }
};

struct EpiFinalNorm {
    static constexpr bool PERM = true, AFTER_DRAIN = true;
    const bf16_t* base; float* out; float* part; unsigned* cnt; const float* g; int ldc;
    __device__ __forceinline__ void fused(f32x4 (&acc)[2][2][4][2], const Unit& u, int wr, int wc, int fr, int fq, PG8_LAS unsigned char* lds, int wid, int lane) const {
        const int row0 = u.pm * BM + wr * 64 + fr, col0 = u.pn * BM + wc * 32 + 8 * fq;
#pragma unroll
        for (int ai = 0; ai < 2; ++ai)
#pragma unroll
            for (int m = 0; m < 4; ++m) { const int row = row0 + ai * HALF + m * 16; const size_t off = (size_t)row * ldc + col0; float ss = 0.f;
#pragma unroll
                for (int bj = 0; bj < 2; ++bj) { const u32x4 bw = __builtin_nontemporal_load((const u32x4*)(base + off + bj * HALF));
                    const f32x4 b0 = {__uint_as_float(bw.x << 16), __uint_as_float(bw.x & 0xffff0000u), __uint_as_float(bw.y << 16), __uint_as_float(bw.y & 0xffff0000u)};
                    const f32x4 b1 = {__uint_as_float(bw.z << 16), __uint_as_float(bw.z & 0xffff0000u), __uint_as_float(bw.w << 16), __uint_as_float(bw.w & 0xffff0000u)};
                    const f32x4 v0 = acc[ai][bj][m][0] + b0, v1 = acc[ai][bj][m][1] + b1; acc[ai][bj][m][0] = v0; acc[ai][bj][m][1] = v1;
                    ss += ((v0[0] * v0[0] + v0[1] * v0[1]) + (v0[2] * v0[2] + v0[3] * v0[3])) + ((v1[0] * v1[0] + v1[1] * v1[1]) + (v1[2] * v1[2] + v1[3] * v1[3])); }
                ss += __shfl_xor(ss, 16); ss += __shfl_xor(ss, 32);
                if (fq == 0) __hip_atomic_store((unsigned*)part + (size_t)row * 32 + u.pn * 4 + wc, __float_as_uint(ss), __ATOMIC_RELAXED, __HIP_MEMORY_SCOPE_AGENT); }
        asm volatile("s_waitcnt vmcnt(0)" ::: "memory");
        unsigned* c = cnt + 16 * u.pm;
        if (lane == 0) __hip_atomic_fetch_add(c, 1u, __ATOMIC_RELAXED, __HIP_MEMORY_SCOPE_AGENT);
        { unsigned sp = 0; while ((unsigned)__builtin_amdgcn_readfirstlane(__hip_atomic_load(c, __ATOMIC_RELAXED, __HIP_MEMORY_SCOPE_AGENT)) < 64u) { __builtin_amdgcn_s_sleep(2); if (++sp > (1u << 20)) break; } }
        asm volatile("" ::: "memory");
        f32x4 gv[2][2];
#pragma unroll
        for (int bj = 0; bj < 2; ++bj)
#pragma unroll
            for (int n = 0; n < 2; ++n) gv[bj][n] = *(const f32x4*)(g + col0 + bj * HALF + 4 * n);
#pragma unroll
        for (int ai = 0; ai < 2; ++ai)
#pragma unroll
            for (int m = 0; m < 4; ++m) { const int row = row0 + ai * HALF + m * 16; const size_t off = (size_t)row * ldc + col0;
                const unsigned long long* pp = (const unsigned long long*)part + (size_t)row * 16 + 4 * fq; float t = 0.f;
#pragma unroll
                for (int q = 0; q < 4; ++q) { const unsigned long long w2 = __hip_atomic_load(pp + q, __ATOMIC_RELAXED, __HIP_MEMORY_SCOPE_AGENT); t += __uint_as_float((unsigned)w2) + __uint_as_float((unsigned)(w2 >> 32)); }
                t += __shfl_xor(t, 16); t += __shfl_xor(t, 32);
                const float s = rsqrtf(t * (1.0f / 2048.0f) + 1e-6f);
#pragma unroll
                for (int bj = 0; bj < 2; ++bj)
#pragma unroll
                    for (int n = 0; n < 2; ++n) __builtin_nontemporal_store(acc[ai][bj][m][n] * s * gv[bj][n], (f32x4*)(out + off + bj * HALF + 4 * n)); }
    }
};
template <class Epi, class Sched, bool ALIGN_EPI = false, bool SP2 = false>
__device__ __forceinline__ void gemm_phase(PG8_LAS unsigned char* lds, const Gemm g, const Sched& S, const Epi& E) {
    const int tid = threadIdx.x, wid = __builtin_amdgcn_readfirstlane(tid >> 6), lane = tid & 63, wr = wid >> 2, wc = wid & 3, fr = lane & 15, fq = lane >> 4;
    const int K = g.K, nt = K / BK;
    unsigned voffA[2], voffB[2];
#pragma unroll
    for (int i = 0; i < 2; ++i) { int R, C; stage_rc(tid * 16 + i * 8192, R, C); const int Rb = Epi::PERM ? ((R & ~31) + perm32(R & 31)) : R;
        voffA[i] = (unsigned)(R * K + C) * 2u; voffB[i] = (unsigned)(Rb * K + C) * 2u; }
    const size_t kstep = (size_t)(BK * 2);
    const size_t hstep = (size_t)HALF * K * 2;
    const size_t tstep = 2 * hstep;
    const unsigned ldsw = (unsigned)wid * 1024u;
    const int aoff = lds_byte(wr * 64 + fr, fq * 8), boff = lds_byte(wc * 32 + fr, fq * 8);
#define PG8_SA(b, h) (((b) * 2 + (h)) * HTB)
#define PG8_SB(b, h) ((4 + (b) * 2 + (h)) * HTB)
#define PG8_STAGE(bufoff, gbase, voff) do { _Pragma("unroll") for (int _i = 0; _i < 2; ++_i) \
        __builtin_amdgcn_global_load_lds((const unsigned*)((const char*)(gbase) + (voff)[_i]), (PG8_LAS unsigned*)(lds + (bufoff) + ldsw + _i * 8192), 16, 0, 0); } while (0)
#define PG8_LDA(dst, b, h) do { _Pragma("unroll") for (int m = 0; m < 4; ++m) _Pragma("unroll") for (int k = 0; k < 2; ++k) dst[m][k] = *(const PG8_LAS bf16x8*)(lds + PG8_SA(b, h) + aoff + m * 2048 + k * 1024); } while (0)
#define PG8_LDB(dst, b, h) do { _Pragma("unroll") for (int n = 0; n < 2; ++n) _Pragma("unroll") for (int k = 0; k < 2; ++k) dst[n][k] = *(const PG8_LAS bf16x8*)(lds + PG8_SB(b, h) + boff + n * 2048 + k * 1024); } while (0)
#define PG8_MMA(ai, bj, At, Bt) do { __builtin_amdgcn_s_setprio(1); _Pragma("unroll") for (int m = 0; m < 4; ++m) _Pragma("unroll") for (int n = 0; n < 2; ++n) _Pragma("unroll") for (int k = 0; k < 2; ++k) \
        acc[ai][bj][m][n] = __builtin_amdgcn_mfma_f32_16x16x32_bf16(Bt[n][k], At[m][k], acc[ai][bj][m][n], 0, 0, 0); __builtin_amdgcn_s_setprio(0); } while (0)
#define PG8_WAIT_V(n) asm volatile("s_waitcnt vmcnt(" #n ")" ::: "memory")
#define PG8_WAIT_L(n) asm volatile("s_waitcnt lgkmcnt(" #n ")" ::: "memory")
#define PG8_BAR __builtin_amdgcn_s_barrier()
#define PG8_SCHED __builtin_amdgcn_sched_barrier(0)
    Unit cur, nxt; int ui = 0;
    if (!S.next(0, cur)) return;
    f32x4 acc[2][2][4][2];
#pragma unroll
    for (int a = 0; a < 2; ++a)
#pragma unroll
        for (int b = 0; b < 2; ++b)
#pragma unroll
            for (int m = 0; m < 4; ++m)
#pragma unroll
                for (int n = 0; n < 2; ++n) acc[a][b][m][n] = (f32x4){0.f, 0.f, 0.f, 0.f};
    bf16x8 At[4][2], B0[2][2], B1[2][2];
    const char* cA = (const char*)g.A + (size_t)cur.pm * tstep; const char* cB = (const char*)g.Bt + (size_t)cur.pn * tstep;
    S.a_ready(cur);
    if constexpr (SP2) {
        PG8_STAGE(PG8_SB(0, 0), cB, voffB); PG8_STAGE(PG8_SB(0, 1), cB + hstep, voffB); PG8_STAGE(PG8_SA(0, 0), cA, voffA); PG8_STAGE(PG8_SA(0, 1), cA + hstep, voffA);
        if (wr == 1) PG8_BAR;
        PG8_WAIT_V(2); PG8_BAR;
        PG8_STAGE(PG8_SB(1, 0), cB + kstep, voffB); PG8_STAGE(PG8_SA(1, 0), cA + kstep, voffA); PG8_STAGE(PG8_SB(1, 1), cB + hstep + kstep, voffB);
        PG8_WAIT_V(6); PG8_BAR;
    } else {
        PG8_STAGE(PG8_SB(0, 0), cB, voffB); PG8_STAGE(PG8_SA(0, 0), cA, voffA); PG8_STAGE(PG8_SB(0, 1), cB + hstep, voffB); PG8_STAGE(PG8_SA(0, 1), cA + hstep, voffA);
        if (wr == 1) PG8_BAR;
        PG8_WAIT_V(4); PG8_BAR;
        PG8_STAGE(PG8_SB(1, 0), cB + kstep, voffB); PG8_STAGE(PG8_SA(1, 0), cA + kstep, voffA); PG8_STAGE(PG8_SB(1, 1), cB + hstep + kstep, voffB);
        PG8_WAIT_V(6); PG8_BAR;
    }
    for (;;) {
        const bool has_next = S.next(ui + 1, nxt);
        const char* nA = has_next ? (const char*)g.A + (size_t)nxt.pm * tstep : cA; const char* nB = has_next ? (const char*)g.Bt + (size_t)nxt.pn * tstep : cB;
        for (int t = 0; t < nt; t += 2) {
            const bool last = (t == nt - 2);
            const char* a1 = cA + (size_t)(t + 1) * kstep;
            const char* a2 = last ? nA : cA + (size_t)(t + 2) * kstep; const char* b2 = last ? nB : cB + (size_t)(t + 2) * kstep;
            const char* a3 = a2 + kstep; const char* b3 = b2 + kstep;
            if (last && has_next) S.a_ready(nxt);
            if constexpr (SP2) {
            PG8_LDB(B0, 0, 0); PG8_LDB(B1, 0, 1); PG8_SCHED; PG8_LDA(At, 0, 0); PG8_STAGE(PG8_SA(1, 1), a1 + hstep, voffA);
            PG8_WAIT_V(8); PG8_WAIT_L(0); PG8_BAR; PG8_MMA(0, 0, At, B0); PG8_MMA(0, 1, At, B1); PG8_BAR; PG8_SCHED;
            PG8_LDA(At, 0, 1); PG8_STAGE(PG8_SB(0, 0), b2, voffB); PG8_STAGE(PG8_SB(0, 1), b2 + hstep, voffB); PG8_STAGE(PG8_SA(0, 0), a2, voffA);
            PG8_WAIT_V(8); PG8_WAIT_L(0); PG8_BAR; PG8_MMA(1, 0, At, B0); PG8_MMA(1, 1, At, B1); PG8_BAR; PG8_SCHED;
            PG8_LDB(B0, 1, 0); PG8_LDB(B1, 1, 1); PG8_SCHED; PG8_LDA(At, 1, 0); PG8_STAGE(PG8_SA(0, 1), a2 + hstep, voffA);
            PG8_WAIT_V(8); PG8_WAIT_L(0); PG8_BAR; PG8_MMA(0, 0, At, B0); PG8_MMA(0, 1, At, B1); PG8_BAR; PG8_SCHED;
            PG8_LDA(At, 1, 1); PG8_STAGE(PG8_SB(1, 0), b3, voffB); PG8_STAGE(PG8_SB(1, 1), b3 + hstep, voffB); PG8_STAGE(PG8_SA(1, 0), a3, voffA);
            PG8_WAIT_V(8); PG8_WAIT_L(0); PG8_BAR; PG8_MMA(1, 0, At, B0); PG8_MMA(1, 1, At, B1); PG8_BAR; PG8_SCHED;
            } else {
            PG8_LDB(B0, 0, 0); PG8_SCHED; PG8_LDA(At, 0, 0); PG8_STAGE(PG8_SA(1, 1), a1 + hstep, voffA);
            PG8_WAIT_L(8); PG8_BAR; PG8_WAIT_L(0); PG8_MMA(0, 0, At, B0); PG8_BAR; PG8_SCHED;
            PG8_LDB(B1, 0, 1); PG8_STAGE(PG8_SB(0, 0), b2, voffB);
            PG8_BAR; PG8_WAIT_L(0); PG8_MMA(0, 1, At, B1); PG8_BAR;
            PG8_LDA(At, 0, 1); PG8_STAGE(PG8_SA(0, 0), a2, voffA);
            PG8_BAR; PG8_WAIT_L(0); PG8_MMA(1, 0, At, B0); PG8_BAR; PG8_SCHED;
            PG8_STAGE(PG8_SB(0, 1), b2 + hstep, voffB);
            PG8_WAIT_V(6); PG8_BAR; PG8_MMA(1, 1, At, B1); PG8_BAR;
            PG8_LDB(B0, 1, 0); PG8_SCHED; PG8_LDA(At, 1, 0); PG8_STAGE(PG8_SA(0, 1), a2 + hstep, voffA);
            PG8_WAIT_L(8); PG8_BAR; PG8_WAIT_L(0); PG8_MMA(0, 0, At, B0); PG8_BAR; PG8_SCHED;
            PG8_LDB(B1, 1, 1); PG8_STAGE(PG8_SB(1, 0), b3, voffB);
            PG8_BAR; PG8_WAIT_L(0); PG8_MMA(0, 1, At, B1); PG8_BAR;
            PG8_LDA(At, 1, 1); PG8_STAGE(PG8_SA(1, 0), a3, voffA);
            PG8_BAR; PG8_WAIT_L(0); PG8_MMA(1, 0, At, B0); PG8_BAR; PG8_SCHED;
            PG8_STAGE(PG8_SB(1, 1), b3 + hstep, voffB);
            PG8_WAIT_V(6); PG8_BAR; PG8_MMA(1, 1, At, B1); PG8_BAR;
            }
        }
        if constexpr (ALIGN_EPI) { if (wr == 0) PG8_BAR; }
        if constexpr (!Epi::AFTER_DRAIN) { E(acc, cur, wr, wc, fr, fq); S.done(cur); }
        if (!has_next) break;
#pragma unroll
        for (int a = 0; a < 2; ++a)
#pragma unroll
            for (int b = 0; b < 2; ++b)
#pragma unroll
                for (int m = 0; m < 4; ++m)
#pragma unroll
                    for (int n = 0; n < 2; ++n) acc[a][b][m][n] = (f32x4){0.f, 0.f, 0.f, 0.f};
        cur = nxt; cA = nA; cB = nB; ++ui;
        if constexpr (ALIGN_EPI) { if (wr == 1) PG8_BAR; }
    }
    PG8_WAIT_V(0);
    if constexpr (!ALIGN_EPI) { if (wr == 0) PG8_BAR; }
    PG8_BAR;
    if constexpr (Epi::AFTER_DRAIN) { E.fused(acc, cur, wr, wc, fr, fq, lds, wid, lane); S.done(cur); }
#undef PG8_SA
#undef PG8_SB
#undef PG8_STAGE
#undef PG8_LDA
#undef PG8_LDB
#undef PG8_MMA
#undef PG8_WAIT_V
#undef PG8_WAIT_L
#undef PG8_BAR
#undef PG8_SCHED
}
}
#define LAS __attribute__((address_space(3)))
typedef unsigned short bf16;
typedef float f32x4 __attribute__((ext_vector_type(4)));
typedef unsigned v4u __attribute__((ext_vector_type(4)));
typedef unsigned v2u __attribute__((ext_vector_type(2)));
constexpr int NWAVES = 8, NTHR = 512;
constexpr int BATCH = 2, SEQ = 4096, DM = 2048, MROWS = BATCH * SEQ;
constexpr int NP = 7424;
constexpr int C_GQ = 0, C_GK = 512, C_GV = 1024, C_GG = 2048, C_FQ = 3072, C_FK = 4096, C_FV = 5120, C_FG = 6144, C_SMALL = 7168;
constexpr int AB_IN = 7192;
constexpr float EPS = 1e-6f;
constexpr size_t MiB = 1u << 20;
constexpr size_t WS_RSTD0 = 0, WS_PART1 = 64 * 1024, WS_PART2 = WS_PART1 + MiB, WS_CFOX = 2 * MiB + 512 * 1024, WS_SMALL = 3 * MiB  ;
constexpr size_t WS_WGLU = 4 * MiB, WS_WCOUT = 12 * MiB, WS_WCIN = 20 * MiB, WS_WOUT = 36 * MiB, WS_WIN = 44 * MiB;
constexpr size_t WS_XB = 73 * MiB, WS_MIX = 73 * MiB, WS_ZB = 73 * MiB;
constexpr size_t WS_P = 105 * MiB, WS_X1 = 105 * MiB, WS_UG = 169 * MiB;
constexpr size_t WS_ORAW = 221 * MiB;
constexpr size_t WS_TB = 20 * MiB;
constexpr int LDS_BYTES = 163840;

struct Args {
    const float* x; const float* ab_norm_g; const float* ab_w_in; const float* alpha_up; const float* alpha_b; const float* head_g; const float* fox_f_b; const float* ab_w_out;
    const float* c_norm_g; const float* c_w_in; const float* lam_re; const float* lam_im; const float* log_step; const float* b_re; const float* b_im; const float* c_re; const float* c_im;
    const float* s5_d; const float* glu_w; const float* glu_b; const float* c_w_out; const float* final_g;
    float* out; unsigned char* ws; int ph_lo, ph_hi;
};

typedef float cv_f32x2 __attribute__((ext_vector_type(2))); typedef __bf16 cv_bf16x2 __attribute__((ext_vector_type(2)));
__device__ __forceinline__ unsigned pk2(float lo, float hi) { cv_f32x2 v = {lo, hi}; cv_bf16x2 b = __builtin_convertvector(v, cv_bf16x2); return __builtin_bit_cast(unsigned, b); }
__device__ __forceinline__ unsigned f2bf(float f) { return pk2(f, f) & 0xffffu; }
__device__ __forceinline__ float bflo(unsigned w) { return __uint_as_float(w << 16); }
__device__ __forceinline__ float bfhi(unsigned w) { return __uint_as_float(w & 0xffff0000u); }
__device__ __forceinline__ float bf2f(bf16 b) { return __uint_as_float(((unsigned)b) << 16); }
__device__ __forceinline__ float wave_sum(float v) {
#pragma unroll
    for (int o = 1; o < 64; o <<= 1) v += __shfl_xor(v, o);
    return v;
}
__device__ __forceinline__ float silu_f(float x) { return x * __builtin_amdgcn_rcpf(1.0f + __expf(-x)); }
__device__ __forceinline__ float logsigmoid_f(float z) { return fminf(z, 0.f) - __logf(1.0f + __expf(-fabsf(z))); }
__device__ __forceinline__ float gelu_tanh(float y) { const float y2 = y * y; const float a2 = y * (-2.3022082f - 0.10294324f * y2); return y * __builtin_amdgcn_rcpf(1.0f + __builtin_amdgcn_exp2f(a2)); }

struct TrItem { const float* W; bf16* WT; const float* gk; int Nsrc, srcc, dstr, kb; };
__device__ __forceinline__ void tr_load(const TrItem& t, f32x4 (&v)[16], int lane) {
    const int k0 = 64 * t.kb, c4 = (lane & 15) * 4, kr = lane >> 4;
#pragma unroll
    for (int i = 0; i < 16; ++i) v[i] = __builtin_nontemporal_load((const f32x4*)(t.W + (size_t)(k0 + 4 * i + kr) * t.Nsrc + t.srcc + c4));
}
template <bool NT>
__device__ __forceinline__ void tr_store(const TrItem& t, const f32x4 (&v)[16], LAS float* scr, int lane) {
    const int K = DM, k0 = 64 * t.kb, c4 = (lane & 15) * 4, kr = lane >> 4;
#pragma unroll
    for (int i = 0; i < 16; ++i) { const int kk = 4 * i + kr; const float s = t.gk ? t.gk[k0 + kk] : 1.0f; LAS float* d = scr + kk * 65 + c4; d[0] = v[i][0] * s; d[1] = v[i][1] * s; d[2] = v[i][2] * s; d[3] = v[i][3] * s; }
    asm volatile("s_waitcnt lgkmcnt(0)" ::: "memory");
    const int c = lane & 7;
#pragma unroll
    for (int j = 0; j < 8; ++j) { const int n = (lane >> 3) + 8 * j; const LAS float* s = scr + (8 * c) * 65 + n;
        v4u o; o.x = pk2(s[0 * 65], s[1 * 65]); o.y = pk2(s[2 * 65], s[3 * 65]); o.z = pk2(s[4 * 65], s[5 * 65]); o.w = pk2(s[6 * 65], s[7 * 65]);
        if constexpr (NT) __builtin_nontemporal_store(o, (v4u*)(t.WT + (size_t)(t.dstr + n) * K + k0 + 8 * c)); else *(v4u*)(t.WT + (size_t)(t.dstr + n) * K + k0 + 8 * c) = o; }
    asm volatile("s_waitcnt lgkmcnt(0)" ::: "memory");
}
__device__ __forceinline__ TrItem tr_decode_late(const Args& a, int r) {
    constexpr int I_OUT = 32 * 32, I_CIN = 32 * 64, I_GLU = 32 * 32;
    TrItem t;
    if (r < I_OUT) { t.W = a.ab_w_out; t.WT = (bf16*)(a.ws + WS_WOUT); t.gk = nullptr; t.Nsrc = DM; t.srcc = t.dstr = 64 * (r % 32); t.kb = r / 32; return t; } r -= I_OUT;
    if (r < I_CIN) { t.W = a.c_w_in; t.WT = (bf16*)(a.ws + WS_WCIN); t.gk = a.c_norm_g; t.Nsrc = 4096; t.srcc = t.dstr = 64 * (r % 64); t.kb = r / 64; return t; } r -= I_CIN;
    if (r < I_GLU) { t.W = a.glu_w; t.WT = (bf16*)(a.ws + WS_WGLU); t.gk = nullptr; t.Nsrc = DM; t.srcc = t.dstr = 64 * (r % 32); t.kb = r / 32; return t; } r -= I_GLU;
    t.W = a.c_w_out; t.WT = (bf16*)(a.ws + WS_WCOUT); t.gk = nullptr; t.Nsrc = DM; t.srcc = t.dstr = 64 * (r % 32); t.kb = r / 32; return t;
}
__device__ __forceinline__ TrItem tr_decode_in(const Args& a, int r) {
    TrItem t; const int nb = r % 112, d0 = 64 * nb;
    t.W = a.ab_w_in; t.WT = (bf16*)(a.ws + WS_WIN); t.gk = a.ab_norm_g; t.Nsrc = AB_IN; t.srcc = d0 + (d0 < 2048 ? 0 : (d0 < 6144 ? 16 : 24)); t.dstr = d0; t.kb = r / 112; return t;
}
__device__ __forceinline__ void prologue_late(const Args& a, LAS unsigned char* lds, int tid, int widx, int nidle) {
    const int lane = tid & 63, wave = tid >> 6; LAS float* scr = (LAS float*)(lds + wave * 16640);
    constexpr int NIT = 32 * 32 * 3 + 32 * 64; const int st = nidle * NWAVES;
    int it = widx * NWAVES + wave; if (it >= NIT) return;
    TrItem cur = tr_decode_late(a, it); f32x4 v[16]; tr_load(cur, v, lane);
    for (;;) { const int nx = it + st; const bool more = nx < NIT; TrItem nt = cur; f32x4 vn[16];
        if (more) { nt = tr_decode_late(a, nx); tr_load(nt, vn, lane); }
        tr_store<false>(cur, v, scr, lane);
        if (!more) break;
#pragma unroll
        for (int i = 0; i < 16; ++i) v[i] = vn[i];
        cur = nt; it = nx; }
}
__device__ __forceinline__ void phase_prologue(const Args& a, LAS unsigned char* lds, int tid, int G) {
    const int lane = tid & 63, wave = tid >> 6;
    LAS float* scr = (LAS float*)(lds + wave * 16640);
    const int gw = blockIdx.x * NWAVES + wave, NGW = G * NWAVES;
    bf16* WinT = (bf16*)(a.ws + WS_WIN);
    constexpr int NITEMS = 32 * (7168 / 64);
    if (gw < NITEMS) { int it = gw; TrItem cur = tr_decode_in(a, it); f32x4 v[16]; tr_load(cur, v, lane);
        for (;;) { const int nx = it + NGW; const bool more = nx < NITEMS; TrItem nt = cur; f32x4 vn[16];
            if (more) { nt = tr_decode_in(a, nx); tr_load(nt, vn, lane); }
            tr_store<false>(cur, v, scr, lane);
            if (!more) break;
#pragma unroll
            for (int i = 0; i < 16; ++i) v[i] = vn[i];
            cur = nt; it = nx; } }
    for (int idx = blockIdx.x * NTHR + tid; idx < 256 * DM; idx += G * NTHR) {
        const int rr = idx / DM, k = idx % DM; float w = 0.f;
        if (rr < 16) w = a.ab_w_in[(size_t)k * AB_IN + 2048 + rr] * a.ab_norm_g[k];
        else if (rr < 24) w = a.ab_w_in[(size_t)k * AB_IN + 6160 + (rr - 16)] * a.ab_norm_g[k];
        WinT[(size_t)(C_SMALL + rr) * DM + k] = (bf16)f2bf(w);
    }
    bf16* xb = (bf16*)(a.ws + WS_XB); float* rstd0 = (float*)(a.ws + WS_RSTD0);
    for (int m0 = gw; m0 < MROWS; m0 += 2 * NGW) {
        const int m1 = m0 + NGW; const bool has1 = m1 < MROWS; const int m1c = has1 ? m1 : m0;
        const f32x4* xr0 = (const f32x4*)(a.x + (size_t)m0 * DM) + lane; const f32x4* xr1 = (const f32x4*)(a.x + (size_t)m1c * DM) + lane;
        f32x4 v0[8], v1[8];
#pragma unroll
        for (int j = 0; j < 8; ++j) v0[j] = __builtin_nontemporal_load(xr0 + 64 * j);
#pragma unroll
        for (int j = 0; j < 8; ++j) v1[j] = __builtin_nontemporal_load(xr1 + 64 * j);
        float s0 = 0.f, s1 = 0.f;
#pragma unroll
        for (int j = 0; j < 8; ++j) { s0 += (v0[j][0] * v0[j][0] + v0[j][1] * v0[j][1]) + (v0[j][2] * v0[j][2] + v0[j][3] * v0[j][3]); s1 += (v1[j][0] * v1[j][0] + v1[j][1] * v1[j][1]) + (v1[j][2] * v1[j][2] + v1[j][3] * v1[j][3]); }
        s0 = wave_sum(s0); s1 = wave_sum(s1);
        if (lane == 0) { rstd0[m0] = rsqrtf(s0 * (1.0f / DM) + EPS); if (has1) rstd0[m1] = rsqrtf(s1 * (1.0f / DM) + EPS); }
        v2u* o0 = (v2u*)(xb + (size_t)m0 * DM) + lane; v2u* o1 = (v2u*)(xb + (size_t)m1c * DM) + lane;
#pragma unroll
        for (int j = 0; j < 8; ++j) { v2u w; w.x = pk2(v0[j][0], v0[j][1]); w.y = pk2(v0[j][2], v0[j][3]); o0[64 * j] = w; }
        if (has1) {
#pragma unroll
            for (int j = 0; j < 8; ++j) { v2u w; w.x = pk2(v1[j][0], v1[j][1]); w.y = pk2(v1[j][2], v1[j][3]); o1[64 * j] = w; } }
    }
}

__device__ __forceinline__ void phase_fox_cumsum(const Args& a, LAS unsigned char* lds, int tid, int G) {
    if (blockIdx.x >= 16) return;
    const int bh = blockIdx.x, b = bh >> 3, h = bh & 7, lane = tid & 63, wave = tid >> 6; const float fb = a.fox_f_b[h];
    const float* small = (const float*)(a.ws + WS_SMALL); float* cf = (float*)(a.ws + WS_CFOX) + (size_t)bh * SEQ; LAS float* WT = (LAS float*)lds;
    float v[8]; float run = 0.f;
#pragma unroll
    for (int i = 0; i < 8; ++i) { run += logsigmoid_f(small[(size_t)(b * SEQ + tid * 8 + i) * 32 + 16 + h] + fb); v[i] = run; }
    float inc = run;
#pragma unroll
    for (int o = 1; o < 64; o <<= 1) { const float n = __shfl_up(inc, o); if (lane >= o) inc += n; }
    if (lane == 63) WT[wave] = inc;
    __syncthreads();
    float base = inc - run;
    for (int w = 0; w < wave; ++w) base += WT[w];
#pragma unroll
    for (int i = 0; i < 8; ++i) cf[tid * 8 + i] = base + v[i];
}

#define XB_TMO      128
#define XB_XCNT(j)  (256  + 64 * (j))
#define XB_XSUB(j)  (1280 + 64 * (j))
#define XB_XGEN(j)  (2304 + 64 * (j))
#define XB_TOP      3328
#define XB_TOPGEN   3392
#define XCD_BAR_WORDS 3456
#define XB_SPIN_CAP (1u << 18)

__device__ __forceinline__ unsigned xb_ld(unsigned* p)              { return __hip_atomic_load(p, __ATOMIC_RELAXED, __HIP_MEMORY_SCOPE_AGENT); }
__device__ __forceinline__ unsigned xb_add(unsigned* p, unsigned v) { return __hip_atomic_fetch_add(p, v, __ATOMIC_RELAXED, __HIP_MEMORY_SCOPE_AGENT); }
__device__ __forceinline__ unsigned xb_xcc_id() { return (unsigned)__builtin_amdgcn_s_getreg((3 << 11) | 20) & 0xFu; }
#define XB_SPIN(cond, bar) do { unsigned _sp = 0; while (cond) { __builtin_amdgcn_s_sleep(1); \
    if ((++_sp & 255u) == 0u) { if (xb_ld(&(bar)[XB_TMO])) break; if (_sp > XB_SPIN_CAP) { atomicAdd(&(bar)[XB_TMO], 1u); break; } } } } while (0)

struct XcdBarrier {
    unsigned* bar; unsigned x;
    volatile LAS unsigned* st;
};

__device__ __forceinline__ XcdBarrier xcd_barrier_post(unsigned* bar, volatile LAS unsigned* st) {
    XcdBarrier b; b.bar = bar; b.x = xb_xcc_id(); b.st = st;
    if (threadIdx.x == 0) (void)xb_add(&bar[XB_XCNT(b.x)], 1u);
    return b;
}
__device__ __forceinline__ void xcd_barrier_complete(unsigned* bar, unsigned x, unsigned& nloc, unsigned& nx) {
    const unsigned G = gridDim.x * gridDim.y * gridDim.z;
    unsigned sum, cnt, mine, sp = 0u;
    for (;;) {
        sum = 0u; cnt = 0u; mine = 0u;
#pragma unroll
        for (unsigned j = 0; j < 16; ++j) { const unsigned c = xb_ld(&bar[XB_XCNT(j)]); sum += c; cnt += (c > 0u) ? 1u : 0u; mine = (j == x) ? c : mine; }
        if (sum == G) break;
        __builtin_amdgcn_s_sleep(1);
        if ((++sp & 255u) == 0u) { if (xb_ld(&bar[XB_TMO])) break; if (sp > XB_SPIN_CAP) { atomicAdd(&bar[XB_TMO], 1u); break; } }
    }
    nloc = mine > 0u ? mine : 1u; nx = cnt > 0u ? cnt : 1u;
}

__device__ __forceinline__ void xcd_barrier(const XcdBarrier& b) {
    asm volatile("s_waitcnt vmcnt(0)" ::: "memory");
    __syncthreads();
    if (threadIdx.x == 0) {
        unsigned* bar = b.bar;
        __builtin_amdgcn_s_waitcnt(0);
        unsigned nloc = b.st[0], nx = b.st[1];
        if (nloc == 0u) { xcd_barrier_complete(bar, b.x, nloc, nx); b.st[0] = nloc; b.st[1] = nx; }
        const unsigned old = xb_add(&bar[XB_XSUB(b.x)], 1u);
        const unsigned gen = old / nloc;
        if (old + 1u == (gen + 1u) * nloc) {
            __builtin_amdgcn_fence(__ATOMIC_RELEASE, "agent");
            asm volatile("s_waitcnt vmcnt(0)" ::: "memory");
            const unsigned og = xb_add(&bar[XB_TOP], 1u);
            const unsigned tg = og / nx;
            if (og + 1u == (tg + 1u) * nx) xb_add(&bar[XB_TOPGEN], 1u);
            else XB_SPIN(xb_ld(&bar[XB_TOPGEN]) == tg, bar);
            __builtin_amdgcn_fence(__ATOMIC_ACQUIRE, "agent");
            xb_add(&bar[XB_XGEN(b.x)], 1u);
            asm volatile("s_waitcnt vmcnt(0)" ::: "memory");
        } else {
            XB_SPIN(xb_ld(&bar[XB_XGEN(b.x)]) == gen, bar);
            __builtin_amdgcn_fence(__ATOMIC_ACQUIRE, "agent");
            asm volatile("s_waitcnt vmcnt(0)" ::: "memory");
        }
    }
    __syncthreads();
}


constexpr size_t WS_BAR = 40 * 1024;
namespace fox {
constexpr int D = 128, KVS = 7424, OS = 2048, WINDOW = 4096; constexpr float THR = 8.f; constexpr bool WSKIP = false;
constexpr float SCALE = 0.08838834764831845f;
constexpr int NW = 8, QBLK = 32, KVBLK = 64, QB = NW * QBLK;
constexpr int SHM_V = KVBLK * D * 2, SHM_K = KVBLK * D * 2;
constexpr int LDS_BYTES = 2 * SHM_V + 2 * SHM_K + NW * 64 * 4;


using bf16 = unsigned short;
typedef short bf16x8 __attribute__((ext_vector_type(8)));
typedef short s16x4 __attribute__((ext_vector_type(4)));
typedef float f32x16 __attribute__((ext_vector_type(16)));
typedef float f32x4 __attribute__((ext_vector_type(4)));
typedef unsigned u32x4 __attribute__((ext_vector_type(4)));
template <class A, class Bt> struct same_t { static constexpr bool v = false; };
template <class A> struct same_t<A, A> { static constexpr bool v = true; };

#define KSWZ(row, colB) ((row) * 256 + ((colB) ^ (((row) & 7) << 4)))
#define SBAR() __builtin_amdgcn_sched_barrier(0)
__device__ __forceinline__ int v_st(int k, int c) { const int kk = (k & ~0xC) | ((k & 4) << 1) | ((k & 8) >> 1); return ((kk >> 3) * 4 + (c >> 5)) * 512 + ((kk & 7) * 32 + (c & 31)) * 2; }
__device__ __forceinline__ int v_rd_base(int lane) { return ((lane & 3) << 3) | (((lane >> 2) & 3) << 6) | (((lane >> 4) & 1) << 5) | (((lane >> 5) & 1) << 8); }
constexpr int v_rd_off(int d0, int ks, int half) { return d0 * 512 + ks * 4096 + half * 2048; }
__device__ __forceinline__ int crow(int r, int hi) { return (r & 3) + 8 * (r >> 2) + 4 * hi; }
__device__ __forceinline__ unsigned cvtpk(float lo, float hi) {
    unsigned r; asm volatile("v_cvt_pk_bf16_f32 %0, %1, %2" : "=v"(r) : "v"(lo), "v"(hi)); return r;
}
__device__ __forceinline__ bf16x8 pack8(f32x4 a, f32x4 b) {
    u32x4 w = {cvtpk(a[0], a[1]), cvtpk(a[2], a[3]), cvtpk(b[0], b[1]), cvtpk(b[2], b[3])};
    return *reinterpret_cast<bf16x8*>(&w);
}
template <class T> __device__ __forceinline__ bf16x8 load8(const T* p) {
    if constexpr (same_t<T, float>::v) { return pack8(*(const f32x4*)p, *(const f32x4*)(p + 4)); }
    else { return *reinterpret_cast<const bf16x8*>(p); }
}
typedef __attribute__((address_space(3))) float lds_f32; typedef __attribute__((address_space(3))) f32x4 lds_f32x4;
__device__ __forceinline__ void bias_tile(f32x16& p0, f32x16& p1, const lds_f32* cbk, int hi) {
    const lds_f32* cb0 = cbk + 4 * hi;
#pragma unroll
    for (int g_ = 0; g_ < 4; ++g_) { const f32x4 b0_ = *(const lds_f32x4*)(cb0 + 8 * g_), b1_ = *(const lds_f32x4*)(cb0 + 32 + 8 * g_);
        p0[4 * g_] += b0_[0]; p0[4 * g_ + 1] += b0_[1]; p0[4 * g_ + 2] += b0_[2]; p0[4 * g_ + 3] += b0_[3]; p1[4 * g_] += b1_[0]; p1[4 * g_ + 1] += b1_[1]; p1[4 * g_ + 2] += b1_[2]; p1[4 * g_ + 3] += b1_[3]; }
}
__device__ __forceinline__ void mask_tile(f32x16& p0, f32x16& p1, int dq, unsigned W) {
    const float NEG = -__builtin_inff();
#pragma unroll
    for (int r = 0; r < 16; ++r) {
        const int c = (r & 3) + 8 * (r >> 2);
        if ((unsigned)(dq - c) >= W) p0[r] = NEG;
        if ((unsigned)(dq - c - 32) >= W) p1[r] = NEG;
    }
}
__device__ __forceinline__ void partialSM(f32x16& p0, f32x16& p1, float& m_reg, float& mn, float& alpha) {
    float pmax = p0[0]; for (int r = 1; r < 16; ++r) pmax = fmaxf(pmax, p0[r]); for (int r = 0; r < 16; ++r) pmax = fmaxf(pmax, p1[r]);
    { auto rr = __builtin_amdgcn_permlane32_swap(__float_as_uint(pmax), __float_as_uint(pmax), false, false);
      pmax = fmaxf(__uint_as_float(rr[0]), __uint_as_float(rr[1])); }
    constexpr float C2 = 1.4426950408889634f * SCALE;
    if (__builtin_expect(__all((pmax - m_reg) * SCALE <= THR), 1)) { mn = m_reg; alpha = 1.f; }
    else { mn = fmaxf(m_reg, pmax); alpha = __builtin_amdgcn_exp2f((m_reg - mn) * C2); m_reg = mn; }
    const float mnL = -mn * C2;
    for (int r = 0; r < 16; ++r) p0[r] = fmaf(p0[r], C2, mnL); for (int r = 0; r < 16; ++r) p1[r] = fmaf(p1[r], C2, mnL);
    for (int r = 0; r < 16; ++r) p0[r] = __builtin_amdgcn_exp2f(p0[r]);
}
__device__ __forceinline__ void finishSM(f32x16& p0, f32x16& p1, float alpha, float& l_reg, bf16x8& pa0, bf16x8& pa1, bf16x8& pa2, bf16x8& pa3) {
    for (int r = 0; r < 16; ++r) p1[r] = __builtin_amdgcn_exp2f(p1[r]);
    float ps = 0; for (int r = 0; r < 16; ++r) ps += p0[r]; for (int r = 0; r < 16; ++r) ps += p1[r];
    { auto rr = __builtin_amdgcn_permlane32_swap(__float_as_uint(ps), __float_as_uint(ps), false, false);
      ps = __uint_as_float(rr[0]) + __uint_as_float(rr[1]); }
    l_reg = l_reg * alpha + ps;
#define PK4(P, B_, OUT) do { unsigned a0 = cvtpk(P[B_+0], P[B_+1]), a1 = cvtpk(P[B_+2], P[B_+3]);                          \
        unsigned b0 = cvtpk(P[B_+4], P[B_+5]), b1 = cvtpk(P[B_+6], P[B_+7]);                                             \
        auto r0 = __builtin_amdgcn_permlane32_swap(a0, b0, false, false); auto r1 = __builtin_amdgcn_permlane32_swap(a1, b1, false, false); \
        u32x4 w = {r0[0], r1[0], r0[1], r1[1]}; OUT = *reinterpret_cast<bf16x8*>(&w); } while (0)
    PK4(p0, 0, pa0); PK4(p0, 8, pa1); PK4(p1, 0, pa2); PK4(p1, 8, pa3);
#undef PK4
}
typedef __attribute__((address_space(3))) bf16x8 lds_bf16x8;
constexpr int QLDS_OFF = LDS_BYTES + 16384, QLDS_ROW = 272;
template <int KB, bool SK>
__device__ __forceinline__ void qkt(f32x16& p0, f32x16& p1, const char* K_lds, int r32, int hi, const lds_bf16x8* qp, bool act) {
    if (SK && !act) { const float NEG = -__builtin_inff();
#pragma unroll
        for (int r = 0; r < 16; ++r) { p0[r] = NEG; p1[r] = NEG; } return; }
    p0 = f32x16{}; p1 = f32x16{};
    const char* kb[4];
#pragma unroll
    for (int dd = 0; dd < 4; ++dd) kb[dd] = K_lds + KB * SHM_K + KSWZ(r32, (dd * 16 + hi * 8) * 2);
#pragma unroll
    for (int d0 = 0; d0 < 8; ++d0) { const char* a = kb[d0 & 3] + (d0 >> 2) * 128;
        bf16x8 b0 = *reinterpret_cast<const bf16x8*>(a);
        bf16x8 b1 = *reinterpret_cast<const bf16x8*>(a + 32 * 256); const bf16x8 qf = qp[2 * d0];
        p0 = __builtin_amdgcn_mfma_f32_32x32x16_bf16(b0, qf, p0, 0, 0, 0);
        p1 = __builtin_amdgcn_mfma_f32_32x32x16_bf16(b1, qf, p1, 0, 0, 0); }
}
template <int VB, bool SK>
__device__ __forceinline__ void pv_tile(f32x16* o, int vb0, bf16x8 pa0, bf16x8 pa1, bf16x8 pa2, bf16x8 pa3, bool act) {
    if (SK && !act) return;
#define TRRD(dst, off) asm volatile("ds_read_b64_tr_b16 %0, %1 offset:%2" : "=&v"(dst) : "v"(vb0), "i"(off) : "memory")
#define PV_D0(d0) do { s16x4 l0, l1, l2, l3, h0, h1, h2, h3; constexpr int b_ = VB * SHM_V + v_rd_off(d0, 0, 0);     \
        TRRD(l0, b_); TRRD(h0, b_ + 2048); TRRD(l1, b_ + 4096); TRRD(h1, b_ + 6144); TRRD(l2, b_ + 8192); TRRD(h2, b_ + 10240); TRRD(l3, b_ + 12288); TRRD(h3, b_ + 14336); \
        asm volatile("s_waitcnt lgkmcnt(0)" ::: "memory"); SBAR();                 \
        o[d0] = __builtin_amdgcn_mfma_f32_32x32x16_bf16(pa0, (bf16x8){l0[0], l0[1], l0[2], l0[3], h0[0], h0[1], h0[2], h0[3]}, o[d0], 0, 0, 0);   \
        o[d0] = __builtin_amdgcn_mfma_f32_32x32x16_bf16(pa1, (bf16x8){l1[0], l1[1], l1[2], l1[3], h1[0], h1[1], h1[2], h1[3]}, o[d0], 0, 0, 0);   \
        o[d0] = __builtin_amdgcn_mfma_f32_32x32x16_bf16(pa2, (bf16x8){l2[0], l2[1], l2[2], l2[3], h2[0], h2[1], h2[2], h2[3]}, o[d0], 0, 0, 0);   \
        o[d0] = __builtin_amdgcn_mfma_f32_32x32x16_bf16(pa3, (bf16x8){l3[0], l3[1], l3[2], l3[3], h3[0], h3[1], h3[2], h3[3]}, o[d0], 0, 0, 0); } while (0)
    PV_D0(0); PV_D0(1); PV_D0(2); PV_D0(3);
#undef PV_D0
#undef TRRD
}

template <class TIn, class TOut> struct BlockRef { const TIn* Q; const TIn* K; const TIn* V; TOut* O; const bf16* G; int P0; int jlo; };
template <class TIn> struct Seam {
    bf16x8 qr[8];
    bf16x8 st_v0, st_v1, st_k0, st_k1; f32x4 sf0, sf1, sf2, sf3;
    f32x4 tq[16];
};
__device__ __forceinline__ int swa_jlo(int P0, int W) { const int lowk = P0 - W + 1; return lowk > 0 ? lowk / KVBLK : 0; }
#define ROW(p, k0, rr) ((p) + (size_t)((k0) + (rr)) * KVS + sc)
#define VMW() asm volatile("s_waitcnt vmcnt(0)" ::: "memory")
#define VMWN(n) asm volatile("s_waitcnt vmcnt(%0)" :: "i"(n) : "memory")
#define SLOAD_H(Kp, Vp, k0) do { S.st_v0 = load8<TIn>(ROW(Vp, k0, sr)); S.st_v1 = load8<TIn>(ROW(Vp, k0, 32 + sr));              \
                         S.st_k0 = load8<TIn>(ROW(Kp, k0, sr)); S.st_k1 = load8<TIn>(ROW(Kp, k0, 32 + sr)); } while (0)
#define SWRITE_HK(bf) do { *(bf16x8*)(K_lds + (bf) * SHM_K + kws) = S.st_k0; *(bf16x8*)(K_lds + (bf) * SHM_K + kws + 32 * 256) = S.st_k1; } while (0)
#define SWRITE_HV(bf) do { *(bf16x8*)(V_lds + (bf) * SHM_V + vst0) = S.st_v0; *(bf16x8*)(V_lds + (bf) * SHM_V + vst1) = S.st_v1; } while (0)
#define SWRITE_H(bf) do { SWRITE_HV(bf); SWRITE_HK(bf); } while (0)
#define SLOAD_F(p, k0) do { S.sf0 = *(const f32x4*)ROW(p, k0, sr); S.sf1 = *(const f32x4*)(ROW(p, k0, sr) + 4);                \
                            S.sf2 = *(const f32x4*)ROW(p, k0, 32 + sr); S.sf3 = *(const f32x4*)(ROW(p, k0, 32 + sr) + 4); } while (0)
#define SWRITE_KF(bf) do { *(bf16x8*)(K_lds + (bf) * SHM_K + kws) = pack8(S.sf0, S.sf1); *(bf16x8*)(K_lds + (bf) * SHM_K + kws + 32 * 256) = pack8(S.sf2, S.sf3); } while (0)
#define SWRITE_VF(bf) do { *(bf16x8*)(V_lds + (bf) * SHM_V + vst0) = pack8(S.sf0, S.sf1); *(bf16x8*)(V_lds + (bf) * SHM_V + vst1) = pack8(S.sf2, S.sf3); } while (0)
template <class TIn, class TOut>
__device__ __forceinline__ void causal_swa_prime(const BlockRef<TIn, TOut>& cur, int W, char* lds, Seam<TIn>& S) {
    constexpr bool F32 = same_t<TIn, float>::v;
    const int tid = threadIdx.x, wid = __builtin_amdgcn_readfirstlane(tid >> 6), lane = tid & 63, r32 = lane & 31, hi = lane >> 5;
    const int sr = tid >> 4, sc = (tid & 15) * 8, kws = KSWZ(sr, sc * 2); char* K_lds = lds + 2 * SHM_V;
    const int kb0 = cur.jlo * KVBLK;
    for (int d0 = 0; d0 < 8; ++d0) S.qr[d0] = load8<TIn>(cur.Q + (size_t)(wid * QBLK + r32) * KVS + d0 * 16 + hi * 8);
    { lds_bf16x8* qp = (lds_bf16x8*)(lds + QLDS_OFF + (wid * QBLK + r32) * QLDS_ROW + hi * 16);
#pragma unroll
      for (int d0 = 0; d0 < 8; ++d0) qp[2 * d0] = S.qr[d0]; }
    if constexpr (F32) { SLOAD_F((const float*)cur.K, kb0); VMW(); SWRITE_KF(0); SBAR(); SLOAD_F((const float*)cur.V, kb0); }
    else { SLOAD_H(cur.K, cur.V, kb0); VMW(); SWRITE_HK(0); }
    __syncthreads();
}
template <class TIn, class TOut>
__device__ __forceinline__ void causal_swa_block(const BlockRef<TIn, TOut>& cur, const BlockRef<TIn, TOut>& nxt, int skv, int W, char* lds, Seam<TIn>& S) {
    constexpr bool F32 = same_t<TIn, float>::v;
    const int tid = threadIdx.x, wid = __builtin_amdgcn_readfirstlane(tid >> 6), lane = tid & 63, r32 = lane & 31, hi = lane >> 5;
    const int j_lo = cur.jlo;
    int j_hi = (cur.P0 + QB - 1) / KVBLK + 1; if (j_hi > skv / KVBLK) j_hi = skv / KVBLK;
    const int NT = j_hi - j_lo;
    const int kbn = nxt.jlo * KVBLK;
    const int qlo = cur.P0 + wid * QBLK, qm = qlo + r32 - 4 * hi;
    char* V_lds = lds; char* K_lds = lds + 2 * SHM_V;
    float* ws = (float*)(lds + 2 * SHM_V + 2 * SHM_K) + wid * 64; float* li_l = ws, * al_l = ws + 32;
    lds_bf16x8* qp = (lds_bf16x8*)(lds + QLDS_OFF + (wid * QBLK + r32) * QLDS_ROW + hi * 16);
    lds_f32* cb = (lds_f32*)(lds + 2 * SHM_V + 2 * SHM_K + NW * 64 * 4);
    float m_reg = -1e30f, l_reg = 0; f32x16 o[4] = {};
    const int sr = tid >> 4, sc = (tid & 15) * 8, vst0 = v_st(sr, sc), vst1 = v_st(32 + sr, sc), kws = KSWZ(sr, sc * 2);
    const int vb0 = (int)(uintptr_t)V_lds + v_rd_base(lane);
    const TIn* Kh = cur.K; const TIn* Vh = cur.V;
#define RESC(a) do { if (__any((a) < 1.f)) { if (hi == 0) al_l[r32] = (a); asm volatile("s_waitcnt lgkmcnt(0)" ::: "memory");              \
                     for (int d_ = 0; d_ < 4; ++d_) for (int r = 0; r < 16; ++r) o[d_][r] *= al_l[crow(r, hi)]; } } while (0)
#define KBASE(t) ((j_lo + (t)) * KVBLK)
#define ACT(t) (KBASE(t) <= qlo + QBLK - 1 && KBASE(t) + KVBLK - 1 >= qlo - W + 1)
#define MASKT(P0_, P1_, t) do { const int kb_ = KBASE(t); if ((!SK || ACT(t)) && (kb_ + KVBLK - 1 > qlo || kb_ <= qlo + QBLK - 1 - W)) mask_tile(P0_, P1_, qm - kb_, (unsigned)W); } while (0)
    constexpr int NQL = F32 ? 16 : 8;
    constexpr bool SK = WSKIP && !F32;
#define SEAM_K0() do { VMWN(NQL); if constexpr (F32) { SWRITE_KF(0); SBAR(); SLOAD_F((const float*)nxt.V, kbn); } else { SWRITE_HK(0); } SBAR(); } while (0)
    f32x16 pA0, pA1, pB0, pB1; float mnA, mnB, alA, alB; bf16x8 pa0, pa1, pa2, pa3;
    if constexpr (F32) { VMW(); SWRITE_VF(0); SBAR(); } else { SWRITE_HV(0); SBAR(); }
    if (NT > 1) { if constexpr (F32) SLOAD_F((const float*)Kh, KBASE(1)); else SLOAD_H(Kh, Vh, KBASE(1)); }
    SBAR(); qkt<0, SK>(pA0, pA1, K_lds, r32, hi, qp, ACT(0));
    if constexpr (F32) { if (NT > 1) { VMW(); SWRITE_KF(1); SBAR(); SLOAD_F((const float*)Vh, KBASE(1)); } }
    bias_tile(pA0, pA1, cb + KBASE(0), hi); MASKT(pA0, pA1, 0); partialSM(pA0, pA1, m_reg, mnA, alA);
    if (NT > 1) { VMW(); if constexpr (F32) { SWRITE_VF(1); SBAR(); if (NT > 2) SLOAD_F((const float*)Kh, KBASE(2)); } else SWRITE_H(1); }
    __syncthreads();
#define HALF_STEP(PX0, PX1, mnX, alX, PY0, PY1, alY, t, KB, VB, SB) do {                                                      \
        SBAR(); qkt<KB, SK>(PX0, PX1, K_lds, r32, hi, qp, ACT(t));                                             \
        finishSM(PY0, PY1, alY, l_reg, pa0, pa1, pa2, pa3); SBAR();                                                           \
        if ((t) + 1 < NT) { if constexpr (F32) { VMW(); SWRITE_KF(SB); SBAR(); SLOAD_F((const float*)Vh, KBASE((t) + 1)); }  \
                            else { SLOAD_H(Kh, Vh, KBASE((t) + 1)); } SBAR(); }                                               \
        pv_tile<VB, SK>(o, vb0, pa0, pa1, pa2, pa3, ACT((t) - 1)); bias_tile(PX0, PX1, cb + KBASE(t), hi); MASKT(PX0, PX1, (t)); partialSM(PX0, PX1, m_reg, mnX, alX);                                        \
        __syncthreads();                                                                                                      \
        if ((t) + 1 < NT) { VMW(); if constexpr (F32) { SWRITE_VF(SB); SBAR(); if ((t) + 2 < NT) SLOAD_F((const float*)Kh, KBASE((t) + 2)); } \
                            else { SWRITE_H(SB); } }                                                                          \
        RESC(alX); __syncthreads(); } while (0)
    for (int t = 1; t + 1 < NT; t += 2) {
        HALF_STEP(pB0, pB1, mnB, alB, pA0, pA1, alA, t, 1, 0, 0);
        HALF_STEP(pA0, pA1, mnA, alA, pB0, pB1, alB, t + 1, 0, 1, 1);
    }
    const bool even = (NT & 1) == 0;
    if (even) { SBAR(); qkt<1, SK>(pB0, pB1, K_lds, r32, hi, qp, ACT(NT - 1)); SBAR(); }
#define QROW(e) (nxt.Q + (size_t)(wid * QBLK + r32) * KVS + ((e) >> 1) * 16 + hi * 8 + ((e) & 1) * 4)
    if constexpr (F32) { SLOAD_F((const float*)nxt.K, kbn); SBAR();
#pragma unroll
        for (int e = 0; e < 8; ++e) S.tq[e] = *(const f32x4*)QROW(e); }
    else { SLOAD_H(nxt.K, nxt.V, kbn); SBAR();
#pragma unroll
        for (int d0 = 0; d0 < 8; ++d0) S.qr[d0] = load8<TIn>(nxt.Q + (size_t)(wid * QBLK + r32) * KVS + d0 * 16 + hi * 8); }
    SBAR();
    finishSM(pA0, pA1, alA, l_reg, pa0, pa1, pa2, pa3); SBAR();
    if constexpr (F32) {
#pragma unroll
        for (int e = 8; e < 16; ++e) S.tq[e] = *(const f32x4*)QROW(e); SBAR(); }
#undef QROW
    pv_tile<0, SK>(o, vb0, pa0, pa1, pa2, pa3, ACT(even ? NT - 2 : NT - 1));
    if (even) { bias_tile(pB0, pB1, cb + KBASE(NT - 1), hi); MASKT(pB0, pB1, NT - 1); partialSM(pB0, pB1, m_reg, mnB, alB); __syncthreads(); RESC(alB);
        finishSM(pB0, pB1, alB, l_reg, pa0, pa1, pa2, pa3); SBAR(); pv_tile<1, SK>(o, vb0, pa0, pa1, pa2, pa3, ACT(NT - 1)); }
    SBAR(); SEAM_K0();
    if (hi == 0) li_l[r32] = l_reg; asm volatile("s_waitcnt lgkmcnt(0)" ::: "memory");
    float rli[16];
#pragma unroll
    for (int r = 0; r < 16; ++r) rli[r] = __builtin_amdgcn_rcpf(li_l[crow(r, hi)]);
    TOut* Ow = cur.O + (size_t)(wid * QBLK) * OS;
    {
        typedef __attribute__((address_space(3))) unsigned short lds_u16; typedef __attribute__((address_space(3))) u32x4 lds_u32x4;
        const bf16* Gw = cur.G + (size_t)(wid * QBLK) * KVS;
        u32x4 gt[8];
#pragma unroll
        for (int i = 0; i < 8; ++i) { const int p = lane + 64 * i; gt[i] = __builtin_nontemporal_load((const u32x4*)(Gw + (size_t)(p >> 4) * KVS + (p & 15) * 8)); }
        lds_u16* st = (lds_u16*)(lds + QLDS_OFF + (wid * QBLK) * QLDS_ROW);
#pragma unroll
        for (int r = 0; r < 16; ++r) { const int orow = crow(r, hi);
#pragma unroll
            for (int d0 = 0; d0 < 4; d0 += 2) { const unsigned w2 = cvtpk(o[d0][r] * rli[r], o[d0 + 1][r] * rli[r]);
                st[orow * (QLDS_ROW / 2) + d0 * 32 + r32] = (unsigned short)w2; st[orow * (QLDS_ROW / 2) + (d0 + 1) * 32 + r32] = (unsigned short)(w2 >> 16); } }
        asm volatile("s_waitcnt lgkmcnt(0)" ::: "memory");
#pragma unroll
        for (int i = 0; i < 8; ++i) { const int p = lane + 64 * i, row = p >> 4, c8 = (p & 15) * 8;
            const u32x4 ov = *(const lds_u32x4*)(lds + QLDS_OFF + (wid * QBLK + row) * QLDS_ROW + c8 * 2); u32x4 w;
#pragma unroll
            for (int e = 0; e < 4; ++e) { const float a0 = __uint_as_float(ov[e] << 16), a1 = __uint_as_float(ov[e] & 0xffff0000u), g0 = __uint_as_float(gt[i][e] << 16), g1 = __uint_as_float(gt[i][e] & 0xffff0000u);
                w[e] = cvtpk(a0 * g0 * __builtin_amdgcn_rcpf(1.0f + __expf(-g0)), a1 * g1 * __builtin_amdgcn_rcpf(1.0f + __expf(-g1))); }
            *(u32x4*)(Ow + (size_t)row * OS + c8) = w; }
        asm volatile("s_waitcnt lgkmcnt(0)" ::: "memory");
    }
    if constexpr (F32) {
#pragma unroll
        for (int d0 = 0; d0 < 8; ++d0) S.qr[d0] = pack8(S.tq[2 * d0], S.tq[2 * d0 + 1]); }
#pragma unroll
    for (int d0 = 0; d0 < 8; ++d0) qp[2 * d0] = S.qr[d0];
    __syncthreads();
#undef RESC
#undef KBASE
#undef ACT
#undef MASKT
#undef SEAM_K0
#undef HALF_STEP
}
#undef ROW
#undef VMW
#undef VMWN
#undef SLOAD_H
#undef SWRITE_HK
#undef SWRITE_HV
#undef SWRITE_H
#undef SLOAD_F
#undef SWRITE_KF
#undef SWRITE_VF
}
__device__ __forceinline__ void fox_naive_row(const Args& a, int bh, int t, int lane) {
    const bf16* P = (const bf16*)(a.ws + WS_P); const float* cf = (const float*)(a.ws + WS_CFOX) + (size_t)bh * SEQ; bf16* mix = (bf16*)(a.ws + WS_MIX);
    const int b = bh >> 3, h = bh & 7; const size_t rowb = (size_t)b * SEQ;
    const unsigned qw = *(const unsigned*)(P + (rowb + t) * NP + C_FQ + 128 * h + 2 * lane);
    const float scale = 0.08838834764831845f; const float q0 = bflo(qw) * scale, q1 = bfhi(qw) * scale; const float ct = cf[t];
    float m = -1e30f, l = 0.f, o0 = 0.f, o1 = 0.f;
    for (int s = 0; s <= t; ++s) {
        const unsigned kw = *(const unsigned*)(P + (rowb + s) * NP + C_FK + 128 * h + 2 * lane), vw = *(const unsigned*)(P + (rowb + s) * NP + C_FV + 128 * h + 2 * lane);
        float d = q0 * bflo(kw) + q1 * bfhi(kw); d = wave_sum(d);
        const float logit = d + (ct - cf[s]);
        const float mn = fmaxf(m, logit), corr = __expf(m - mn), p = __expf(logit - mn);
        l = l * corr + p; o0 = o0 * corr + p * bflo(vw); o1 = o1 * corr + p * bfhi(vw); m = mn;
    }
    const unsigned gw_ = *(const unsigned*)(P + (rowb + t) * NP + C_FG + 128 * h + 2 * lane);
    const float inv = 1.0f / l;
    *(unsigned*)(mix + (rowb + t) * DM + 1024 + 128 * h + 2 * lane) = pk2(o0 * inv * silu_f(bflo(gw_)), o1 * inv * silu_f(bfhi(gw_)));
}
__device__ __forceinline__ void gla_naive(const Args& a, LAS unsigned char* lds, int bh, int tid) {
    const bf16* P = (const bf16*)(a.ws + WS_P); const float* small = (const float*)(a.ws + WS_SMALL); float* oraw = (float*)(a.ws + WS_ORAW);
    const int b = bh >> 2, h = bh & 3; const size_t rowb = (size_t)b * SEQ;
    LAS float* A = (LAS float*)lds; LAS float* Kk = A + 8 * 128; LAS float* Qq = Kk + 8 * 128; LAS float* Vv = Qq + 8 * 128; LAS float* OP = Vv + 8 * 256;
    const int dv = tid & 255, kh = tid >> 8;
    float S[64];
#pragma unroll
    for (int j = 0; j < 64; ++j) S[j] = 0.f;
    const float qscale = 0.08838834764831845f;
    for (int tb = 0; tb < SEQ / 8; ++tb) {
        for (int idx = tid; idx < 1024; idx += NTHR) { const int tt = idx >> 7, k = idx & 127; const size_t row = rowb + tb * 8 + tt;
            float z = a.alpha_b[128 * h + k];
#pragma unroll
            for (int r = 0; r < 16; ++r) z += small[row * 32 + r] * a.alpha_up[r * 512 + 128 * h + k];
            A[idx] = __expf(logsigmoid_f(z) * (1.0f / 16.0f)); Kk[idx] = bf2f(P[row * NP + C_GK + 128 * h + k]); Qq[idx] = bf2f(P[row * NP + C_GQ + 128 * h + k]) * qscale; }
        for (int idx = tid; idx < 2048; idx += NTHR) { const int tt = idx >> 8, d = idx & 255; Vv[idx] = bf2f(P[(rowb + tb * 8 + tt) * NP + C_GV + 256 * h + d]); }
        __syncthreads();
        for (int tt = 0; tt < 8; ++tt) { const float v = Vv[tt * 256 + dv]; float o = 0.f;
#pragma unroll
            for (int j = 0; j < 64; ++j) { const int ki = tt * 128 + kh * 64 + j; S[j] = A[ki] * S[j] + Kk[ki] * v; o += Qq[ki] * S[j]; }
            OP[(tt * 2 + kh) * 256 + dv] = o; }
        __syncthreads();
        for (int idx = tid; idx < 2048; idx += NTHR) { const int tt = idx >> 8, d = idx & 255; oraw[(rowb + tb * 8 + tt) * 1024 + 256 * h + d] = OP[(tt * 2) * 256 + d] + OP[(tt * 2 + 1) * 256 + d]; }
    }
}
__device__ __forceinline__ void gla_pass_a(const Args& a, LAS unsigned char* lds, int unit, int tid);
__device__ __forceinline__ void gla_pass_c(const Args& a, LAS unsigned char* lds, int unit, int tid);
__device__ __forceinline__ void phase_gla_b(const Args& a, int tid, int gw, int NG);
__device__ __forceinline__ void phase_gla_b2(const Args& a, int tid, int gw, int NG);
__device__ __forceinline__ void sub_barrier(unsigned* cnt, unsigned target) {
    asm volatile("s_waitcnt vmcnt(0)" ::: "memory"); __syncthreads();
    if (threadIdx.x == 0) {
        __builtin_amdgcn_fence(__ATOMIC_RELEASE, "agent"); asm volatile("s_waitcnt vmcnt(0)" ::: "memory");
        __hip_atomic_fetch_add(cnt, 1u, __ATOMIC_RELAXED, __HIP_MEMORY_SCOPE_AGENT);
        unsigned sp = 0; while (__hip_atomic_load(cnt, __ATOMIC_RELAXED, __HIP_MEMORY_SCOPE_AGENT) < target) { __builtin_amdgcn_s_sleep(2); if (++sp > (1u << 22)) break; }
        __builtin_amdgcn_fence(__ATOMIC_ACQUIRE, "agent"); asm volatile("s_waitcnt vmcnt(0)" ::: "memory");
    }
    __syncthreads();
}
__device__ __forceinline__ fox::BlockRef<bf16, bf16> fox_ref(const Args& a, int bh, int qb, int jlo) {
    const bf16* P = (const bf16*)(a.ws + WS_P); const int b = bh >> 3, h = bh & 7; const size_t row0 = (size_t)b * SEQ + (size_t)qb * 256;
    fox::BlockRef<bf16, bf16> r;
    r.Q = P + row0 * NP + C_FQ + 128 * h; r.K = P + (size_t)b * SEQ * NP + C_FK + 128 * h; r.V = P + (size_t)b * SEQ * NP + C_FV + 128 * h;
    r.O = (bf16*)(a.ws + WS_MIX) + row0 * DM + 1024 + 128 * h; r.G = P + row0 * NP + C_FG + 128 * h; r.P0 = qb * 256; r.jlo = jlo;
    return r;
}
__device__ __forceinline__ void phase_fox(const Args& a, char* lds, int w) {
    const int bh = 2 * (w & 7) + (w >> 7), qb = (w >> 3) & 15, P0 = qb * 256;
    fox::lds_f32* cb = (fox::lds_f32*)(lds + fox::LDS_BYTES);
    {   const float* cf = (const float*)(a.ws + WS_CFOX) + (size_t)bh * SEQ;
        for (int j = threadIdx.x; j < P0 + 256; j += NTHR) cb[j] = cf[j] * (-1.0f / fox::SCALE); }
    __syncthreads();
    int jl0;
    {   const float* nm = (const float*)(a.ws + WS_BAR + 20480) + (size_t)bh * 8;
        const float qn2 = (nm[0] + nm[1]) + (nm[2] + nm[3]), kn2 = (nm[4] + nm[5]) + (nm[6] + nm[7]);
        const float thr = -(50.0f / fox::SCALE) - 2.0f * 1.02f * sqrtf(qn2 * kn2);
        const int lane = threadIdx.x & 63;
        const bool skip = lane < P0 / 64 && (cb[64 * lane + 63] - cb[P0] <= thr);
        jl0 = __builtin_amdgcn_readfirstlane((int)__builtin_popcountll(__ballot(skip)));
    }
    const fox::BlockRef<bf16, bf16> cur = fox_ref(a, bh, qb, jl0);
    fox::Seam<bf16> S;
    fox::causal_swa_prime<bf16, bf16>(cur, SEQ, lds, S);
    fox::causal_swa_block<bf16, bf16>(cur, cur, SEQ, SEQ, lds, S);
}
__device__ __forceinline__ void phase_m1(const Args& a, LAS unsigned char* lds, int tid, int G) {
    for (int unit = blockIdx.x; unit < 512; unit += G) gla_pass_a(a, lds, unit, tid);
    __syncthreads();
    phase_fox_cumsum(a, lds, tid, G);
}
__device__ __forceinline__ void phase_m2(const Args& a, unsigned char* lds_raw, int tid, int G) {
    if (G * NTHR >= 131072) phase_gla_b2(a, tid, blockIdx.x, G); else phase_gla_b(a, tid, blockIdx.x, G);
    if (blockIdx.x < 256) phase_fox(a, (char*)lds_raw, blockIdx.x);
}
__device__ __forceinline__ void phase_gla_finalize(const Args& a, int tid, int G) {
    const int lane = tid & 63, wave = tid >> 6; const int gw = blockIdx.x * NWAVES + wave, NGW = G * NWAVES;
    const bf16* P = (const bf16*)(a.ws + WS_P); const float* oraw = (const float*)(a.ws + WS_ORAW); bf16* mix = (bf16*)(a.ws + WS_MIX);
    for (int it = gw; it < MROWS * 4; it += NGW) { const int row = it >> 2, h = it & 3;
        const f32x4 v = *(const f32x4*)(oraw + (size_t)row * 1024 + 256 * h + 4 * lane);
        float s = (v[0] * v[0] + v[1] * v[1]) + (v[2] * v[2] + v[3] * v[3]); s = wave_sum(s);
        const float r = rsqrtf(s * (1.0f / 256.0f) + EPS);
        const f32x4 g = *(const f32x4*)(a.head_g + 256 * h + 4 * lane);
        const v2u gt = *(const v2u*)(P + (size_t)row * NP + C_GG + 256 * h + 4 * lane);
        v2u w; w.x = pk2(v[0] * r * g[0] * silu_f(bflo(gt.x)), v[1] * r * g[1] * silu_f(bfhi(gt.x))); w.y = pk2(v[2] * r * g[2] * silu_f(bflo(gt.y)), v[3] * r * g[3] * silu_f(bfhi(gt.y)));
        *(v2u*)(mix + (size_t)row * DM + 256 * h + 4 * lane) = w; }
    for (int row0 = gw; row0 < MROWS; row0 += 4 * NGW) {
        v4u m[4][2], g[4][2];
#pragma unroll
        for (int rr = 0; rr < 4; ++rr) { const int row = row0 + rr * NGW; if (row < MROWS) { const v4u* mp = (const v4u*)(mix + (size_t)row * DM + 1024 + 16 * lane); const v4u* gp = (const v4u*)(P + (size_t)row * NP + C_FG + 16 * lane);
            m[rr][0] = mp[0]; m[rr][1] = mp[1]; g[rr][0] = gp[0]; g[rr][1] = gp[1]; } }
#pragma unroll
        for (int rr = 0; rr < 4; ++rr) { const int row = row0 + rr * NGW; if (row < MROWS) { v4u* mp = (v4u*)(mix + (size_t)row * DM + 1024 + 16 * lane);
#pragma unroll
            for (int q = 0; q < 2; ++q) { v4u o;
#pragma unroll
                for (int e = 0; e < 4; ++e) o[e] = pk2(bflo(m[rr][q][e]) * silu_f(bflo(g[rr][q][e])), bfhi(m[rr][q][e]) * silu_f(bfhi(g[rr][q][e])));
                mp[q] = o; } } }
    }
}
__device__ __forceinline__ void phase_s5_naive(const Args& a, int tid, int G) {
    const int lane = tid & 63, wave = tid >> 6; const int gw = blockIdx.x * NWAVES + wave;
    if (gw >= 256) return;
    const int b = gw >> 7, g = gw & 127, p = lane;
    const bf16* UG = (const bf16*)(a.ws + WS_UG); bf16* zb = (bf16*)(a.ws + WS_ZB);
    const float lr = fminf(a.lam_re[g * 64 + p], -1e-4f), li = a.lam_im[g * 64 + p], step = __expf(a.log_step[g]);
    const float mag = __expf(lr * step), lbr = mag * cosf(li * step), lbi = mag * sinf(li * step);
    const float den = lr * lr + li * li, nr = lbr - 1.0f, ni = lbi, cr = (nr * lr + ni * li) / den, ci = (ni * lr - nr * li) / den;
    float bbr[16], bbi[16], ccr[16], cci[16];
#pragma unroll
    for (int c = 0; c < 16; ++c) { const float br = a.b_re[(g * 64 + p) * 16 + c], bi = a.b_im[(g * 64 + p) * 16 + c]; bbr[c] = cr * br - ci * bi; bbi[c] = cr * bi + ci * br;
        ccr[c] = a.c_re[(g * 16 + c) * 64 + p]; cci[c] = a.c_im[(g * 16 + c) * 64 + p]; }
    const float dd = a.s5_d[g * 16 + (lane & 15)];
    float xr = 0.f, xi = 0.f;
    for (int t = 0; t < SEQ; ++t) { const size_t row = (size_t)b * SEQ + t;
        const v4u u0 = *(const v4u*)(UG + row * 4096 + 16 * g), u1 = *(const v4u*)(UG + row * 4096 + 16 * g + 8);
        float u[16];
#pragma unroll
        for (int e = 0; e < 4; ++e) { u[2 * e] = bflo(u0[e]); u[2 * e + 1] = bfhi(u0[e]); u[8 + 2 * e] = bflo(u1[e]); u[8 + 2 * e + 1] = bfhi(u1[e]); }
        float br = 0.f, bi = 0.f;
#pragma unroll
        for (int c = 0; c < 16; ++c) { br += bbr[c] * u[c]; bi += bbi[c] * u[c]; }
        const float nxr = lbr * xr - lbi * xi + br, nxi = lbr * xi + lbi * xr + bi; xr = nxr; xi = nxi;
        float ymine = 0.f, umine = 0.f;
#pragma unroll
        for (int c = 0; c < 16; ++c) { const float y = wave_sum(ccr[c] * xr - cci[c] * xi); if ((lane & 15) == c) { ymine = y; umine = u[c]; } }
        if (lane < 16) { const float y = ymine + dd * umine; zb[row * DM + 16 * g + lane] = (bf16)f2bf(gelu_tanh(y)); }
    }
}

typedef short s5_bf16x8 __attribute__((ext_vector_type(8)));
typedef float s5_f32x16 __attribute__((ext_vector_type(16)));
typedef float s5_f32x2 __attribute__((ext_vector_type(2)));
template <bool PASS2>
__device__ __forceinline__ void s5_pass(const bf16* UG, bf16* zb, LAS unsigned char* xl, int g, int seg0, int lane, const s5_bf16x8 (&Bf)[4], const s5_bf16x8 (&Cf)[4], f32x4 Dv,
                                        float lbr0, float lbi0, float lbr1, float lbi1, s5_f32x2& xr0, s5_f32x2& xi0, s5_f32x2& xr1, s5_f32x2& xi1, int nblk) {
    const int r = lane & 31, hl = lane >> 5, q4 = lane >> 4;
    const int rgA = 4 * (r >> 3) + (r & 3);
    const bf16* ap = UG + ((size_t)((rgA & 1) * SEQ + seg0 + 128 * ((r >> 2) & 1) + (rgA >> 1))) * 4096 + 16 * g + 8 * hl;
    s5_bf16x8 af = *(const s5_bf16x8*)ap;
    for (int blk = 0; blk < nblk; ++blk) {
        const s5_bf16x8 afn = *(const s5_bf16x8*)(ap + (size_t)((blk < nblk - 1 ? blk + 1 : blk) * 8) * 4096);
        v2u uu2[2] = {};
        if constexpr (PASS2) {
#pragma unroll
            for (int nblk = 0; nblk < 2; ++nblk) { const int i = 16 * nblk + (lane & 15), rg = 4 * (i >> 3) + (i & 3); const size_t rowg = (size_t)((rg & 1) * SEQ + seg0 + 128 * ((i >> 2) & 1) + blk * 8 + (rg >> 1));
                uu2[nblk] = *(const v2u*)(UG + rowg * 4096 + 16 * g + 4 * q4); } }
        s5_f32x16 acc[4];
#pragma unroll
        for (int nb = 0; nb < 4; ++nb) { acc[nb] = s5_f32x16{}; acc[nb] = __builtin_amdgcn_mfma_f32_32x32x16_bf16(af, Bf[nb], acc[nb], 0, 0, 0); }
#pragma unroll
        for (int k = 0; k < 8; ++k) {
            const s5_f32x2 b0r = {acc[0][2 * k], acc[0][2 * k + 1]}, b0i = {acc[2][2 * k], acc[2][2 * k + 1]}, b1r = {acc[1][2 * k], acc[1][2 * k + 1]}, b1i = {acc[3][2 * k], acc[3][2 * k + 1]};
            const s5_f32x2 n0r = lbr0 * xr0 - lbi0 * xi0 + b0r, n0i = lbr0 * xi0 + lbi0 * xr0 + b0i;
            const s5_f32x2 n1r = lbr1 * xr1 - lbi1 * xi1 + b1r, n1i = lbr1 * xi1 + lbi1 * xr1 + b1i;
            xr0 = n0r; xi0 = n0i; xr1 = n1r; xi1 = n1i;
            acc[0][2 * k] = n0r.x; acc[0][2 * k + 1] = n0r.y; acc[2][2 * k] = n0i.x; acc[2][2 * k + 1] = n0i.y; acc[1][2 * k] = n1r.x; acc[1][2 * k + 1] = n1r.y; acc[3][2 * k] = n1i.x; acc[3][2 * k + 1] = n1i.y;
        }
        if constexpr (PASS2) {
#pragma unroll
            for (int nb = 0; nb < 4; ++nb)
#pragma unroll
                for (int t = 0; t < 16; t += 2) { const int i = (t & 3) + 8 * (t >> 2) + 4 * hl; const unsigned pw = pk2(acc[nb][t], acc[nb][t + 1]);
                    *(LAS unsigned short*)(xl + i * 272 + (32 * nb + r) * 2) = (unsigned short)pw; *(LAS unsigned short*)(xl + (i + 1) * 272 + (32 * nb + r) * 2) = (unsigned short)(pw >> 16); }
            asm volatile("s_waitcnt lgkmcnt(0)" ::: "memory"); __builtin_amdgcn_wave_barrier();
#pragma unroll
            for (int nblk = 0; nblk < 2; ++nblk) {
                const int i = 16 * nblk + (lane & 15), rg = 4 * (i >> 3) + (i & 3);
                f32x4 y = {0.f, 0.f, 0.f, 0.f};
#pragma unroll
                for (int ks = 0; ks < 4; ++ks) { const s5_bf16x8 xf = *(const LAS s5_bf16x8*)(xl + i * 272 + 64 * ks + 16 * q4); y = __builtin_amdgcn_mfma_f32_16x16x32_bf16(Cf[ks], xf, y, 0, 0, 0); }
                const size_t rowg = (size_t)((rg & 1) * SEQ + seg0 + 128 * ((i >> 2) & 1) + blk * 8 + (rg >> 1));
                const v2u uu = uu2[nblk];
                const float z0 = gelu_tanh(y[0] + Dv[0] * bflo(uu.x)), z1 = gelu_tanh(y[1] + Dv[1] * bfhi(uu.x)), z2 = gelu_tanh(y[2] + Dv[2] * bflo(uu.y)), z3 = gelu_tanh(y[3] + Dv[3] * bfhi(uu.y));
                v2u w; w.x = pk2(z0, z1); w.y = pk2(z2, z3); *(v2u*)(zb + rowg * DM + 16 * g + 4 * q4) = w;
            }
            asm volatile("s_waitcnt lgkmcnt(0)" ::: "memory"); __builtin_amdgcn_wave_barrier();
        }
        af = afn;
    }
}
constexpr size_t WS_S5E = 56 * MiB;
__device__ __forceinline__ void phase_s5(const Args& a, LAS unsigned char* lds, int tid) {
    if (blockIdx.x >= 256) return;
    const int wave0 = __builtin_amdgcn_readfirstlane(tid >> 6);
    const int g = (blockIdx.x & 15) * 8 + wave0, seg_wg = blockIdx.x >> 4;
    const int lane = tid & 63, wave = wave0, r = lane & 31, hl = lane >> 5, q4 = lane >> 4, ch = lane & 15;
    const bf16* UG = (const bf16*)(a.ws + WS_UG); bf16* zb = (bf16*)(a.ws + WS_ZB);
    const float step = __expf(a.log_step[g]);
    float lbr[2], lbi[2]; s5_bf16x8 Bf[4], Cf[4];
#pragma unroll
    for (int s2 = 0; s2 < 2; ++s2) { const int p = r + 32 * s2;
        const float lr = fminf(a.lam_re[g * 64 + p], -1e-4f), li = a.lam_im[g * 64 + p];
        const float mag = __expf(lr * step); lbr[s2] = mag * cosf(li * step); lbi[s2] = mag * sinf(li * step);
        const float den = lr * lr + li * li, nr = lbr[s2] - 1.0f, ni = lbi[s2], cr = (nr * lr + ni * li) / den, ci = (ni * lr - nr * li) / den;
        const f32x4 br0 = *(const f32x4*)(a.b_re + (size_t)(g * 64 + p) * 16 + 8 * hl), br1 = *(const f32x4*)(a.b_re + (size_t)(g * 64 + p) * 16 + 8 * hl + 4);
        const f32x4 bi0 = *(const f32x4*)(a.b_im + (size_t)(g * 64 + p) * 16 + 8 * hl), bi1 = *(const f32x4*)(a.b_im + (size_t)(g * 64 + p) * 16 + 8 * hl + 4);
#pragma unroll
        for (int j = 0; j < 8; ++j) { const float br = j < 4 ? br0[j & 3] : br1[j & 3], bi = j < 4 ? bi0[j & 3] : bi1[j & 3];
            Bf[s2][j] = (short)f2bf(cr * br - ci * bi); Bf[2 + s2][j] = (short)f2bf(cr * bi + ci * br); } }
#pragma unroll
    for (int ks = 0; ks < 4; ++ks) { const int st = (ks & 1) * 32 + 8 * q4; const float* src = (ks < 2 ? a.c_re : a.c_im) + (size_t)(g * 16 + ch) * 64 + st;
        const f32x4 c0 = *(const f32x4*)src, c1 = *(const f32x4*)(src + 4);
#pragma unroll
        for (int j = 0; j < 8; ++j) { const float v = j < 4 ? c0[j & 3] : c1[j & 3]; Cf[ks][j] = (short)f2bf(ks < 2 ? v : -v); } }
    const f32x4 Dv = *(const f32x4*)(a.s5_d + g * 16 + 4 * q4);
    LAS unsigned char* xl = lds + wave * 8704; float* Ef = (float*)(a.ws + WS_S5E) + (size_t)g * 32 * 32 * 8;
    const int seg = seg_wg, subseg = 2 * seg + hl;
    s5_f32x2 xr0 = {0.f, 0.f}, xi0 = {0.f, 0.f}, xr1 = {0.f, 0.f}, xi1 = {0.f, 0.f};
    s5_pass<false>(UG, zb, xl, g, seg * 256, lane, Bf, Cf, Dv, lbr[0], lbi[0], lbr[1], lbi[1], xr0, xi0, xr1, xi1, 16);
    {   unsigned long long* E64 = (unsigned long long*)(Ef + (size_t)(subseg * 32 + r) * 8);
        __hip_atomic_store(E64, ((unsigned long long)__float_as_uint(xr0.y) << 32) | __float_as_uint(xr0.x), __ATOMIC_RELAXED, __HIP_MEMORY_SCOPE_AGENT);
        __hip_atomic_store(E64 + 1, ((unsigned long long)__float_as_uint(xi0.y) << 32) | __float_as_uint(xi0.x), __ATOMIC_RELAXED, __HIP_MEMORY_SCOPE_AGENT);
        __hip_atomic_store(E64 + 2, ((unsigned long long)__float_as_uint(xr1.y) << 32) | __float_as_uint(xr1.x), __ATOMIC_RELAXED, __HIP_MEMORY_SCOPE_AGENT);
        __hip_atomic_store(E64 + 3, ((unsigned long long)__float_as_uint(xi1.y) << 32) | __float_as_uint(xi1.x), __ATOMIC_RELAXED, __HIP_MEMORY_SCOPE_AGENT); }
    asm volatile("s_waitcnt vmcnt(0)" ::: "memory"); __syncthreads();
    unsigned* cnt = (unsigned*)(a.ws + WS_BAR + 18432) + 16 * (blockIdx.x & 15);
    if (tid == 0) { __hip_atomic_fetch_add(cnt, 1u, __ATOMIC_RELAXED, __HIP_MEMORY_SCOPE_AGENT);
        unsigned sp = 0; while (__hip_atomic_load(cnt, __ATOMIC_RELAXED, __HIP_MEMORY_SCOPE_AGENT) < 16u) { __builtin_amdgcn_s_sleep(2); if (++sp > (1u << 20)) break; }
        __builtin_amdgcn_fence(__ATOMIC_ACQUIRE, "agent"); asm volatile("s_waitcnt vmcnt(0)" ::: "memory"); }
    __syncthreads();
    {   float p0r = lbr[0], p0i = lbi[0], p1r = lbr[1], p1i = lbi[1];
#pragma unroll
        for (int s = 0; s < 7; ++s) { const float a0 = p0r * p0r - p0i * p0i, b0 = 2.f * p0r * p0i, a1 = p1r * p1r - p1i * p1i, b1 = 2.f * p1r * p1i; p0r = a0; p0i = b0; p1r = a1; p1i = b1; }
        xr0 = (s5_f32x2){0.f, 0.f}; xi0 = xr0; xr1 = xr0; xi1 = xr0;
        for (int s = 0; s < 2 * seg + 1; ++s) { if (s < subseg) { const f32x4 e0 = *(const f32x4*)(Ef + (size_t)(s * 32 + r) * 8), e1 = *(const f32x4*)(Ef + (size_t)(s * 32 + r) * 8 + 4);
            const s5_f32x2 er0 = {e0[0], e0[1]}, ei0 = {e0[2], e0[3]}, er1 = {e1[0], e1[1]}, ei1 = {e1[2], e1[3]};
            const s5_f32x2 n0r = p0r * xr0 - p0i * xi0 + er0, n0i = p0r * xi0 + p0i * xr0 + ei0, n1r = p1r * xr1 - p1i * xi1 + er1, n1i = p1r * xi1 + p1i * xr1 + ei1;
            xr0 = n0r; xi0 = n0i; xr1 = n1r; xi1 = n1i; } }
        s5_pass<true>(UG, zb, xl, g, seg * 256, lane, Bf, Cf, Dv, lbr[0], lbi[0], lbr[1], lbi[1], xr0, xi0, xr1, xi1, 16);
    }
}
constexpr size_t WS_S5E_DUMMY = 0;

typedef short g_bf16x8 __attribute__((ext_vector_type(8)));
typedef float g_f32x16 __attribute__((ext_vector_type(16)));
constexpr size_t WS_QT = 44 * MiB, WS_OINTRA = 52 * MiB, WS_SINT = 221 * MiB, WS_DECAY = WS_PART2;
__device__ __forceinline__ int g_irow(int reg, int hl) { return (reg & 3) + 8 * (reg >> 2) + 4 * hl; }
__device__ __forceinline__ void gla_pass_a(const Args& a, LAS unsigned char* lds, int unit, int tid) {
    const bf16* P = (const bf16*)(a.ws + WS_P); const float* small = (const float*)(a.ws + WS_SMALL);
    bf16* qtg = (bf16*)(a.ws + WS_QT); unsigned* oin = (unsigned*)(a.ws + WS_OINTRA); bf16* kvt = (bf16*)a.out; float* decay = (float*)(a.ws + WS_DECAY);
    const int bh = unit >> 6, n = unit & 63, b = bh >> 2, h = bh & 3; const size_t R0 = (size_t)b * SEQ + 64 * n;
    LAS bf16* QT = (LAS bf16*)lds; LAS bf16* KT = (LAS bf16*)(lds + 17408); LAS bf16* KH = (LAS bf16*)(lds + 34816); LAS bf16* VT = (LAS bf16*)(lds + 53248); LAS bf16* AT = (LAS bf16*)(lds + 90112); LAS float* PART = (LAS float*)(lds + 99328);
    const int lane = tid & 63, w = __builtin_amdgcn_readfirstlane(tid >> 6), r = lane & 31, hl = lane >> 5;
    __syncthreads();
    {
        const int col = tid & 127, qtr = tid >> 7; const float ab = a.alpha_b[128 * h + col]; float au[16];
#pragma unroll
        for (int rr = 0; rr < 16; ++rr) au[rr] = a.alpha_up[rr * 512 + 128 * h + col];
        bf16 qraw[16], kraw[16];
#pragma unroll
        for (int t = 0; t < 16; ++t) { const size_t row = R0 + 16 * qtr + t; qraw[t] = P[row * NP + C_GQ + 128 * h + col]; kraw[t] = P[row * NP + C_GK + 128 * h + col]; }
        float cs[16]; float run = 0.f;
#pragma unroll
        for (int t = 0; t < 16; ++t) { const size_t row = R0 + 16 * qtr + t; const f32x4* sp = (const f32x4*)(small + row * 32); float z = ab;
#pragma unroll
            for (int q = 0; q < 4; ++q) { const f32x4 s4 = sp[q]; z += s4[0] * au[4 * q] + s4[1] * au[4 * q + 1] + s4[2] * au[4 * q + 2] + s4[3] * au[4 * q + 3]; }
            run += logsigmoid_f(z) * (1.0f / 16.0f); cs[t] = run; }
        PART[qtr * 128 + col] = run;
        {   const int dv = tid & 255, half = tid >> 8;
#pragma unroll 8
            for (int t = 0; t < 32; t += 2) { const int tok = 32 * half + t; const unsigned lo = P[(R0 + tok) * NP + C_GV + 256 * h + dv], hi2 = P[(R0 + tok + 1) * NP + C_GV + 256 * h + dv];
                *(LAS unsigned*)(VT + dv * 72 + tok) = lo | (hi2 << 16); } }
        __syncthreads();
        float pre = 0.f, tot = 0.f;
#pragma unroll
        for (int q = 0; q < 4; ++q) { const float v = PART[q * 128 + col]; tot += v; if (q < qtr) pre += v; }
        const float qscale = 0.08838834764831845f;
#pragma unroll
        for (int t = 0; t < 16; t += 2) { float khv[2];
#pragma unroll
            for (int u2 = 0; u2 < 2; ++u2) { const int tok = 16 * qtr + t + u2; const size_t row = R0 + tok; const float bb = pre + cs[t + u2];
                const float qv = bf2f(qraw[t + u2]) * qscale * __expf(bb), kv = bf2f(kraw[t + u2]);
                const bf16 qb = (bf16)f2bf(qv);
                QT[tok * 136 + col] = qb; KT[tok * 136 + col] = (bf16)f2bf(kv * __expf(-bb)); khv[u2] = kv * __expf(tot - bb); qtg[row * 512 + 128 * h + col] = qb; }
            *(LAS unsigned*)(KH + col * 72 + 16 * qtr + t) = pk2(khv[0], khv[1]); }
        if (qtr == 0) decay[(size_t)unit * 128 + col] = __expf(tot);
    }
    __syncthreads();
    if (w < 4) {
        const int bi = w >> 1, bj = w & 1;
        if (bi == 0 && bj == 1) {
#pragma unroll
            for (int reg = 0; reg < 16; ++reg) AT[g_irow(reg, hl) * 72 + 32 + r] = 0;
        } else {
            g_f32x16 acc = g_f32x16{};
#pragma unroll
            for (int ks = 0; ks < 8; ++ks) { const g_bf16x8 af = *(const LAS g_bf16x8*)(QT + (32 * bi + r) * 136 + 16 * ks + 8 * hl), bf = *(const LAS g_bf16x8*)(KT + (32 * bj + r) * 136 + 16 * ks + 8 * hl);
                acc = __builtin_amdgcn_mfma_f32_32x32x16_bf16(af, bf, acc, 0, 0, 0); }
#pragma unroll
            for (int reg = 0; reg < 16; ++reg) { const int i = 32 * bi + g_irow(reg, hl), j = 32 * bj + r; AT[i * 72 + j] = (bf16)f2bf(j <= i ? acc[reg] : 0.f); }
        }
    }
    __syncthreads();
    {
#pragma unroll
        for (int bi = 0; bi < 2; ++bi) { g_f32x16 acc = g_f32x16{};
#pragma unroll
            for (int ks = 0; ks < 4; ++ks) { if (bi == 0 && ks >= 2) continue;
                const g_bf16x8 af = *(const LAS g_bf16x8*)(AT + (32 * bi + r) * 72 + 16 * ks + 8 * hl), bf = *(const LAS g_bf16x8*)(VT + (32 * w + r) * 72 + 16 * ks + 8 * hl);
                acc = __builtin_amdgcn_mfma_f32_32x32x16_bf16(bf, af, acc, 0, 0, 0); }
            v4u o0, o1;
#pragma unroll
            for (int e = 0; e < 4; ++e) { o0[e] = pk2(acc[2 * e], acc[2 * e + 1]); o1[e] = pk2(acc[8 + 2 * e], acc[8 + 2 * e + 1]); }
            v4u* op = (v4u*)(oin + ((size_t)((unit * 8 + w) * 2 + bi) * 64 + lane) * 8); op[0] = o0; op[1] = o1; }
        g_bf16x8 av[4];
#pragma unroll
        for (int ks = 0; ks < 4; ++ks) av[ks] = *(const LAS g_bf16x8*)(VT + (32 * w + r) * 72 + 16 * ks + 8 * hl);
#pragma unroll
        for (int nb = 0; nb < 4; ++nb) { g_f32x16 acc = g_f32x16{};
#pragma unroll
            for (int ks = 0; ks < 4; ++ks) { const g_bf16x8 bf = *(const LAS g_bf16x8*)(KH + (32 * nb + r) * 72 + 16 * ks + 8 * hl); acc = __builtin_amdgcn_mfma_f32_32x32x16_bf16(bf, av[ks], acc, 0, 0, 0); }
#pragma unroll
            for (int g4 = 0; g4 < 4; ++g4) { v2u o; o.x = pk2(acc[4 * g4], acc[4 * g4 + 1]); o.y = pk2(acc[4 * g4 + 2], acc[4 * g4 + 3]);
                *(v2u*)(kvt + ((size_t)unit * 256 + 32 * w + r) * 128 + 32 * nb + 8 * g4 + 4 * hl) = o; } }
    }
}
__device__ __forceinline__ void phase_gla_b(const Args& a, int tid, int gw, int NG) {
    const bf16* kvt = (const bf16*)a.out; const float* decay = (const float*)(a.ws + WS_DECAY); bf16* sint = (bf16*)(a.ws + WS_SINT);
    for (size_t qi = (size_t)gw * NTHR + tid; qi < (size_t)2 * 32768; qi += (size_t)NG * NTHR) {
        const size_t idx = qi * 4; const int bh = (int)(idx >> 15), e = (int)(idx & 32767);
        float s0 = 0.f, s1 = 0.f, s2 = 0.f, s3 = 0.f;
#pragma unroll 8
        for (int n = 0; n < 64; ++n) { const size_t unit = (size_t)bh * 64 + n;
            v2u o; o.x = pk2(s0, s1); o.y = pk2(s2, s3); *(v2u*)(sint + unit * 32768 + e) = o;
            const f32x4 d = *(const f32x4*)(decay + unit * 128 + (e & 127)); const v2u kw = *(const v2u*)(kvt + unit * 32768 + e);
            s0 = d[0] * s0 + bflo(kw.x); s1 = d[1] * s1 + bfhi(kw.x); s2 = d[2] * s2 + bflo(kw.y); s3 = d[3] * s3 + bfhi(kw.y); }
    }
}
__device__ __forceinline__ void phase_gla_b2(const Args& a, int tid, int gw, int NG) {
    typedef float f32x2v __attribute__((ext_vector_type(2)));
    const bf16* kvt = (const bf16*)a.out; const float* decay = (const float*)(a.ws + WS_DECAY); bf16* sint = (bf16*)(a.ws + WS_SINT);
    for (size_t pi = (size_t)gw * NTHR + tid; pi < (size_t)4 * 32768; pi += (size_t)NG * NTHR) {
        const size_t idx = pi * 2; const int bh = (int)(idx >> 15), e = (int)(idx & 32767);
        float s0 = 0.f, s1 = 0.f;
#pragma unroll 8
        for (int n = 0; n < 64; ++n) { const size_t unit = (size_t)bh * 64 + n;
            *(unsigned*)(sint + unit * 32768 + e) = pk2(s0, s1);
            const f32x2v d = *(const f32x2v*)(decay + unit * 128 + (e & 127)); const unsigned kw = *(const unsigned*)(kvt + unit * 32768 + e);
            s0 = d.x * s0 + bflo(kw); s1 = d.y * s1 + bfhi(kw); }
    }
}
__device__ __forceinline__ void gla_pass_c(const Args& a, LAS unsigned char* lds, int unit, int tid) {
    const bf16* P = (const bf16*)(a.ws + WS_P); const bf16* qtg = (const bf16*)(a.ws + WS_QT); const unsigned* oin = (const unsigned*)(a.ws + WS_OINTRA); const bf16* sint = (const bf16*)(a.ws + WS_SINT); bf16* mix = (bf16*)(a.ws + WS_MIX);
    const int bh = unit >> 6, n = unit & 63, b = bh >> 2, h = bh & 3; const size_t R0 = (size_t)b * SEQ + 64 * n;
    const int lane = tid & 63, w = __builtin_amdgcn_readfirstlane(tid >> 6), r = lane & 31, hl = lane >> 5;
    LAS float* RED = (LAS float*)lds; LAS float* RSTD = RED + 1024;
    g_f32x16 acc[2];
#pragma unroll
    for (int bi = 0; bi < 2; ++bi) { const v4u* op = (const v4u*)(oin + ((size_t)((unit * 8 + w) * 2 + bi) * 64 + lane) * 8); const v4u o0 = op[0], o1 = op[1];
#pragma unroll
        for (int e = 0; e < 4; ++e) { acc[bi][2 * e] = bflo(o0[e]); acc[bi][2 * e + 1] = bfhi(o0[e]); acc[bi][8 + 2 * e] = bflo(o1[e]); acc[bi][8 + 2 * e + 1] = bfhi(o1[e]); } }
    v2u gtv[2][4]; f32x4 hgv[4];
#pragma unroll
    for (int g4 = 0; g4 < 4; ++g4) { const int dv0 = 32 * w + 8 * g4 + 4 * hl; hgv[g4] = *(const f32x4*)(a.head_g + 256 * h + dv0);
#pragma unroll
        for (int bi = 0; bi < 2; ++bi) gtv[bi][g4] = *(const v2u*)(P + (R0 + 32 * bi + r) * NP + C_GG + 256 * h + dv0); }
#pragma unroll
    for (int ks = 0; ks < 8; ++ks) { const g_bf16x8 sf = *(const g_bf16x8*)(sint + ((size_t)unit * 256 + 32 * w + r) * 128 + 16 * ks + 8 * hl);
#pragma unroll
        for (int bi = 0; bi < 2; ++bi) { const g_bf16x8 qf = *(const g_bf16x8*)(qtg + (R0 + 32 * bi + r) * 512 + 128 * h + 16 * ks + 8 * hl); acc[bi] = __builtin_amdgcn_mfma_f32_32x32x16_bf16(sf, qf, acc[bi], 0, 0, 0); } }
    __syncthreads();
#pragma unroll
    for (int bi = 0; bi < 2; ++bi) { float s = 0.f;
#pragma unroll
        for (int reg = 0; reg < 16; ++reg) s += acc[bi][reg] * acc[bi][reg];
        RED[(w * 2 + hl) * 64 + 32 * bi + r] = s; }
    __syncthreads();
    if (tid < 64) { float t = 0.f;
#pragma unroll
        for (int q = 0; q < 16; ++q) t += RED[q * 64 + tid];
        RSTD[tid] = rsqrtf(t * (1.0f / 256.0f) + EPS); }
    __syncthreads();
#pragma unroll
    for (int bi = 0; bi < 2; ++bi) { const size_t row = R0 + 32 * bi + r; const float rs = RSTD[32 * bi + r];
#pragma unroll
        for (int g4 = 0; g4 < 4; ++g4) { const int dv0 = 32 * w + 8 * g4 + 4 * hl;
            const v2u gt = gtv[bi][g4]; const f32x4 hg = hgv[g4];
            v2u o; o.x = pk2(acc[bi][4 * g4] * rs * hg[0] * silu_f(bflo(gt.x)), acc[bi][4 * g4 + 1] * rs * hg[1] * silu_f(bfhi(gt.x)));
            o.y = pk2(acc[bi][4 * g4 + 2] * rs * hg[2] * silu_f(bflo(gt.y)), acc[bi][4 * g4 + 3] * rs * hg[3] * silu_f(bfhi(gt.y)));
            *(v2u*)(mix + row * DM + 256 * h + dv0) = o; } }
}
__device__ __forceinline__ void phase_gla_c(const Args& a, LAS unsigned char* lds, int tid, int G) {
    for (int unit = blockIdx.x; unit < 512; unit += G) gla_pass_c(a, lds, unit, tid);
}
__device__ __forceinline__ void phase_final_norm(const Args& a, int tid, int G) {
    const int lane = tid & 63, wave = tid >> 6; const int gw = blockIdx.x * NWAVES + wave, NGW = G * NWAVES;
    const float* part2 = (const float*)(a.ws + WS_PART2);
    for (int m = gw; m < MROWS; m += NGW) {
        float s = (lane < 32) ? part2[(size_t)m * 32 + lane] : 0.f; s = wave_sum(s);
        const float r = rsqrtf(s * (1.0f / DM) + EPS);
        f32x4* xr = (f32x4*)(a.out + (size_t)m * DM) + lane; const f32x4* gr = (const f32x4*)a.final_g + lane;
#pragma unroll
        for (int j = 0; j < 8; ++j) { f32x4 v = xr[64 * j]; const f32x4 g = gr[64 * j]; v[0] *= r * g[0]; v[1] *= r * g[1]; v[2] *= r * g[2]; v[3] *= r * g[3]; xr[64 * j] = v; }
    }
}

constexpr int NPHASE = 11;
__global__ void __launch_bounds__(NTHR, 2) trunk_fwd(Args a) {
    extern __shared__ __attribute__((aligned(16))) unsigned char lds_raw[];
    LAS unsigned char* lds = (LAS unsigned char*)lds_raw;
    cg::grid_group grid = cg::this_grid();
    const int tid = threadIdx.x, G = gridDim.x;
    const int lo = a.ph_lo, hi = a.ph_hi;
#define IN(k) (lo <= (k) && (k) < hi)
#define SEAM(k) do { if (IN(k) && IN((k) + 1)) { if (hi > 1000) grid.sync();   xcd_barrier(bar); } } while (0)
    unsigned char* ws = a.ws;
    volatile LAS unsigned* bst = (volatile LAS unsigned*)(lds + LDS_BYTES - 16);
    if (tid < 4) bst[tid] = 0u;
    __syncthreads();
    XcdBarrier bar; bar.bar = (unsigned*)(ws + WS_BAR); bar.x = 0; bar.st = bst;
    if (hi - lo > 1) bar = xcd_barrier_post((unsigned*)(ws + WS_BAR), bst);
    if (IN(0)) { phase_prologue(a, lds, tid, G); } SEAM(0);
    if (IN(1)) {
        pg8::Gemm g{(const pg8::bf16_t*)(ws + WS_XB), (const pg8::bf16_t*)(ws + WS_WIN), MROWS, NP, DM}; pg8::StaticOrder S; S.init(MROWS, NP, G, (int)blockIdx.x);
        pg8::EpiScaleBf16 E{(pg8::bf16_t*)(ws + WS_P), NP, (const float*)(ws + WS_RSTD0), nullptr, C_SMALL / 256, (float*)(ws + WS_SMALL), (float*)(ws + WS_BAR + 20480), C_FQ / 256};
        pg8::gemm_phase<pg8::EpiScaleBf16, pg8::StaticOrder, true, true>(lds, g, S, E);
        { const int nwg = (MROWS / 256) * (NP / 256), rem = nwg % G, first = rem, nidle = G - first;
          if ((int)blockIdx.x >= first) { __syncthreads(); prologue_late(a, lds, tid, (int)blockIdx.x - first, nidle); } }
    } SEAM(1);
    if (IN(3)) { phase_m1(a, lds, tid, G); } SEAM(3);
    if (IN(4)) { phase_m2(a, lds_raw, tid, G); } SEAM(4);
    if (IN(5)) { phase_gla_c(a, lds, tid, G); } SEAM(5);
    if (IN(6)) {
        pg8::Gemm g{(const pg8::bf16_t*)(ws + WS_MIX), (const pg8::bf16_t*)(ws + WS_WOUT), MROWS, DM, DM}; pg8::StaticOrder S; S.init(MROWS, DM, G, (int)blockIdx.x);
        pg8::EpiResid E{a.x, nullptr, (pg8::bf16_t*)(ws + WS_X1), (float*)(ws + WS_PART1), DM};
        pg8::gemm_phase<pg8::EpiResid, pg8::StaticOrder, true, true>(lds, g, S, E);
    } SEAM(6);
    if (IN(7)) {
        pg8::Gemm g{(const pg8::bf16_t*)(ws + WS_X1), (const pg8::bf16_t*)(ws + WS_WCIN), MROWS, 4096, DM}; pg8::StaticOrder S; S.init(MROWS, 4096, G, (int)blockIdx.x);
        pg8::EpiScaleBf16 E{(pg8::bf16_t*)(ws + WS_UG), 4096, nullptr, (const float*)(ws + WS_PART1), -1, nullptr, nullptr, 0};
        pg8::gemm_phase<pg8::EpiScaleBf16, pg8::StaticOrder, true, true>(lds, g, S, E);
    } SEAM(7);
    if (IN(8)) { phase_s5(a, lds, tid); } SEAM(8);
    if (IN(9)) {
        pg8::Gemm g{(const pg8::bf16_t*)(ws + WS_ZB), (const pg8::bf16_t*)(ws + WS_WGLU), MROWS, DM, DM}; pg8::StaticOrder S; S.init(MROWS, DM, G, (int)blockIdx.x);
        pg8::EpiGlu E{(const pg8::bf16_t*)(ws + WS_ZB), (const pg8::bf16_t*)(ws + WS_UG), a.glu_b, (pg8::bf16_t*)(ws + WS_TB)};
        pg8::gemm_phase<pg8::EpiGlu, pg8::StaticOrder, true, true>(lds, g, S, E);
    } SEAM(9);
    if (IN(10)) {
        pg8::Gemm g{(const pg8::bf16_t*)(ws + WS_TB), (const pg8::bf16_t*)(ws + WS_WCOUT), MROWS, DM, DM}; pg8::StaticOrder S; S.init(MROWS, DM, G, (int)blockIdx.x);
        pg8::EpiFinalNorm E{(const pg8::bf16_t*)(ws + WS_X1), a.out, (float*)(ws + WS_PART2), (unsigned*)(ws + WS_BAR + 16384), a.final_g, DM};
        pg8::gemm_phase<pg8::EpiFinalNorm, pg8::StaticOrder, false, true>(lds, g, S, E);
    }
#undef IN
#undef SEAM
}

#ifndef MK_ONE_LAUNCH
#define MK_ONE_LAUNCH 1
#endif
extern "C" void kernel_launch(void* const* d_in, const int* in_sizes, int n_in, void* d_out, int out_size, void* d_ws, size_t ws_size, hipStream_t stream) {
    static int grid = 0;
    if (grid == 0) {
        int dev = 0, cus = 0, per_cu = 0;
        if (hipGetDevice(&dev) != hipSuccess || hipDeviceGetAttribute(&cus, hipDeviceAttributeMultiprocessorCount, dev) != hipSuccess) { fprintf(stderr, "kernel_launch: device query failed\n"); grid = -1; return; }
        if (hipFuncSetAttribute((const void*)trunk_fwd, hipFuncAttributeMaxDynamicSharedMemorySize, LDS_BYTES) != hipSuccess) { fprintf(stderr, "kernel_launch: hipFuncSetAttribute failed\n"); grid = -1; return; }
        if (hipOccupancyMaxActiveBlocksPerMultiprocessor(&per_cu, (const void*)trunk_fwd, NTHR, LDS_BYTES) != hipSuccess || per_cu < 1) { fprintf(stderr, "kernel_launch: occupancy query says %d\n", per_cu); per_cu = 1; }
        (void)hipGetLastError();
        grid = cus;
        if (ws_size < 256 * MiB) { fprintf(stderr, "kernel_launch: workspace too small (%zu)\n", ws_size); grid = -1; return; }
    }
    if (grid < 0) return;
    if (hipMemsetAsync((char*)d_ws + WS_BAR, 0, 24576, stream) != hipSuccess) { fprintf(stderr, "kernel_launch: memset of barrier words failed\n"); return; }
    Args a{};
    const float** ap = (const float**)&a;
    for (int i = 0; i < 22; ++i) ap[i] = (const float*)d_in[i];
    a.out = (float*)d_out; a.ws = (unsigned char*)d_ws;
#if MK_ONE_LAUNCH
    a.ph_lo = 0; a.ph_hi = NPHASE;
    void* args[] = {&a};
    hipError_t e = hipLaunchCooperativeKernel((const void*)trunk_fwd, dim3(grid), dim3(NTHR), args, LDS_BYTES, stream);
    if (e != hipSuccess) fprintf(stderr, "cooperative launch failed: %s (grid %d)\n", hipGetErrorString(e), grid);
#else
    for (int p = 0; p < NPHASE; ++p) { a.ph_lo = p; a.ph_hi = p + 1; hipLaunchKernelGGL(trunk_fwd, dim3(grid), dim3(NTHR), LDS_BYTES, stream, a); }
#endif
}
```

```cpp
#include <hip/hip_runtime.h>
#include <hip/hip_cooperative_groups.h>
#include <cstdio>
#include <cstdint>
namespace cg = cooperative_groups;
namespace pg8 {
#define PG8_LAS __attribute__((address_space(3)))
typedef unsigned short bf16_t;
typedef short bf16x8 __attribute__((ext_vector_type(8)));
typedef float f32x4 __attribute__((ext_vector_type(4)));
typedef unsigned u32x4 __attribute__((ext_vector_type(4)));
constexpr int BM = 256, BK = 64, HALF = 128, HTB = HALF * BK * 2  , STAGE_BYTES = 8 * HTB, NXCD = 8, WGM = 8;

__host__ __device__ __forceinline__ int lds_byte(int r, int c) { const int st = (r >> 4) * 2 + (c >> 5), rr = r & 15, cc = c & 31, ob = rr * 64 + cc * 2; return st * 1024 + (ob ^ (((ob >> 9) & 1) << 5)); }
__host__ __device__ __forceinline__ void stage_rc(int b, int& R, int& C) { const int st = b / 1024, sb = b % 1024, swz = sb ^ (((sb >> 9) & 1) << 5); R = (st >> 1) * 16 + swz / 64; C = (st & 1) * 32 + (swz % 64) / 2; }
__host__ __device__ __forceinline__ int perm32(int rho) { const int n = rho >> 4, i = rho & 15; return 8 * (i >> 2) + 4 * n + (i & 3); }

struct Unit { int pm, pn; };
struct Gemm { const bf16_t* A; const bf16_t* Bt; int M, N, K; };

struct StaticOrder {
    int nM, nN, nwg, G, c;
    __host__ __device__ void init(int M, int N, int G_, int c_) { nM = M / BM; nN = N / BM; nwg = nM * nN; G = G_; c = c_; }
    __host__ __device__ bool next(int i, Unit& u) const {
        const long L = (long)i * G + c; if (L >= nwg) return false;
        int wgid = (int)L; { const int q = nwg / NXCD, r = nwg % NXCD, xcd = wgid % NXCD, off = wgid / NXCD; wgid = (xcd < r ? xcd * (q + 1) : r * (q + 1) + (xcd - r) * q) + off; }
        const int nig = WGM * nN, gid = wgid / nig, fm = gid * WGM, gsz = (nM - fm) < WGM ? (nM - fm) : WGM;
        u.pm = fm + ((wgid % nig) % gsz); u.pn = (wgid % nig) / gsz; return true;
    }
    __device__ __forceinline__ void a_ready(const Unit&) const {}
    __device__ __forceinline__ void done(const Unit&) const {}
};

__device__ __forceinline__ unsigned cvt_pk_bf16(float lo, float hi) { unsigned r; asm volatile("v_cvt_pk_bf16_f32 %0, %1, %2" : "=v"(r) : "v"(lo), "v"(hi)); return r; }
typedef float f32x2 __attribute__((ext_vector_type(2)));
__device__ __forceinline__ float sigmoid_f(float x) { return __builtin_amdgcn_rcpf(1.0f + __expf(-x)); }
__device__ __forceinline__ float silu_f(float x) { return x * __builtin_amdgcn_rcpf(1.0f + __expf(-x)); }
__device__ __forceinline__ float bf2f(unsigned short b) { return __uint_as_float(((unsigned)b) << 16); }
struct EpiScaleBf16 {
    static constexpr bool PERM = true, AFTER_DRAIN = false;
    bf16_t* O; int ldc; const float* rstd; const float* part; int small_pn; float* smallbuf; float* nmax; int q_pn0;
    __device__ __forceinline__ void operator()(const f32x4 (&acc)[2][2][4][2], const Unit& u, int wr, int wc, int fr, int fq) const {
        const int row0 = u.pm * BM + wr * 64 + fr, col0 = u.pn * BM + wc * 32 + 8 * fq;
        const bool nrm = nmax != nullptr && u.pn >= q_pn0 && u.pn < q_pn0 + 8; float rmx[2] = {0.f, 0.f};
#pragma unroll
        for (int ai = 0; ai < 2; ++ai)
#pragma unroll
            for (int m = 0; m < 4; ++m) {
                const int row = row0 + ai * HALF + m * 16; float s;
                if (rstd) s = rstd[row];
                else { const f32x4 a = *(const f32x4*)(part + (size_t)row * 32 + 8 * fq), b = *(const f32x4*)(part + (size_t)row * 32 + 8 * fq + 4);
                    float t = ((a[0] + a[1]) + (a[2] + a[3])) + ((b[0] + b[1]) + (b[2] + b[3])); t += __shfl_xor(t, 16); t += __shfl_xor(t, 32); s = rsqrtf(t * (1.0f / 2048.0f) + 1e-6f); }
                bf16_t* rowp = O + (size_t)row * ldc + col0;
#pragma unroll
                for (int bj = 0; bj < 2; ++bj) { const f32x4 v0 = acc[ai][bj][m][0] * s, v1 = acc[ai][bj][m][1] * s;
                    u32x4 w; w.x = cvt_pk_bf16(v0[0], v0[1]); w.y = cvt_pk_bf16(v0[2], v0[3]); w.z = cvt_pk_bf16(v1[0], v1[1]); w.w = cvt_pk_bf16(v1[2], v1[3]);
                    *(u32x4*)(rowp + bj * HALF) = w;
                    if (nrm) { float ss = ((v0[0] * v0[0] + v0[1] * v0[1]) + (v0[2] * v0[2] + v0[3] * v0[3])) + ((v1[0] * v1[0] + v1[1] * v1[1]) + (v1[2] * v1[2] + v1[3] * v1[3])); ss += __shfl_xor(ss, 16); ss += __shfl_xor(ss, 32); rmx[bj] = fmaxf(rmx[bj], ss); }
                    if (u.pn == small_pn && bj == 0 && wc == 0) { *(f32x4*)(smallbuf + (size_t)row * 32 + 8 * fq) = v0; *(f32x4*)(smallbuf + (size_t)row * 32 + 8 * fq + 4) = v1; } }
            }
        if (nrm) { const int t = u.pn - q_pn0;
#pragma unroll
            for (int bj = 0; bj < 2; ++bj) { float r = rmx[bj]; r = fmaxf(r, __shfl_xor(r, 1)); r = fmaxf(r, __shfl_xor(r, 2)); r = fmaxf(r, __shfl_xor(r, 4)); r = fmaxf(r, __shfl_xor(r, 8));
                if (fr == 0 && fq == 0) __hip_atomic_fetch_max((unsigned*)nmax + ((((u.pm >> 4) * 8 + 2 * (t & 3) + bj) * 2 + (t >> 2)) * 4 + wc), __float_as_uint(r), __ATOMIC_RELAXED, __HIP_MEMORY_SCOPE_AGENT); } }
    }
};
struct EpiResid {
    static constexpr bool PERM = true, AFTER_DRAIN = false;
    const float* base; float* out; bf16_t* outb; float* part; int ldc;
    __device__ __forceinline__ void operator()(const f32x4 (&acc)[2][2][4][2], const Unit& u, int wr, int wc, int fr, int fq) const {
        const int row0 = u.pm * BM + wr * 64 + fr, col0 = u.pn * BM + wc * 32 + 8 * fq;
#pragma unroll
        for (int ai = 0; ai < 2; ++ai)
#pragma unroll
            for (int m = 0; m < 4; ++m) {
                const int row = row0 + ai * HALF + m * 16; const size_t off = (size_t)row * ldc + col0; float ss = 0.f;
#pragma unroll
                for (int bj = 0; bj < 2; ++bj) { const size_t o = off + bj * HALF;
                    const f32x4 v0 = acc[ai][bj][m][0] + __builtin_nontemporal_load((const f32x4*)(base + o)), v1 = acc[ai][bj][m][1] + __builtin_nontemporal_load((const f32x4*)(base + o + 4));
                    if (out) { *(f32x4*)(out + o) = v0; *(f32x4*)(out + o + 4) = v1; }
                    ss += ((v0[0] * v0[0] + v0[1] * v0[1]) + (v0[2] * v0[2] + v0[3] * v0[3])) + ((v1[0] * v1[0] + v1[1] * v1[1]) + (v1[2] * v1[2] + v1[3] * v1[3]));
                    if (outb) { u32x4 w; w.x = cvt_pk_bf16(v0[0], v0[1]); w.y = cvt_pk_bf16(v0[2], v0[3]); w.z = cvt_pk_bf16(v1[0], v1[1]); w.w = cvt_pk_bf16(v1[2], v1[3]); *(u32x4*)(outb + o) = w; } }
                ss += __shfl_xor(ss, 16); ss += __shfl_xor(ss, 32);
                if (fq == 0) part[(size_t)row * 32 + u.pn * 4 + wc] = ss;
            }
    }
};
struct EpiGlu {
    static constexpr bool PERM = true, AFTER_DRAIN = false;
    const bf16_t* zb; const bf16_t* ug; const float* bias; bf16_t* tb;
    __device__ __forceinline__ void operator()(const f32x4 (&acc)[2][2][4][2], const Unit& u, int wr, int wc, int fr, int fq) const {
        const int row0 = u.pm * BM + wr * 64 + fr, col0 = u.pn * BM + wc * 32 + 8 * fq;
#pragma unroll
        for (int ai = 0; ai < 2; ++ai)
#pragma unroll
            for (int m = 0; m < 4; ++m) {
                const int row = row0 + ai * HALF + m * 16;
#pragma unroll
                for (int bj = 0; bj < 2; ++bj) { const int col = col0 + bj * HALF;
                    const f32x4 b0 = *(const f32x4*)(bias + col), b1 = *(const f32x4*)(bias + col + 4);
                    const u32x4 zz = __builtin_nontemporal_load((const u32x4*)(zb + (size_t)row * 2048 + col)), gg = __builtin_nontemporal_load((const u32x4*)(ug + (size_t)row * 4096 + 2048 + col));
                    float r[8];
#pragma unroll
                    for (int e = 0; e < 8; ++e) { const float a = (e < 4 ? acc[ai][bj][m][0][e] : acc[ai][bj][m][1][e - 4]) + (e < 4 ? b0[e] : b1[e - 4]);
                        const unsigned zw = zz[e >> 1], gw = gg[e >> 1];
                        const float z = (e & 1) ? __uint_as_float(zw & 0xffff0000u) : __uint_as_float(zw << 16), g = (e & 1) ? __uint_as_float(gw & 0xffff0000u) : __uint_as_float(gw << 16);
                        r[e] = z * sigmoid_f(a) * silu_f(g); }
                    u32x4 w; w.x = cvt_pk_bf16(r[0], r[1]); w.y = cvt_pk_bf16(r[2], r[3]); w.z = cvt_pk_bf16(r[4], r[5]); w.w = cvt_pk_bf16(r[6], r[7]);
                    *(u32x4*)(tb + (size_t)row * 2048 + col) = w; }
            }
    }
};

struct EpiFinalNorm {
    static constexpr bool PERM = true, AFTER_DRAIN = true;
    const bf16_t* base; float* out; float* part; unsigned* cnt; const float* g; int ldc;
    __device__ __forceinline__ void fused(f32x4 (&acc)[2][2][4][2], const Unit& u, int wr, int wc, int fr, int fq, PG8_LAS unsigned char* lds, int wid, int lane) const {
        const int row0 = u.pm * BM + wr * 64 + fr, col0 = u.pn * BM + wc * 32 + 8 * fq;
#pragma unroll
        for (int ai = 0; ai < 2; ++ai)
#pragma unroll
            for (int m = 0; m < 4; ++m) { const int row = row0 + ai * HALF + m * 16; const size_t off = (size_t)row * ldc + col0; float ss = 0.f;
#pragma unroll
                for (int bj = 0; bj < 2; ++bj) { const u32x4 bw = __builtin_nontemporal_load((const u32x4*)(base + off + bj * HALF));
                    const f32x4 b0 = {__uint_as_float(bw.x << 16), __uint_as_float(bw.x & 0xffff0000u), __uint_as_float(bw.y << 16), __uint_as_float(bw.y & 0xffff0000u)};
                    const f32x4 b1 = {__uint_as_float(bw.z << 16), __uint_as_float(bw.z & 0xffff0000u), __uint_as_float(bw.w << 16), __uint_as_float(bw.w & 0xffff0000u)};
                    const f32x4 v0 = acc[ai][bj][m][0] + b0, v1 = acc[ai][bj][m][1] + b1; acc[ai][bj][m][0] = v0; acc[ai][bj][m][1] = v1;
                    ss += ((v0[0] * v0[0] + v0[1] * v0[1]) + (v0[2] * v0[2] + v0[3] * v0[3])) + ((v1[0] * v1[0] + v1[1] * v1[1]) + (v1[2] * v1[2] + v1[3] * v1[3])); }
                ss += __shfl_xor(ss, 16); ss += __shfl_xor(ss, 32);
                if (fq == 0) __hip_atomic_store((unsigned*)part + (size_t)row * 32 + u.pn * 4 + wc, __float_as_uint(ss), __ATOMIC_RELAXED, __HIP_MEMORY_SCOPE_AGENT); }
        asm volatile("s_waitcnt vmcnt(0)" ::: "memory");
        unsigned* c = cnt + 16 * u.pm;
        if (lane == 0) __hip_atomic_fetch_add(c, 1u, __ATOMIC_RELAXED, __HIP_MEMORY_SCOPE_AGENT);
        { unsigned sp = 0; while ((unsigned)__builtin_amdgcn_readfirstlane(__hip_atomic_load(c, __ATOMIC_RELAXED, __HIP_MEMORY_SCOPE_AGENT)) < 64u) { __builtin_amdgcn_s_sleep(2); if (++sp > (1u << 20)) break; } }
        asm volatile("" ::: "memory");
        f32x4 gv[2][2];
#pragma unroll
        for (int bj = 0; bj < 2; ++bj)
#pragma unroll
            for (int n = 0; n < 2; ++n) gv[bj][n] = *(const f32x4*)(g + col0 + bj * HALF + 4 * n);
#pragma unroll
        for (int ai = 0; ai < 2; ++ai)
#pragma unroll
            for (int m = 0; m < 4; ++m) { const int row = row0 + ai * HALF + m * 16; const size_t off = (size_t)row * ldc + col0;
                const unsigned long long* pp = (const unsigned long long*)part + (size_t)row * 16 + 4 * fq; float t = 0.f;
#pragma unroll
                for (int q = 0; q < 4; ++q) { const unsigned long long w2 = __hip_atomic_load(pp + q, __ATOMIC_RELAXED, __HIP_MEMORY_SCOPE_AGENT); t += __uint_as_float((unsigned)w2) + __uint_as_float((unsigned)(w2 >> 32)); }
                t += __shfl_xor(t, 16); t += __shfl_xor(t, 32);
                const float s = rsqrtf(t * (1.0f / 2048.0f) + 1e-6f);
#pragma unroll
                for (int bj = 0; bj < 2; ++bj)
#pragma unroll
                    for (int n = 0; n < 2; ++n) __builtin_nontemporal_store(acc[ai][bj][m][n] * s * gv[bj][n], (f32x4*)(out + off + bj * HALF + 4 * n)); }
    }
};
template <class Epi, class Sched, bool ALIGN_EPI = false, bool SP2 = false>
__device__ __forceinline__ void gemm_phase(PG8_LAS unsigned char* lds, const Gemm g, const Sched& S, const Epi& E) {
    const int tid = threadIdx.x, wid = __builtin_amdgcn_readfirstlane(tid >> 6), lane = tid & 63, wr = wid >> 2, wc = wid & 3, fr = lane & 15, fq = lane >> 4;
    const int K = g.K, nt = K / BK;
    unsigned voffA[2], voffB[2];
#pragma unroll
    for (int i = 0; i < 2; ++i) { int R, C; stage_rc(tid * 16 + i * 8192, R, C); const int Rb = Epi::PERM ? ((R & ~31) + perm32(R & 31)) : R;
        voffA[i] = (unsigned)(R * K + C) * 2u; voffB[i] = (unsigned)(Rb * K + C) * 2u; }
    const size_t kstep = (size_t)(BK * 2);
    const size_t hstep = (size_t)HALF * K * 2;
    const size_t tstep = 2 * hstep;
    const unsigned ldsw = (unsigned)wid * 1024u;
    const int aoff = lds_byte(wr * 64 + fr, fq * 8), boff = lds_byte(wc * 32 + fr, fq * 8);
#define PG8_SA(b, h) (((b) * 2 + (h)) * HTB)
#define PG8_SB(b, h) ((4 + (b) * 2 + (h)) * HTB)
#define PG8_STAGE(bufoff, gbase, voff) do { _Pragma("unroll") for (int _i = 0; _i < 2; ++_i) \
        __builtin_amdgcn_global_load_lds((const unsigned*)((const char*)(gbase) + (voff)[_i]), (PG8_LAS unsigned*)(lds + (bufoff) + ldsw + _i * 8192), 16, 0, 0); } while (0)
#define PG8_LDA(dst, b, h) do { _Pragma("unroll") for (int m = 0; m < 4; ++m) _Pragma("unroll") for (int k = 0; k < 2; ++k) dst[m][k] = *(const PG8_LAS bf16x8*)(lds + PG8_SA(b, h) + aoff + m * 2048 + k * 1024); } while (0)
#define PG8_LDB(dst, b, h) do { _Pragma("unroll") for (int n = 0; n < 2; ++n) _Pragma("unroll") for (int k = 0; k < 2; ++k) dst[n][k] = *(const PG8_LAS bf16x8*)(lds + PG8_SB(b, h) + boff + n * 2048 + k * 1024); } while (0)
#define PG8_MMA(ai, bj, At, Bt) do { __builtin_amdgcn_s_setprio(1); _Pragma("unroll") for (int m = 0; m < 4; ++m) _Pragma("unroll") for (int n = 0; n < 2; ++n) _Pragma("unroll") for (int k = 0; k < 2; ++k) \
        acc[ai][bj][m][n] = __builtin_amdgcn_mfma_f32_16x16x32_bf16(Bt[n][k], At[m][k], acc[ai][bj][m][n], 0, 0, 0); __builtin_amdgcn_s_setprio(0); } while (0)
#define PG8_WAIT_V(n) asm volatile("s_waitcnt vmcnt(" #n ")" ::: "memory")
#define PG8_WAIT_L(n) asm volatile("s_waitcnt lgkmcnt(" #n ")" ::: "memory")
#define PG8_BAR __builtin_amdgcn_s_barrier()
#define PG8_SCHED __builtin_amdgcn_sched_barrier(0)
    Unit cur, nxt; int ui = 0;
    if (!S.next(0, cur)) return;
    f32x4 acc[2][2][4][2];
#pragma unroll
    for (int a = 0; a < 2; ++a)
#pragma unroll
        for (int b = 0; b < 2; ++b)
#pragma unroll
            for (int m = 0; m < 4; ++m)
#pragma unroll
                for (int n = 0; n < 2; ++n) acc[a][b][m][n] = (f32x4){0.f, 0.f, 0.f, 0.f};
    bf16x8 At[4][2], B0[2][2], B1[2][2];
    const char* cA = (const char*)g.A + (size_t)cur.pm * tstep; const char* cB = (const char*)g.Bt + (size_t)cur.pn * tstep;
    S.a_ready(cur);
    if constexpr (SP2) {
        PG8_STAGE(PG8_SB(0, 0), cB, voffB); PG8_STAGE(PG8_SB(0, 1), cB + hstep, voffB); PG8_STAGE(PG8_SA(0, 0), cA, voffA); PG8_STAGE(PG8_SA(0, 1), cA + hstep, voffA);
        if (wr == 1) PG8_BAR;
        PG8_WAIT_V(2); PG8_BAR;
        PG8_STAGE(PG8_SB(1, 0), cB + kstep, voffB); PG8_STAGE(PG8_SA(1, 0), cA + kstep, voffA); PG8_STAGE(PG8_SB(1, 1), cB + hstep + kstep, voffB);
        PG8_WAIT_V(6); PG8_BAR;
    } else {
        PG8_STAGE(PG8_SB(0, 0), cB, voffB); PG8_STAGE(PG8_SA(0, 0), cA, voffA); PG8_STAGE(PG8_SB(0, 1), cB + hstep, voffB); PG8_STAGE(PG8_SA(0, 1), cA + hstep, voffA);
        if (wr == 1) PG8_BAR;
        PG8_WAIT_V(4); PG8_BAR;
        PG8_STAGE(PG8_SB(1, 0), cB + kstep, voffB); PG8_STAGE(PG8_SA(1, 0), cA + kstep, voffA); PG8_STAGE(PG8_SB(1, 1), cB + hstep + kstep, voffB);
        PG8_WAIT_V(6); PG8_BAR;
    }
    for (;;) {
        const bool has_next = S.next(ui + 1, nxt);
        const char* nA = has_next ? (const char*)g.A + (size_t)nxt.pm * tstep : cA; const char* nB = has_next ? (const char*)g.Bt + (size_t)nxt.pn * tstep : cB;
        for (int t = 0; t < nt; t += 2) {
            const bool last = (t == nt - 2);
            const char* a1 = cA + (size_t)(t + 1) * kstep;
            const char* a2 = last ? nA : cA + (size_t)(t + 2) * kstep; const char* b2 = last ? nB : cB + (size_t)(t + 2) * kstep;
            const char* a3 = a2 + kstep; const char* b3 = b2 + kstep;
            if (last && has_next) S.a_ready(nxt);
            if constexpr (SP2) {
            PG8_LDB(B0, 0, 0); PG8_LDB(B1, 0, 1); PG8_SCHED; PG8_LDA(At, 0, 0); PG8_STAGE(PG8_SA(1, 1), a1 + hstep, voffA);
            PG8_WAIT_V(8); PG8_WAIT_L(0); PG8_BAR; PG8_MMA(0, 0, At, B0); PG8_MMA(0, 1, At, B1); PG8_BAR; PG8_SCHED;
            PG8_LDA(At, 0, 1); PG8_STAGE(PG8_SB(0, 0), b2, voffB); PG8_STAGE(PG8_SB(0, 1), b2 + hstep, voffB); PG8_STAGE(PG8_SA(0, 0), a2, voffA);
            PG8_WAIT_V(8); PG8_WAIT_L(0); PG8_BAR; PG8_MMA(1, 0, At, B0); PG8_MMA(1, 1, At, B1); PG8_BAR; PG8_SCHED;
            PG8_LDB(B0, 1, 0); PG8_LDB(B1, 1, 1); PG8_SCHED; PG8_LDA(At, 1, 0); PG8_STAGE(PG8_SA(0, 1), a2 + hstep, voffA);
            PG8_WAIT_V(8); PG8_WAIT_L(0); PG8_BAR; PG8_MMA(0, 0, At, B0); PG8_MMA(0, 1, At, B1); PG8_BAR; PG8_SCHED;
            PG8_LDA(At, 1, 1); PG8_STAGE(PG8_SB(1, 0), b3, voffB); PG8_STAGE(PG8_SB(1, 1), b3 + hstep, voffB); PG8_STAGE(PG8_SA(1, 0), a3, voffA);
            PG8_WAIT_V(8); PG8_WAIT_L(0); PG8_BAR; PG8_MMA(1, 0, At, B0); PG8_MMA(1, 1, At, B1); PG8_BAR; PG8_SCHED;
            } else {
            PG8_LDB(B0, 0, 0); PG8_SCHED; PG8_LDA(At, 0, 0); PG8_STAGE(PG8_SA(1, 1), a1 + hstep, voffA);
            PG8_WAIT_L(8); PG8_BAR; PG8_WAIT_L(0); PG8_MMA(0, 0, At, B0); PG8_BAR; PG8_SCHED;
            PG8_LDB(B1, 0, 1); PG8_STAGE(PG8_SB(0, 0), b2, voffB);
            PG8_BAR; PG8_WAIT_L(0); PG8_MMA(0, 1, At, B1); PG8_BAR;
            PG8_LDA(At, 0, 1); PG8_STAGE(PG8_SA(0, 0), a2, voffA);
            PG8_BAR; PG8_WAIT_L(0); PG8_MMA(1, 0, At, B0); PG8_BAR; PG8_SCHED;
            PG8_STAGE(PG8_SB(0, 1), b2 + hstep, voffB);
            PG8_WAIT_V(6); PG8_BAR; PG8_MMA(1, 1, At, B1); PG8_BAR;
            PG8_LDB(B0, 1, 0); PG8_SCHED; PG8_LDA(At, 1, 0); PG8_STAGE(PG8_SA(0, 1), a2 + hstep, voffA);
            PG8_WAIT_L(8); PG8_BAR; PG8_WAIT_L(0); PG8_MMA(0, 0, At, B0); PG8_BAR; PG8_SCHED;
            PG8_LDB(B1, 1, 1); PG8_STAGE(PG8_SB(1, 0), b3, voffB);
            PG8_BAR; PG8_WAIT_L(0); PG8_MMA(0, 1, At, B1); PG8_BAR;
            PG8_LDA(At, 1, 1); PG8_STAGE(PG8_SA(1, 0), a3, voffA);
            PG8_BAR; PG8_WAIT_L(0); PG8_MMA(1, 0, At, B0); PG8_BAR; PG8_SCHED;
            PG8_STAGE(PG8_SB(1, 1), b3 + hstep, voffB);
            PG8_WAIT_V(6); PG8_BAR; PG8_MMA(1, 1, At, B1); PG8_BAR;
            }
        }
        if constexpr (ALIGN_EPI) { if (wr == 0) PG8_BAR; }
        if constexpr (!Epi::AFTER_DRAIN) { E(acc, cur, wr, wc, fr, fq); S.done(cur); }
        if (!has_next) break;
#pragma unroll
        for (int a = 0; a < 2; ++a)
#pragma unroll
            for (int b = 0; b < 2; ++b)
#pragma unroll
                for (int m = 0; m < 4; ++m)
#pragma unroll
                    for (int n = 0; n < 2; ++n) acc[a][b][m][n] = (f32x4){0.f, 0.f, 0.f, 0.f};
        cur = nxt; cA = nA; cB = nB; ++ui;
        if constexpr (ALIGN_EPI) { if (wr == 1) PG8_BAR; }
    }
    PG8_WAIT_V(0);
    if constexpr (!ALIGN_EPI) { if (wr == 0) PG8_BAR; }
    PG8_BAR;
    if constexpr (Epi::AFTER_DRAIN) { E.fused(acc, cur, wr, wc, fr, fq, lds, wid, lane); S.done(cur); }
#undef PG8_SA
#undef PG8_SB
#undef PG8_STAGE
#undef PG8_LDA
#undef PG8_LDB
#undef PG8_MMA
#undef PG8_WAIT_V
#undef PG8_WAIT_L
#undef PG8_BAR
#undef PG8_SCHED
}
}
#define LAS __attribute__((address_space(3)))
typedef unsigned short bf16;
typedef float f32x4 __attribute__((ext_vector_type(4)));
typedef unsigned v4u __attribute__((ext_vector_type(4)));
typedef unsigned v2u __attribute__((ext_vector_type(2)));
constexpr int NWAVES = 8, NTHR = 512;
constexpr int BATCH = 2, SEQ = 4096, DM = 2048, MROWS = BATCH * SEQ;
constexpr int NP = 7424;
constexpr int C_GQ = 0, C_GK = 512, C_GV = 1024, C_GG = 2048, C_FQ = 3072, C_FK = 4096, C_FV = 5120, C_FG = 6144, C_SMALL = 7168;
constexpr int AB_IN = 7192;
constexpr float EPS = 1e-6f;
constexpr size_t MiB = 1u << 20;
constexpr size_t WS_RSTD0 = 0, WS_PART1 = 64 * 1024, WS_PART2 = WS_PART1 + MiB, WS_CFOX = 2 * MiB + 512 * 1024, WS_SMALL = 3 * MiB  ;
constexpr size_t WS_WGLU = 4 * MiB, WS_WCOUT = 12 * MiB, WS_WCIN = 20 * MiB, WS_WOUT = 36 * MiB, WS_WIN = 44 * MiB;
constexpr size_t WS_XB = 73 * MiB, WS_MIX = 73 * MiB, WS_ZB = 73 * MiB;
constexpr size_t WS_P = 105 * MiB, WS_X1 = 105 * MiB, WS_UG = 169 * MiB;
constexpr size_t WS_ORAW = 221 * MiB;
constexpr size_t WS_TB = 20 * MiB;
constexpr int LDS_BYTES = 163840;

struct Args {
    const float* x; const float* ab_norm_g; const float* ab_w_in; const float* alpha_up; const float* alpha_b; const float* head_g; const float* fox_f_b; const float* ab_w_out;
    const float* c_norm_g; const float* c_w_in; const float* lam_re; const float* lam_im; const float* log_step; const float* b_re; const float* b_im; const float* c_re; const float* c_im;
    const float* s5_d; const float* glu_w; const float* glu_b; const float* c_w_out; const float* final_g;
    float* out; unsigned char* ws; int ph_lo, ph_hi;
};

typedef float cv_f32x2 __attribute__((ext_vector_type(2))); typedef __bf16 cv_bf16x2 __attribute__((ext_vector_type(2)));
__device__ __forceinline__ unsigned pk2(float lo, float hi) { cv_f32x2 v = {lo, hi}; cv_bf16x2 b = __builtin_convertvector(v, cv_bf16x2); return __builtin_bit_cast(unsigned, b); }
__device__ __forceinline__ unsigned f2bf(float f) { return pk2(f, f) & 0xffffu; }
__device__ __forceinline__ float bflo(unsigned w) { return __uint_as_float(w << 16); }
__device__ __forceinline__ float bfhi(unsigned w) { return __uint_as_float(w & 0xffff0000u); }
__device__ __forceinline__ float bf2f(bf16 b) { return __uint_as_float(((unsigned)b) << 16); }
__device__ __forceinline__ float wave_sum(float v) {
#pragma unroll
    for (int o = 1; o < 64; o <<= 1) v += __shfl_xor(v, o);
    return v;
}
__device__ __forceinline__ float silu_f(float x) { return x * __builtin_amdgcn_rcpf(1.0f + __expf(-x)); }
__device__ __forceinline__ float logsigmoid_f(float z) { return fminf(z, 0.f) - __logf(1.0f + __expf(-fabsf(z))); }
__device__ __forceinline__ float gelu_tanh(float y) { const float y2 = y * y; const float a2 = y * (-2.3022082f - 0.10294324f * y2); return y * __builtin_amdgcn_rcpf(1.0f + __builtin_amdgcn_exp2f(a2)); }

struct TrItem { const float* W; bf16* WT; const float* gk; int Nsrc, srcc, dstr, kb; };
__device__ __forceinline__ void tr_load(const TrItem& t, f32x4 (&v)[16], int lane) {
    const int k0 = 64 * t.kb, c4 = (lane & 15) * 4, kr = lane >> 4;
#pragma unroll
    for (int i = 0; i < 16; ++i) v[i] = __builtin_nontemporal_load((const f32x4*)(t.W + (size_t)(k0 + 4 * i + kr) * t.Nsrc + t.srcc + c4));
}
template <bool NT>
__device__ __forceinline__ void tr_store(const TrItem& t, const f32x4 (&v)[16], LAS float* scr, int lane) {
    const int K = DM, k0 = 64 * t.kb, c4 = (lane & 15) * 4, kr = lane >> 4;
#pragma unroll
    for (int i = 0; i < 16; ++i) { const int kk = 4 * i + kr; const float s = t.gk ? t.gk[k0 + kk] : 1.0f; LAS float* d = scr + kk * 65 + c4; d[0] = v[i][0] * s; d[1] = v[i][1] * s; d[2] = v[i][2] * s; d[3] = v[i][3] * s; }
    asm volatile("s_waitcnt lgkmcnt(0)" ::: "memory");
    const int c = lane & 7;
#pragma unroll
    for (int j = 0; j < 8; ++j) { const int n = (lane >> 3) + 8 * j; const LAS float* s = scr + (8 * c) * 65 + n;
        v4u o; o.x = pk2(s[0 * 65], s[1 * 65]); o.y = pk2(s[2 * 65], s[3 * 65]); o.z = pk2(s[4 * 65], s[5 * 65]); o.w = pk2(s[6 * 65], s[7 * 65]);
        if constexpr (NT) __builtin_nontemporal_store(o, (v4u*)(t.WT + (size_t)(t.dstr + n) * K + k0 + 8 * c)); else *(v4u*)(t.WT + (size_t)(t.dstr + n) * K + k0 + 8 * c) = o; }
    asm volatile("s_waitcnt lgkmcnt(0)" ::: "memory");
}
__device__ __forceinline__ TrItem tr_decode_late(const Args& a, int r) {
    constexpr int I_OUT = 32 * 32, I_CIN = 32 * 64, I_GLU = 32 * 32;
    TrItem t;
    if (r < I_OUT) { t.W = a.ab_w_out; t.WT = (bf16*)(a.ws + WS_WOUT); t.gk = nullptr; t.Nsrc = DM; t.srcc = t.dstr = 64 * (r % 32); t.kb = r / 32; return t; } r -= I_OUT;
    if (r < I_CIN) { t.W = a.c_w_in; t.WT = (bf16*)(a.ws + WS_WCIN); t.gk = a.c_norm_g; t.Nsrc = 4096; t.srcc = t.dstr = 64 * (r % 64); t.kb = r / 64; return t; } r -= I_CIN;
    if (r < I_GLU) { t.W = a.glu_w; t.WT = (bf16*)(a.ws + WS_WGLU); t.gk = nullptr; t.Nsrc = DM; t.srcc = t.dstr = 64 * (r % 32); t.kb = r / 32; return t; } r -= I_GLU;
    t.W = a.c_w_out; t.WT = (bf16*)(a.ws + WS_WCOUT); t.gk = nullptr; t.Nsrc = DM; t.srcc = t.dstr = 64 * (r % 32); t.kb = r / 32; return t;
}
__device__ __forceinline__ TrItem tr_decode_in(const Args& a, int r) {
    TrItem t; const int nb = r % 112, d0 = 64 * nb;
    t.W = a.ab_w_in; t.WT = (bf16*)(a.ws + WS_WIN); t.gk = a.ab_norm_g; t.Nsrc = AB_IN; t.srcc = d0 + (d0 < 2048 ? 0 : (d0 < 6144 ? 16 : 24)); t.dstr = d0; t.kb = r / 112; return t;
}
__device__ __forceinline__ void prologue_late(const Args& a, LAS unsigned char* lds, int tid, int widx, int nidle) {
    const int lane = tid & 63, wave = tid >> 6; LAS float* scr = (LAS float*)(lds + wave * 16640);
    constexpr int NIT = 32 * 32 * 3 + 32 * 64; const int st = nidle * NWAVES;
    int it = widx * NWAVES + wave; if (it >= NIT) return;
    TrItem cur = tr_decode_late(a, it); f32x4 v[16]; tr_load(cur, v, lane);
    for (;;) { const int nx = it + st; const bool more = nx < NIT; TrItem nt = cur; f32x4 vn[16];
        if (more) { nt = tr_decode_late(a, nx); tr_load(nt, vn, lane); }
        tr_store<false>(cur, v, scr, lane);
        if (!more) break;
#pragma unroll
        for (int i = 0; i < 16; ++i) v[i] = vn[i];
        cur = nt; it = nx; }
}
__device__ __forceinline__ void phase_prologue(const Args& a, LAS unsigned char* lds, int tid, int G) {
    const int lane = tid & 63, wave = tid >> 6;
    LAS float* scr = (LAS float*)(lds + wave * 16640);
    const int gw = blockIdx.x * NWAVES + wave, NGW = G * NWAVES;
    bf16* WinT = (bf16*)(a.ws + WS_WIN);
    constexpr int NITEMS = 32 * (7168 / 64);
    if (gw < NITEMS) { int it = gw; TrItem cur = tr_decode_in(a, it); f32x4 v[16]; tr_load(cur, v, lane);
        for (;;) { const int nx = it + NGW; const bool more = nx < NITEMS; TrItem nt = cur; f32x4 vn[16];
            if (more) { nt = tr_decode_in(a, nx); tr_load(nt, vn, lane); }
            tr_store<false>(cur, v, scr, lane);
            if (!more) break;
#pragma unroll
            for (int i = 0; i < 16; ++i) v[i] = vn[i];
            cur = nt; it = nx; } }
    for (int idx = blockIdx.x * NTHR + tid; idx < 256 * DM; idx += G * NTHR) {
        const int rr = idx / DM, k = idx % DM; float w = 0.f;
        if (rr < 16) w = a.ab_w_in[(size_t)k * AB_IN + 2048 + rr] * a.ab_norm_g[k];
        else if (rr < 24) w = a.ab_w_in[(size_t)k * AB_IN + 6160 + (rr - 16)] * a.ab_norm_g[k];
        WinT[(size_t)(C_SMALL + rr) * DM + k] = (bf16)f2bf(w);
    }
    bf16* xb = (bf16*)(a.ws + WS_XB); float* rstd0 = (float*)(a.ws + WS_RSTD0);
    for (int m0 = gw; m0 < MROWS; m0 += 2 * NGW) {
        const int m1 = m0 + NGW; const bool has1 = m1 < MROWS; const int m1c = has1 ? m1 : m0;
        const f32x4* xr0 = (const f32x4*)(a.x + (size_t)m0 * DM) + lane; const f32x4* xr1 = (const f32x4*)(a.x + (size_t)m1c * DM) + lane;
        f32x4 v0[8], v1[8];
#pragma unroll
        for (int j = 0; j < 8; ++j) v0[j] = __builtin_nontemporal_load(xr0 + 64 * j);
#pragma unroll
        for (int j = 0; j < 8; ++j) v1[j] = __builtin_nontemporal_load(xr1 + 64 * j);
        float s0 = 0.f, s1 = 0.f;
#pragma unroll
        for (int j = 0; j < 8; ++j) { s0 += (v0[j][0] * v0[j][0] + v0[j][1] * v0[j][1]) + (v0[j][2] * v0[j][2] + v0[j][3] * v0[j][3]); s1 += (v1[j][0] * v1[j][0] + v1[j][1] * v1[j][1]) + (v1[j][2] * v1[j][2] + v1[j][3] * v1[j][3]); }
        s0 = wave_sum(s0); s1 = wave_sum(s1);
        if (lane == 0) { rstd0[m0] = rsqrtf(s0 * (1.0f / DM) + EPS); if (has1) rstd0[m1] = rsqrtf(s1 * (1.0f / DM) + EPS); }
        v2u* o0 = (v2u*)(xb + (size_t)m0 * DM) + lane; v2u* o1 = (v2u*)(xb + (size_t)m1c * DM) + lane;
#pragma unroll
        for (int j = 0; j < 8; ++j) { v2u w; w.x = pk2(v0[j][0], v0[j][1]); w.y = pk2(v0[j][2], v0[j][3]); o0[64 * j] = w; }
        if (has1) {
#pragma unroll
            for (int j = 0; j < 8; ++j) { v2u w; w.x = pk2(v1[j][0], v1[j][1]); w.y = pk2(v1[j][2], v1[j][3]); o1[64 * j] = w; } }
    }
}

__device__ __forceinline__ void phase_fox_cumsum(const Args& a, LAS unsigned char* lds, int tid, int G) {
    if (blockIdx.x >= 16) return;
    const int bh = blockIdx.x, b = bh >> 3, h = bh & 7, lane = tid & 63, wave = tid >> 6; const float fb = a.fox_f_b[h];
    const float* small = (const float*)(a.ws + WS_SMALL); float* cf = (float*)(a.ws + WS_CFOX) + (size_t)bh * SEQ; LAS float* WT = (LAS float*)lds;
    float v[8]; float run = 0.f;
#pragma unroll
    for (int i = 0; i < 8; ++i) { run += logsigmoid_f(small[(size_t)(b * SEQ + tid * 8 + i) * 32 + 16 + h] + fb); v[i] = run; }
    float inc = run;
#pragma unroll
    for (int o = 1; o < 64; o <<= 1) { const float n = __shfl_up(inc, o); if (lane >= o) inc += n; }
    if (lane == 63) WT[wave] = inc;
    __syncthreads();
    float base = inc - run;
    for (int w = 0; w < wave; ++w) base += WT[w];
#pragma unroll
    for (int i = 0; i < 8; ++i) cf[tid * 8 + i] = base + v[i];
}

#define XB_TMO      128
#define XB_XCNT(j)  (256  + 64 * (j))
#define XB_XSUB(j)  (1280 + 64 * (j))
#define XB_XGEN(j)  (2304 + 64 * (j))
#define XB_TOP      3328
#define XB_TOPGEN   3392
#define XCD_BAR_WORDS 3456
#define XB_SPIN_CAP (1u << 18)

__device__ __forceinline__ unsigned xb_ld(unsigned* p)              { return __hip_atomic_load(p, __ATOMIC_RELAXED, __HIP_MEMORY_SCOPE_AGENT); }
__device__ __forceinline__ unsigned xb_add(unsigned* p, unsigned v) { return __hip_atomic_fetch_add(p, v, __ATOMIC_RELAXED, __HIP_MEMORY_SCOPE_AGENT); }
__device__ __forceinline__ unsigned xb_xcc_id() { return (unsigned)__builtin_amdgcn_s_getreg((3 << 11) | 20) & 0xFu; }
#define XB_SPIN(cond, bar) do { unsigned _sp = 0; while (cond) { __builtin_amdgcn_s_sleep(1); \
    if ((++_sp & 255u) == 0u) { if (xb_ld(&(bar)[XB_TMO])) break; if (_sp > XB_SPIN_CAP) { atomicAdd(&(bar)[XB_TMO], 1u); break; } } } } while (0)

struct XcdBarrier {
    unsigned* bar; unsigned x;
    volatile LAS unsigned* st;
};

__device__ __forceinline__ XcdBarrier xcd_barrier_post(unsigned* bar, volatile LAS unsigned* st) {
    XcdBarrier b; b.bar = bar; b.x = xb_xcc_id(); b.st = st;
    if (threadIdx.x == 0) (void)xb_add(&bar[XB_XCNT(b.x)], 1u);
    return b;
}
__device__ __forceinline__ void xcd_barrier_complete(unsigned* bar, unsigned x, unsigned& nloc, unsigned& nx) {
    const unsigned G = gridDim.x * gridDim.y * gridDim.z;
    unsigned sum, cnt, mine, sp = 0u;
    for (;;) {
        sum = 0u; cnt = 0u; mine = 0u;
#pragma unroll
        for (unsigned j = 0; j < 16; ++j) { const unsigned c = xb_ld(&bar[XB_XCNT(j)]); sum += c; cnt += (c > 0u) ? 1u : 0u; mine = (j == x) ? c : mine; }
        if (sum == G) break;
        __builtin_amdgcn_s_sleep(1);
        if ((++sp & 255u) == 0u) { if (xb_ld(&bar[XB_TMO])) break; if (sp > XB_SPIN_CAP) { atomicAdd(&bar[XB_TMO], 1u); break; } }
    }
    nloc = mine > 0u ? mine : 1u; nx = cnt > 0u ? cnt : 1u;
}

__device__ __forceinline__ void xcd_barrier(const XcdBarrier& b) {
    asm volatile("s_waitcnt vmcnt(0)" ::: "memory");
    __syncthreads();
    if (threadIdx.x == 0) {
        unsigned* bar = b.bar;
        __builtin_amdgcn_s_waitcnt(0);
        unsigned nloc = b.st[0], nx = b.st[1];
        if (nloc == 0u) { xcd_barrier_complete(bar, b.x, nloc, nx); b.st[0] = nloc; b.st[1] = nx; }
        const unsigned old = xb_add(&bar[XB_XSUB(b.x)], 1u);
        const unsigned gen = old / nloc;
        if (old + 1u == (gen + 1u) * nloc) {
            __builtin_amdgcn_fence(__ATOMIC_RELEASE, "agent");
            asm volatile("s_waitcnt vmcnt(0)" ::: "memory");
            const unsigned og = xb_add(&bar[XB_TOP], 1u);
            const unsigned tg = og / nx;
            if (og + 1u == (tg + 1u) * nx) xb_add(&bar[XB_TOPGEN], 1u);
            else XB_SPIN(xb_ld(&bar[XB_TOPGEN]) == tg, bar);
            __builtin_amdgcn_fence(__ATOMIC_ACQUIRE, "agent");
            xb_add(&bar[XB_XGEN(b.x)], 1u);
            asm volatile("s_waitcnt vmcnt(0)" ::: "memory");
        } else {
            XB_SPIN(xb_ld(&bar[XB_XGEN(b.x)]) == gen, bar);
            __builtin_amdgcn_fence(__ATOMIC_ACQUIRE, "agent");
            asm volatile("s_waitcnt vmcnt(0)" ::: "memory");
        }
    }
    __syncthreads();
}


constexpr size_t WS_BAR = 40 * 1024;
namespace fox {
constexpr int D = 128, KVS = 7424, OS = 2048, WINDOW = 4096; constexpr float THR = 8.f; constexpr bool WSKIP = false;
constexpr float SCALE = 0.08838834764831845f;
constexpr int NW = 8, QBLK = 32, KVBLK = 64, QB = NW * QBLK;
constexpr int SHM_V = KVBLK * D * 2, SHM_K = KVBLK * D * 2;
constexpr int LDS_BYTES = 2 * SHM_V + 2 * SHM_K + NW * 64 * 4;


using bf16 = unsigned short;
typedef short bf16x8 __attribute__((ext_vector_type(8)));
typedef short s16x4 __attribute__((ext_vector_type(4)));
typedef float f32x16 __attribute__((ext_vector_type(16)));
typedef float f32x4 __attribute__((ext_vector_type(4)));
typedef unsigned u32x4 __attribute__((ext_vector_type(4)));
template <class A, class Bt> struct same_t { static constexpr bool v = false; };
template <class A> struct same_t<A, A> { static constexpr bool v = true; };

#define KSWZ(row, colB) ((row) * 256 + ((colB) ^ (((row) & 7) << 4)))
#define SBAR() __builtin_amdgcn_sched_barrier(0)
__device__ __forceinline__ int v_st(int k, int c) { const int kk = (k & ~0xC) | ((k & 4) << 1) | ((k & 8) >> 1); return ((kk >> 3) * 4 + (c >> 5)) * 512 + ((kk & 7) * 32 + (c & 31)) * 2; }
__device__ __forceinline__ int v_rd_base(int lane) { return ((lane & 3) << 3) | (((lane >> 2) & 3) << 6) | (((lane >> 4) & 1) << 5) | (((lane >> 5) & 1) << 8); }
constexpr int v_rd_off(int d0, int ks, int half) { return d0 * 512 + ks * 4096 + half * 2048; }
__device__ __forceinline__ int crow(int r, int hi) { return (r & 3) + 8 * (r >> 2) + 4 * hi; }
__device__ __forceinline__ unsigned cvtpk(float lo, float hi) {
    unsigned r; asm volatile("v_cvt_pk_bf16_f32 %0, %1, %2" : "=v"(r) : "v"(lo), "v"(hi)); return r;
}
__device__ __forceinline__ bf16x8 pack8(f32x4 a, f32x4 b) {
    u32x4 w = {cvtpk(a[0], a[1]), cvtpk(a[2], a[3]), cvtpk(b[0], b[1]), cvtpk(b[2], b[3])};
    return *reinterpret_cast<bf16x8*>(&w);
}
template <class T> __device__ __forceinline__ bf16x8 load8(const T* p) {
    if constexpr (same_t<T, float>::v) { return pack8(*(const f32x4*)p, *(const f32x4*)(p + 4)); }
    else { return *reinterpret_cast<const bf16x8*>(p); }
}
typedef __attribute__((address_space(3))) float lds_f32; typedef __attribute__((address_space(3))) f32x4 lds_f32x4;
__device__ __forceinline__ void bias_tile(f32x16& p0, f32x16& p1, const lds_f32* cbk, int hi) {
    const lds_f32* cb0 = cbk + 4 * hi;
#pragma unroll
    for (int g_ = 0; g_ < 4; ++g_) { const f32x4 b0_ = *(const lds_f32x4*)(cb0 + 8 * g_), b1_ = *(const lds_f32x4*)(cb0 + 32 + 8 * g_);
        p0[4 * g_] += b0_[0]; p0[4 * g_ + 1] += b0_[1]; p0[4 * g_ + 2] += b0_[2]; p0[4 * g_ + 3] += b0_[3]; p1[4 * g_] += b1_[0]; p1[4 * g_ + 1] += b1_[1]; p1[4 * g_ + 2] += b1_[2]; p1[4 * g_ + 3] += b1_[3]; }
}
__device__ __forceinline__ void mask_tile(f32x16& p0, f32x16& p1, int dq, unsigned W) {
    const float NEG = -__builtin_inff();
#pragma unroll
    for (int r = 0; r < 16; ++r) {
        const int c = (r & 3) + 8 * (r >> 2);
        if ((unsigned)(dq - c) >= W) p0[r] = NEG;
        if ((unsigned)(dq - c - 32) >= W) p1[r] = NEG;
    }
}
__device__ __forceinline__ void partialSM(f32x16& p0, f32x16& p1, float& m_reg, float& mn, float& alpha) {
    float pmax = p0[0]; for (int r = 1; r < 16; ++r) pmax = fmaxf(pmax, p0[r]); for (int r = 0; r < 16; ++r) pmax = fmaxf(pmax, p1[r]);
    { auto rr = __builtin_amdgcn_permlane32_swap(__float_as_uint(pmax), __float_as_uint(pmax), false, false);
      pmax = fmaxf(__uint_as_float(rr[0]), __uint_as_float(rr[1])); }
    constexpr float C2 = 1.4426950408889634f * SCALE;
    if (__builtin_expect(__all((pmax - m_reg) * SCALE <= THR), 1)) { mn = m_reg; alpha = 1.f; }
    else { mn = fmaxf(m_reg, pmax); alpha = __builtin_amdgcn_exp2f((m_reg - mn) * C2); m_reg = mn; }
    const float mnL = -mn * C2;
    for (int r = 0; r < 16; ++r) p0[r] = fmaf(p0[r], C2, mnL); for (int r = 0; r < 16; ++r) p1[r] = fmaf(p1[r], C2, mnL);
    for (int r = 0; r < 16; ++r) p0[r] = __builtin_amdgcn_exp2f(p0[r]);
}
__device__ __forceinline__ void finishSM(f32x16& p0, f32x16& p1, float alpha, float& l_reg, bf16x8& pa0, bf16x8& pa1, bf16x8& pa2, bf16x8& pa3) {
    for (int r = 0; r < 16; ++r) p1[r] = __builtin_amdgcn_exp2f(p1[r]);
    float ps = 0; for (int r = 0; r < 16; ++r) ps += p0[r]; for (int r = 0; r < 16; ++r) ps += p1[r];
    { auto rr = __builtin_amdgcn_permlane32_swap(__float_as_uint(ps), __float_as_uint(ps), false, false);
      ps = __uint_as_float(rr[0]) + __uint_as_float(rr[1]); }
    l_reg = l_reg * alpha + ps;
#define PK4(P, B_, OUT) do { unsigned a0 = cvtpk(P[B_+0], P[B_+1]), a1 = cvtpk(P[B_+2], P[B_+3]);                          \
        unsigned b0 = cvtpk(P[B_+4], P[B_+5]), b1 = cvtpk(P[B_+6], P[B_+7]);                                             \
        auto r0 = __builtin_amdgcn_permlane32_swap(a0, b0, false, false); auto r1 = __builtin_amdgcn_permlane32_swap(a1, b1, false, false); \
        u32x4 w = {r0[0], r1[0], r0[1], r1[1]}; OUT = *reinterpret_cast<bf16x8*>(&w); } while (0)
    PK4(p0, 0, pa0); PK4(p0, 8, pa1); PK4(p1, 0, pa2); PK4(p1, 8, pa3);
#undef PK4
}
typedef __attribute__((address_space(3))) bf16x8 lds_bf16x8;
constexpr int QLDS_OFF = LDS_BYTES + 16384, QLDS_ROW = 272;
template <int KB, bool SK>
__device__ __forceinline__ void qkt(f32x16& p0, f32x16& p1, const char* K_lds, int r32, int hi, const lds_bf16x8* qp, bool act) {
    if (SK && !act) { const float NEG = -__builtin_inff();
#pragma unroll
        for (int r = 0; r < 16; ++r) { p0[r] = NEG; p1[r] = NEG; } return; }
    p0 = f32x16{}; p1 = f32x16{};
    const char* kb[4];
#pragma unroll
    for (int dd = 0; dd < 4; ++dd) kb[dd] = K_lds + KB * SHM_K + KSWZ(r32, (dd * 16 + hi * 8) * 2);
#pragma unroll
    for (int d0 = 0; d0 < 8; ++d0) { const char* a = kb[d0 & 3] + (d0 >> 2) * 128;
        bf16x8 b0 = *reinterpret_cast<const bf16x8*>(a);
        bf16x8 b1 = *reinterpret_cast<const bf16x8*>(a + 32 * 256); const bf16x8 qf = qp[2 * d0];
        p0 = __builtin_amdgcn_mfma_f32_32x32x16_bf16(b0, qf, p0, 0, 0, 0);
        p1 = __builtin_amdgcn_mfma_f32_32x32x16_bf16(b1, qf, p1, 0, 0, 0); }
}
template <int VB, bool SK>
__device__ __forceinline__ void pv_tile(f32x16* o, int vb0, bf16x8 pa0, bf16x8 pa1, bf16x8 pa2, bf16x8 pa3, bool act) {
    if (SK && !act) return;
#define TRRD(dst, off) asm volatile("ds_read_b64_tr_b16 %0, %1 offset:%2" : "=&v"(dst) : "v"(vb0), "i"(off) : "memory")
#define PV_D0(d0) do { s16x4 l0, l1, l2, l3, h0, h1, h2, h3; constexpr int b_ = VB * SHM_V + v_rd_off(d0, 0, 0);     \
        TRRD(l0, b_); TRRD(h0, b_ + 2048); TRRD(l1, b_ + 4096); TRRD(h1, b_ + 6144); TRRD(l2, b_ + 8192); TRRD(h2, b_ + 10240); TRRD(l3, b_ + 12288); TRRD(h3, b_ + 14336); \
        asm volatile("s_waitcnt lgkmcnt(0)" ::: "memory"); SBAR();                 \
        o[d0] = __builtin_amdgcn_mfma_f32_32x32x16_bf16(pa0, (bf16x8){l0[0], l0[1], l0[2], l0[3], h0[0], h0[1], h0[2], h0[3]}, o[d0], 0, 0, 0);   \
        o[d0] = __builtin_amdgcn_mfma_f32_32x32x16_bf16(pa1, (bf16x8){l1[0], l1[1], l1[2], l1[3], h1[0], h1[1], h1[2], h1[3]}, o[d0], 0, 0, 0);   \
        o[d0] = __builtin_amdgcn_mfma_f32_32x32x16_bf16(pa2, (bf16x8){l2[0], l2[1], l2[2], l2[3], h2[0], h2[1], h2[2], h2[3]}, o[d0], 0, 0, 0);   \
        o[d0] = __builtin_amdgcn_mfma_f32_32x32x16_bf16(pa3, (bf16x8){l3[0], l3[1], l3[2], l3[3], h3[0], h3[1], h3[2], h3[3]}, o[d0], 0, 0, 0); } while (0)
    PV_D0(0); PV_D0(1); PV_D0(2); PV_D0(3);
#undef PV_D0
#undef TRRD
}

template <class TIn, class TOut> struct BlockRef { const TIn* Q; const TIn* K; const TIn* V; TOut* O; const bf16* G; int P0; int jlo; };
template <class TIn> struct Seam {
    bf16x8 qr[8];
    bf16x8 st_v0, st_v1, st_k0, st_k1; f32x4 sf0, sf1, sf2, sf3;
    f32x4 tq[16];
};
__device__ __forceinline__ int swa_jlo(int P0, int W) { const int lowk = P0 - W + 1; return lowk > 0 ? lowk / KVBLK : 0; }
#define ROW(p, k0, rr) ((p) + (size_t)((k0) + (rr)) * KVS + sc)
#define VMW() asm volatile("s_waitcnt vmcnt(0)" ::: "memory")
#define VMWN(n) asm volatile("s_waitcnt vmcnt(%0)" :: "i"(n) : "memory")
#define SLOAD_H(Kp, Vp, k0) do { S.st_v0 = load8<TIn>(ROW(Vp, k0, sr)); S.st_v1 = load8<TIn>(ROW(Vp, k0, 32 + sr));              \
                         S.st_k0 = load8<TIn>(ROW(Kp, k0, sr)); S.st_k1 = load8<TIn>(ROW(Kp, k0, 32 + sr)); } while (0)
#define SWRITE_HK(bf) do { *(bf16x8*)(K_lds + (bf) * SHM_K + kws) = S.st_k0; *(bf16x8*)(K_lds + (bf) * SHM_K + kws + 32 * 256) = S.st_k1; } while (0)
#define SWRITE_HV(bf) do { *(bf16x8*)(V_lds + (bf) * SHM_V + vst0) = S.st_v0; *(bf16x8*)(V_lds + (bf) * SHM_V + vst1) = S.st_v1; } while (0)
#define SWRITE_H(bf) do { SWRITE_HV(bf); SWRITE_HK(bf); } while (0)
#define SLOAD_F(p, k0) do { S.sf0 = *(const f32x4*)ROW(p, k0, sr); S.sf1 = *(const f32x4*)(ROW(p, k0, sr) + 4);                \
                            S.sf2 = *(const f32x4*)ROW(p, k0, 32 + sr); S.sf3 = *(const f32x4*)(ROW(p, k0, 32 + sr) + 4); } while (0)
#define SWRITE_KF(bf) do { *(bf16x8*)(K_lds + (bf) * SHM_K + kws) = pack8(S.sf0, S.sf1); *(bf16x8*)(K_lds + (bf) * SHM_K + kws + 32 * 256) = pack8(S.sf2, S.sf3); } while (0)
#define SWRITE_VF(bf) do { *(bf16x8*)(V_lds + (bf) * SHM_V + vst0) = pack8(S.sf0, S.sf1); *(bf16x8*)(V_lds + (bf) * SHM_V + vst1) = pack8(S.sf2, S.sf3); } while (0)
template <class TIn, class TOut>
__device__ __forceinline__ void causal_swa_prime(const BlockRef<TIn, TOut>& cur, int W, char* lds, Seam<TIn>& S) {
    constexpr bool F32 = same_t<TIn, float>::v;
    const int tid = threadIdx.x, wid = __builtin_amdgcn_readfirstlane(tid >> 6), lane = tid & 63, r32 = lane & 31, hi = lane >> 5;
    const int sr = tid >> 4, sc = (tid & 15) * 8, kws = KSWZ(sr, sc * 2); char* K_lds = lds + 2 * SHM_V;
    const int kb0 = cur.jlo * KVBLK;
    for (int d0 = 0; d0 < 8; ++d0) S.qr[d0] = load8<TIn>(cur.Q + (size_t)(wid * QBLK + r32) * KVS + d0 * 16 + hi * 8);
    { lds_bf16x8* qp = (lds_bf16x8*)(lds + QLDS_OFF + (wid * QBLK + r32) * QLDS_ROW + hi * 16);
#pragma unroll
      for (int d0 = 0; d0 < 8; ++d0) qp[2 * d0] = S.qr[d0]; }
    if constexpr (F32) { SLOAD_F((const float*)cur.K, kb0); VMW(); SWRITE_KF(0); SBAR(); SLOAD_F((const float*)cur.V, kb0); }
    else { SLOAD_H(cur.K, cur.V, kb0); VMW(); SWRITE_HK(0); }
    __syncthreads();
}
template <class TIn, class TOut>
__device__ __forceinline__ void causal_swa_block(const BlockRef<TIn, TOut>& cur, const BlockRef<TIn, TOut>& nxt, int skv, int W, char* lds, Seam<TIn>& S) {
    constexpr bool F32 = same_t<TIn, float>::v;
    const int tid = threadIdx.x, wid = __builtin_amdgcn_readfirstlane(tid >> 6), lane = tid & 63, r32 = lane & 31, hi = lane >> 5;
    const int j_lo = cur.jlo;
    int j_hi = (cur.P0 + QB - 1) / KVBLK + 1; if (j_hi > skv / KVBLK) j_hi = skv / KVBLK;
    const int NT = j_hi - j_lo;
    const int kbn = nxt.jlo * KVBLK;
    const int qlo = cur.P0 + wid * QBLK, qm = qlo + r32 - 4 * hi;
    char* V_lds = lds; char* K_lds = lds + 2 * SHM_V;
    float* ws = (float*)(lds + 2 * SHM_V + 2 * SHM_K) + wid * 64; float* li_l = ws, * al_l = ws + 32;
    lds_bf16x8* qp = (lds_bf16x8*)(lds + QLDS_OFF + (wid * QBLK + r32) * QLDS_ROW + hi * 16);
    lds_f32* cb = (lds_f32*)(lds + 2 * SHM_V + 2 * SHM_K + NW * 64 * 4);
    float m_reg = -1e30f, l_reg = 0; f32x16 o[4] = {};
    const int sr = tid >> 4, sc = (tid & 15) * 8, vst0 = v_st(sr, sc), vst1 = v_st(32 + sr, sc), kws = KSWZ(sr, sc * 2);
    const int vb0 = (int)(uintptr_t)V_lds + v_rd_base(lane);
    const TIn* Kh = cur.K; const TIn* Vh = cur.V;
#define RESC(a) do { if (__any((a) < 1.f)) { if (hi == 0) al_l[r32] = (a); asm volatile("s_waitcnt lgkmcnt(0)" ::: "memory");              \
                     for (int d_ = 0; d_ < 4; ++d_) for (int r = 0; r < 16; ++r) o[d_][r] *= al_l[crow(r, hi)]; } } while (0)
#define KBASE(t) ((j_lo + (t)) * KVBLK)
#define ACT(t) (KBASE(t) <= qlo + QBLK - 1 && KBASE(t) + KVBLK - 1 >= qlo - W + 1)
#define MASKT(P0_, P1_, t) do { const int kb_ = KBASE(t); if ((!SK || ACT(t)) && (kb_ + KVBLK - 1 > qlo || kb_ <= qlo + QBLK - 1 - W)) mask_tile(P0_, P1_, qm - kb_, (unsigned)W); } while (0)
    constexpr int NQL = F32 ? 16 : 8;
    constexpr bool SK = WSKIP && !F32;
#define SEAM_K0() do { VMWN(NQL); if constexpr (F32) { SWRITE_KF(0); SBAR(); SLOAD_F((const float*)nxt.V, kbn); } else { SWRITE_HK(0); } SBAR(); } while (0)
    f32x16 pA0, pA1, pB0, pB1; float mnA, mnB, alA, alB; bf16x8 pa0, pa1, pa2, pa3;
    if constexpr (F32) { VMW(); SWRITE_VF(0); SBAR(); } else { SWRITE_HV(0); SBAR(); }
    if (NT > 1) { if constexpr (F32) SLOAD_F((const float*)Kh, KBASE(1)); else SLOAD_H(Kh, Vh, KBASE(1)); }
    SBAR(); qkt<0, SK>(pA0, pA1, K_lds, r32, hi, qp, ACT(0));
    if constexpr (F32) { if (NT > 1) { VMW(); SWRITE_KF(1); SBAR(); SLOAD_F((const float*)Vh, KBASE(1)); } }
    bias_tile(pA0, pA1, cb + KBASE(0), hi); MASKT(pA0, pA1, 0); partialSM(pA0, pA1, m_reg, mnA, alA);
    if (NT > 1) { VMW(); if constexpr (F32) { SWRITE_VF(1); SBAR(); if (NT > 2) SLOAD_F((const float*)Kh, KBASE(2)); } else SWRITE_H(1); }
    __syncthreads();
#define HALF_STEP(PX0, PX1, mnX, alX, PY0, PY1, alY, t, KB, VB, SB) do {                                                      \
        SBAR(); qkt<KB, SK>(PX0, PX1, K_lds, r32, hi, qp, ACT(t));                                             \
        finishSM(PY0, PY1, alY, l_reg, pa0, pa1, pa2, pa3); SBAR();                                                           \
        if ((t) + 1 < NT) { if constexpr (F32) { VMW(); SWRITE_KF(SB); SBAR(); SLOAD_F((const float*)Vh, KBASE((t) + 1)); }  \
                            else { SLOAD_H(Kh, Vh, KBASE((t) + 1)); } SBAR(); }                                               \
        pv_tile<VB, SK>(o, vb0, pa0, pa1, pa2, pa3, ACT((t) - 1)); bias_tile(PX0, PX1, cb + KBASE(t), hi); MASKT(PX0, PX1, (t)); partialSM(PX0, PX1, m_reg, mnX, alX);                                        \
        __syncthreads();                                                                                                      \
        if ((t) + 1 < NT) { VMW(); if constexpr (F32) { SWRITE_VF(SB); SBAR(); if ((t) + 2 < NT) SLOAD_F((const float*)Kh, KBASE((t) + 2)); } \
                            else { SWRITE_H(SB); } }                                                                          \
        RESC(alX); __syncthreads(); } while (0)
    for (int t = 1; t + 1 < NT; t += 2) {
        HALF_STEP(pB0, pB1, mnB, alB, pA0, pA1, alA, t, 1, 0, 0);
        HALF_STEP(pA0, pA1, mnA, alA, pB0, pB1, alB, t + 1, 0, 1, 1);
    }
    const bool even = (NT & 1) == 0;
    if (even) { SBAR(); qkt<1, SK>(pB0, pB1, K_lds, r32, hi, qp, ACT(NT - 1)); SBAR(); }
#define QROW(e) (nxt.Q + (size_t)(wid * QBLK + r32) * KVS + ((e) >> 1) * 16 + hi * 8 + ((e) & 1) * 4)
    if constexpr (F32) { SLOAD_F((const float*)nxt.K, kbn); SBAR();
#pragma unroll
        for (int e = 0; e < 8; ++e) S.tq[e] = *(const f32x4*)QROW(e); }
    else { SLOAD_H(nxt.K, nxt.V, kbn); SBAR();
#pragma unroll
        for (int d0 = 0; d0 < 8; ++d0) S.qr[d0] = load8<TIn>(nxt.Q + (size_t)(wid * QBLK + r32) * KVS + d0 * 16 + hi * 8); }
    SBAR();
    finishSM(pA0, pA1, alA, l_reg, pa0, pa1, pa2, pa3); SBAR();
    if constexpr (F32) {
#pragma unroll
        for (int e = 8; e < 16; ++e) S.tq[e] = *(const f32x4*)QROW(e); SBAR(); }
#undef QROW
    pv_tile<0, SK>(o, vb0, pa0, pa1, pa2, pa3, ACT(even ? NT - 2 : NT - 1));
    if (even) { bias_tile(pB0, pB1, cb + KBASE(NT - 1), hi); MASKT(pB0, pB1, NT - 1); partialSM(pB0, pB1, m_reg, mnB, alB); __syncthreads(); RESC(alB);
        finishSM(pB0, pB1, alB, l_reg, pa0, pa1, pa2, pa3); SBAR(); pv_tile<1, SK>(o, vb0, pa0, pa1, pa2, pa3, ACT(NT - 1)); }
    SBAR(); SEAM_K0();
    if (hi == 0) li_l[r32] = l_reg; asm volatile("s_waitcnt lgkmcnt(0)" ::: "memory");
    float rli[16];
#pragma unroll
    for (int r = 0; r < 16; ++r) rli[r] = __builtin_amdgcn_rcpf(li_l[crow(r, hi)]);
    TOut* Ow = cur.O + (size_t)(wid * QBLK) * OS;
    {
        typedef __attribute__((address_space(3))) unsigned short lds_u16; typedef __attribute__((address_space(3))) u32x4 lds_u32x4;
        const bf16* Gw = cur.G + (size_t)(wid * QBLK) * KVS;
        u32x4 gt[8];
#pragma unroll
        for (int i = 0; i < 8; ++i) { const int p = lane + 64 * i; gt[i] = __builtin_nontemporal_load((const u32x4*)(Gw + (size_t)(p >> 4) * KVS + (p & 15) * 8)); }
        lds_u16* st = (lds_u16*)(lds + QLDS_OFF + (wid * QBLK) * QLDS_ROW);
#pragma unroll
        for (int r = 0; r < 16; ++r) { const int orow = crow(r, hi);
#pragma unroll
            for (int d0 = 0; d0 < 4; d0 += 2) { const unsigned w2 = cvtpk(o[d0][r] * rli[r], o[d0 + 1][r] * rli[r]);
                st[orow * (QLDS_ROW / 2) + d0 * 32 + r32] = (unsigned short)w2; st[orow * (QLDS_ROW / 2) + (d0 + 1) * 32 + r32] = (unsigned short)(w2 >> 16); } }
        asm volatile("s_waitcnt lgkmcnt(0)" ::: "memory");
#pragma unroll
        for (int i = 0; i < 8; ++i) { const int p = lane + 64 * i, row = p >> 4, c8 = (p & 15) * 8;
            const u32x4 ov = *(const lds_u32x4*)(lds + QLDS_OFF + (wid * QBLK + row) * QLDS_ROW + c8 * 2); u32x4 w;
#pragma unroll
            for (int e = 0; e < 4; ++e) { const float a0 = __uint_as_float(ov[e] << 16), a1 = __uint_as_float(ov[e] & 0xffff0000u), g0 = __uint_as_float(gt[i][e] << 16), g1 = __uint_as_float(gt[i][e] & 0xffff0000u);
                w[e] = cvtpk(a0 * g0 * __builtin_amdgcn_rcpf(1.0f + __expf(-g0)), a1 * g1 * __builtin_amdgcn_rcpf(1.0f + __expf(-g1))); }
            *(u32x4*)(Ow + (size_t)row * OS + c8) = w; }
        asm volatile("s_waitcnt lgkmcnt(0)" ::: "memory");
    }
    if constexpr (F32) {
#pragma unroll
        for (int d0 = 0; d0 < 8; ++d0) S.qr[d0] = pack8(S.tq[2 * d0], S.tq[2 * d0 + 1]); }
#pragma unroll
    for (int d0 = 0; d0 < 8; ++d0) qp[2 * d0] = S.qr[d0];
    __syncthreads();
#undef RESC
#undef KBASE
#undef ACT
#undef MASKT
#undef SEAM_K0
#undef HALF_STEP
}
#undef ROW
#undef VMW
#undef VMWN
#undef SLOAD_H
#undef SWRITE_HK
#undef SWRITE_HV
#undef SWRITE_H
#undef SLOAD_F
#undef SWRITE_KF
#undef SWRITE_VF
}
__device__ __forceinline__ void fox_naive_row(const Args& a, int bh, int t, int lane) {
    const bf16* P = (const bf16*)(a.ws + WS_P); const float* cf = (const float*)(a.ws + WS_CFOX) + (size_t)bh * SEQ; bf16* mix = (bf16*)(a.ws + WS_MIX);
    const int b = bh >> 3, h = bh & 7; const size_t rowb = (size_t)b * SEQ;
    const unsigned qw = *(const unsigned*)(P + (rowb + t) * NP + C_FQ + 128 * h + 2 * lane);
    const float scale = 0.08838834764831845f; const float q0 = bflo(qw) * scale, q1 = bfhi(qw) * scale; const float ct = cf[t];
    float m = -1e30f, l = 0.f, o0 = 0.f, o1 = 0.f;
    for (int s = 0; s <= t; ++s) {
        const unsigned kw = *(const unsigned*)(P + (rowb + s) * NP + C_FK + 128 * h + 2 * lane), vw = *(const unsigned*)(P + (rowb + s) * NP + C_FV + 128 * h + 2 * lane);
        float d = q0 * bflo(kw) + q1 * bfhi(kw); d = wave_sum(d);
        const float logit = d + (ct - cf[s]);
        const float mn = fmaxf(m, logit), corr = __expf(m - mn), p = __expf(logit - mn);
        l = l * corr + p; o0 = o0 * corr + p * bflo(vw); o1 = o1 * corr + p * bfhi(vw); m = mn;
    }
    const unsigned gw_ = *(const unsigned*)(P + (rowb + t) * NP + C_FG + 128 * h + 2 * lane);
    const float inv = 1.0f / l;
    *(unsigned*)(mix + (rowb + t) * DM + 1024 + 128 * h + 2 * lane) = pk2(o0 * inv * silu_f(bflo(gw_)), o1 * inv * silu_f(bfhi(gw_)));
}
__device__ __forceinline__ void gla_naive(const Args& a, LAS unsigned char* lds, int bh, int tid) {
    const bf16* P = (const bf16*)(a.ws + WS_P); const float* small = (const float*)(a.ws + WS_SMALL); float* oraw = (float*)(a.ws + WS_ORAW);
    const int b = bh >> 2, h = bh & 3; const size_t rowb = (size_t)b * SEQ;
    LAS float* A = (LAS float*)lds; LAS float* Kk = A + 8 * 128; LAS float* Qq = Kk + 8 * 128; LAS float* Vv = Qq + 8 * 128; LAS float* OP = Vv + 8 * 256;
    const int dv = tid & 255, kh = tid >> 8;
    float S[64];
#pragma unroll
    for (int j = 0; j < 64; ++j) S[j] = 0.f;
    const float qscale = 0.08838834764831845f;
    for (int tb = 0; tb < SEQ / 8; ++tb) {
        for (int idx = tid; idx < 1024; idx += NTHR) { const int tt = idx >> 7, k = idx & 127; const size_t row = rowb + tb * 8 + tt;
            float z = a.alpha_b[128 * h + k];
#pragma unroll
            for (int r = 0; r < 16; ++r) z += small[row * 32 + r] * a.alpha_up[r * 512 + 128 * h + k];
            A[idx] = __expf(logsigmoid_f(z) * (1.0f / 16.0f)); Kk[idx] = bf2f(P[row * NP + C_GK + 128 * h + k]); Qq[idx] = bf2f(P[row * NP + C_GQ + 128 * h + k]) * qscale; }
        for (int idx = tid; idx < 2048; idx += NTHR) { const int tt = idx >> 8, d = idx & 255; Vv[idx] = bf2f(P[(rowb + tb * 8 + tt) * NP + C_GV + 256 * h + d]); }
        __syncthreads();
        for (int tt = 0; tt < 8; ++tt) { const float v = Vv[tt * 256 + dv]; float o = 0.f;
#pragma unroll
            for (int j = 0; j < 64; ++j) { const int ki = tt * 128 + kh * 64 + j; S[j] = A[ki] * S[j] + Kk[ki] * v; o += Qq[ki] * S[j]; }
            OP[(tt * 2 + kh) * 256 + dv] = o; }
        __syncthreads();
        for (int idx = tid; idx < 2048; idx += NTHR) { const int tt = idx >> 8, d = idx & 255; oraw[(rowb + tb * 8 + tt) * 1024 + 256 * h + d] = OP[(tt * 2) * 256 + d] + OP[(tt * 2 + 1) * 256 + d]; }
    }
}
__device__ __forceinline__ void gla_pass_a(const Args& a, LAS unsigned char* lds, int unit, int tid);
__device__ __forceinline__ void gla_pass_c(const Args& a, LAS unsigned char* lds, int unit, int tid);
__device__ __forceinline__ void phase_gla_b(const Args& a, int tid, int gw, int NG);
__device__ __forceinline__ void phase_gla_b2(const Args& a, int tid, int gw, int NG);
__device__ __forceinline__ void sub_barrier(unsigned* cnt, unsigned target) {
    asm volatile("s_waitcnt vmcnt(0)" ::: "memory"); __syncthreads();
    if (threadIdx.x == 0) {
        __builtin_amdgcn_fence(__ATOMIC_RELEASE, "agent"); asm volatile("s_waitcnt vmcnt(0)" ::: "memory");
        __hip_atomic_fetch_add(cnt, 1u, __ATOMIC_RELAXED, __HIP_MEMORY_SCOPE_AGENT);
        unsigned sp = 0; while (__hip_atomic_load(cnt, __ATOMIC_RELAXED, __HIP_MEMORY_SCOPE_AGENT) < target) { __builtin_amdgcn_s_sleep(2); if (++sp > (1u << 22)) break; }
        __builtin_amdgcn_fence(__ATOMIC_ACQUIRE, "agent"); asm volatile("s_waitcnt vmcnt(0)" ::: "memory");
    }
    __syncthreads();
}
__device__ __forceinline__ fox::BlockRef<bf16, bf16> fox_ref(const Args& a, int bh, int qb, int jlo) {
    const bf16* P = (const bf16*)(a.ws + WS_P); const int b = bh >> 3, h = bh & 7; const size_t row0 = (size_t)b * SEQ + (size_t)qb * 256;
    fox::BlockRef<bf16, bf16> r;
    r.Q = P + row0 * NP + C_FQ + 128 * h; r.K = P + (size_t)b * SEQ * NP + C_FK + 128 * h; r.V = P + (size_t)b * SEQ * NP + C_FV + 128 * h;
    r.O = (bf16*)(a.ws + WS_MIX) + row0 * DM + 1024 + 128 * h; r.G = P + row0 * NP + C_FG + 128 * h; r.P0 = qb * 256; r.jlo = jlo;
    return r;
}
__device__ __forceinline__ void phase_fox(const Args& a, char* lds, int w) {
    const int bh = 2 * (w & 7) + (w >> 7), qb = (w >> 3) & 15, P0 = qb * 256;
    fox::lds_f32* cb = (fox::lds_f32*)(lds + fox::LDS_BYTES);
    {   const float* cf = (const float*)(a.ws + WS_CFOX) + (size_t)bh * SEQ;
        for (int j = threadIdx.x; j < P0 + 256; j += NTHR) cb[j] = cf[j] * (-1.0f / fox::SCALE); }
    __syncthreads();
    int jl0;
    {   const float* nm = (const float*)(a.ws + WS_BAR + 20480) + (size_t)bh * 8;
        const float qn2 = (nm[0] + nm[1]) + (nm[2] + nm[3]), kn2 = (nm[4] + nm[5]) + (nm[6] + nm[7]);
        const float thr = -(50.0f / fox::SCALE) - 2.0f * 1.02f * sqrtf(qn2 * kn2);
        const int lane = threadIdx.x & 63;
        const bool skip = lane < P0 / 64 && (cb[64 * lane + 63] - cb[P0] <= thr);
        jl0 = __builtin_amdgcn_readfirstlane((int)__builtin_popcountll(__ballot(skip)));
    }
    const fox::BlockRef<bf16, bf16> cur = fox_ref(a, bh, qb, jl0);
    fox::Seam<bf16> S;
    fox::causal_swa_prime<bf16, bf16>(cur, SEQ, lds, S);
    fox::causal_swa_block<bf16, bf16>(cur, cur, SEQ, SEQ, lds, S);
}
__device__ __forceinline__ void phase_m1(const Args& a, LAS unsigned char* lds, int tid, int G) {
    for (int unit = blockIdx.x; unit < 512; unit += G) gla_pass_a(a, lds, unit, tid);
    __syncthreads();
    phase_fox_cumsum(a, lds, tid, G);
}
__device__ __forceinline__ void phase_m2(const Args& a, unsigned char* lds_raw, int tid, int G) {
    if (G * NTHR >= 131072) phase_gla_b2(a, tid, blockIdx.x, G); else phase_gla_b(a, tid, blockIdx.x, G);
    if (blockIdx.x < 256) phase_fox(a, (char*)lds_raw, blockIdx.x);
}
__device__ __forceinline__ void phase_gla_finalize(const Args& a, int tid, int G) {
    const int lane = tid & 63, wave = tid >> 6; const int gw = blockIdx.x * NWAVES + wave, NGW = G * NWAVES;
    const bf16* P = (const bf16*)(a.ws + WS_P); const float* oraw = (const float*)(a.ws + WS_ORAW); bf16* mix = (bf16*)(a.ws + WS_MIX);
    for (int it = gw; it < MROWS * 4; it += NGW) { const int row = it >> 2, h = it & 3;
        const f32x4 v = *(const f32x4*)(oraw + (size_t)row * 1024 + 256 * h + 4 * lane);
        float s = (v[0] * v[0] + v[1] * v[1]) + (v[2] * v[2] + v[3] * v[3]); s = wave_sum(s);
        const float r = rsqrtf(s * (1.0f / 256.0f) + EPS);
        const f32x4 g = *(const f32x4*)(a.head_g + 256 * h + 4 * lane);
        const v2u gt = *(const v2u*)(P + (size_t)row * NP + C_GG + 256 * h + 4 * lane);
        v2u w; w.x = pk2(v[0] * r * g[0] * silu_f(bflo(gt.x)), v[1] * r * g[1] * silu_f(bfhi(gt.x))); w.y = pk2(v[2] * r * g[2] * silu_f(bflo(gt.y)), v[3] * r * g[3] * silu_f(bfhi(gt.y)));
        *(v2u*)(mix + (size_t)row * DM + 256 * h + 4 * lane) = w; }
    for (int row0 = gw; row0 < MROWS; row0 += 4 * NGW) {
        v4u m[4][2], g[4][2];
#pragma unroll
        for (int rr = 0; rr < 4; ++rr) { const int row = row0 + rr * NGW; if (row < MROWS) { const v4u* mp = (const v4u*)(mix + (size_t)row * DM + 1024 + 16 * lane); const v4u* gp = (const v4u*)(P + (size_t)row * NP + C_FG + 16 * lane);
            m[rr][0] = mp[0]; m[rr][1] = mp[1]; g[rr][0] = gp[0]; g[rr][1] = gp[1]; } }
#pragma unroll
        for (int rr = 0; rr < 4; ++rr) { const int row = row0 + rr * NGW; if (row < MROWS) { v4u* mp = (v4u*)(mix + (size_t)row * DM + 1024 + 16 * lane);
#pragma unroll
            for (int q = 0; q < 2; ++q) { v4u o;
#pragma unroll
                for (int e = 0; e < 4; ++e) o[e] = pk2(bflo(m[rr][q][e]) * silu_f(bflo(g[rr][q][e])), bfhi(m[rr][q][e]) * silu_f(bfhi(g[rr][q][e])));
                mp[q] = o; } } }
    }
}
__device__ __forceinline__ void phase_s5_naive(const Args& a, int tid, int G) {
    const int lane = tid & 63, wave = tid >> 6; const int gw = blockIdx.x * NWAVES + wave;
    if (gw >= 256) return;
    const int b = gw >> 7, g = gw & 127, p = lane;
    const bf16* UG = (const bf16*)(a.ws + WS_UG); bf16* zb = (bf16*)(a.ws + WS_ZB);
    const float lr = fminf(a.lam_re[g * 64 + p], -1e-4f), li = a.lam_im[g * 64 + p], step = __expf(a.log_step[g]);
    const float mag = __expf(lr * step), lbr = mag * cosf(li * step), lbi = mag * sinf(li * step);
    const float den = lr * lr + li * li, nr = lbr - 1.0f, ni = lbi, cr = (nr * lr + ni * li) / den, ci = (ni * lr - nr * li) / den;
    float bbr[16], bbi[16], ccr[16], cci[16];
#pragma unroll
    for (int c = 0; c < 16; ++c) { const float br = a.b_re[(g * 64 + p) * 16 + c], bi = a.b_im[(g * 64 + p) * 16 + c]; bbr[c] = cr * br - ci * bi; bbi[c] = cr * bi + ci * br;
        ccr[c] = a.c_re[(g * 16 + c) * 64 + p]; cci[c] = a.c_im[(g * 16 + c) * 64 + p]; }
    const float dd = a.s5_d[g * 16 + (lane & 15)];
    float xr = 0.f, xi = 0.f;
    for (int t = 0; t < SEQ; ++t) { const size_t row = (size_t)b * SEQ + t;
        const v4u u0 = *(const v4u*)(UG + row * 4096 + 16 * g), u1 = *(const v4u*)(UG + row * 4096 + 16 * g + 8);
        float u[16];
#pragma unroll
        for (int e = 0; e < 4; ++e) { u[2 * e] = bflo(u0[e]); u[2 * e + 1] = bfhi(u0[e]); u[8 + 2 * e] = bflo(u1[e]); u[8 + 2 * e + 1] = bfhi(u1[e]); }
        float br = 0.f, bi = 0.f;
#pragma unroll
        for (int c = 0; c < 16; ++c) { br += bbr[c] * u[c]; bi += bbi[c] * u[c]; }
        const float nxr = lbr * xr - lbi * xi + br, nxi = lbr * xi + lbi * xr + bi; xr = nxr; xi = nxi;
        float ymine = 0.f, umine = 0.f;
#pragma unroll
        for (int c = 0; c < 16; ++c) { const float y = wave_sum(ccr[c] * xr - cci[c] * xi); if ((lane & 15) == c) { ymine = y; umine = u[c]; } }
        if (lane < 16) { const float y = ymine + dd * umine; zb[row * DM + 16 * g + lane] = (bf16)f2bf(gelu_tanh(y)); }
    }
}

typedef short s5_bf16x8 __attribute__((ext_vector_type(8)));
typedef float s5_f32x16 __attribute__((ext_vector_type(16)));
typedef float s5_f32x2 __attribute__((ext_vector_type(2)));
template <bool PASS2>
__device__ __forceinline__ void s5_pass(const bf16* UG, bf16* zb, LAS unsigned char* xl, int g, int seg0, int lane, const s5_bf16x8 (&Bf)[4], const s5_bf16x8 (&Cf)[4], f32x4 Dv,
                                        float lbr0, float lbi0, float lbr1, float lbi1, s5_f32x2& xr0, s5_f32x2& xi0, s5_f32x2& xr1, s5_f32x2& xi1, int nblk) {
    const int r = lane & 31, hl = lane >> 5, q4 = lane >> 4;
    const int rgA = 4 * (r >> 3) + (r & 3);
    const bf16* ap = UG + ((size_t)((rgA & 1) * SEQ + seg0 + 128 * ((r >> 2) & 1) + (rgA >> 1))) * 4096 + 16 * g + 8 * hl;
    s5_bf16x8 af = *(const s5_bf16x8*)ap;
    for (int blk = 0; blk < nblk; ++blk) {
        const s5_bf16x8 afn = *(const s5_bf16x8*)(ap + (size_t)((blk < nblk - 1 ? blk + 1 : blk) * 8) * 4096);
        v2u uu2[2] = {};
        if constexpr (PASS2) {
#pragma unroll
            for (int nblk = 0; nblk < 2; ++nblk) { const int i = 16 * nblk + (lane & 15), rg = 4 * (i >> 3) + (i & 3); const size_t rowg = (size_t)((rg & 1) * SEQ + seg0 + 128 * ((i >> 2) & 1) + blk * 8 + (rg >> 1));
                uu2[nblk] = *(const v2u*)(UG + rowg * 4096 + 16 * g + 4 * q4); } }
        s5_f32x16 acc[4];
#pragma unroll
        for (int nb = 0; nb < 4; ++nb) { acc[nb] = s5_f32x16{}; acc[nb] = __builtin_amdgcn_mfma_f32_32x32x16_bf16(af, Bf[nb], acc[nb], 0, 0, 0); }
#pragma unroll
        for (int k = 0; k < 8; ++k) {
            const s5_f32x2 b0r = {acc[0][2 * k], acc[0][2 * k + 1]}, b0i = {acc[2][2 * k], acc[2][2 * k + 1]}, b1r = {acc[1][2 * k], acc[1][2 * k + 1]}, b1i = {acc[3][2 * k], acc[3][2 * k + 1]};
            const s5_f32x2 n0r = lbr0 * xr0 - lbi0 * xi0 + b0r, n0i = lbr0 * xi0 + lbi0 * xr0 + b0i;
            const s5_f32x2 n1r = lbr1 * xr1 - lbi1 * xi1 + b1r, n1i = lbr1 * xi1 + lbi1 * xr1 + b1i;
            xr0 = n0r; xi0 = n0i; xr1 = n1r; xi1 = n1i;
            acc[0][2 * k] = n0r.x; acc[0][2 * k + 1] = n0r.y; acc[2][2 * k] = n0i.x; acc[2][2 * k + 1] = n0i.y; acc[1][2 * k] = n1r.x; acc[1][2 * k + 1] = n1r.y; acc[3][2 * k] = n1i.x; acc[3][2 * k + 1] = n1i.y;
        }
        if constexpr (PASS2) {
#pragma unroll
            for (int nb = 0; nb < 4; ++nb)
#pragma unroll
                for (int t = 0; t < 16; t += 2) { const int i = (t & 3) + 8 * (t >> 2) + 4 * hl; const unsigned pw = pk2(acc[nb][t], acc[nb][t + 1]);
                    *(LAS unsigned short*)(xl + i * 272 + (32 * nb + r) * 2) = (unsigned short)pw; *(LAS unsigned short*)(xl + (i + 1) * 272 + (32 * nb + r) * 2) = (unsigned short)(pw >> 16); }
            asm volatile("s_waitcnt lgkmcnt(0)" ::: "memory"); __builtin_amdgcn_wave_barrier();
#pragma unroll
            for (int nblk = 0; nblk < 2; ++nblk) {
                const int i = 16 * nblk + (lane & 15), rg = 4 * (i >> 3) + (i & 3);
                f32x4 y = {0.f, 0.f, 0.f, 0.f};
#pragma unroll
                for (int ks = 0; ks < 4; ++ks) { const s5_bf16x8 xf = *(const LAS s5_bf16x8*)(xl + i * 272 + 64 * ks + 16 * q4); y = __builtin_amdgcn_mfma_f32_16x16x32_bf16(Cf[ks], xf, y, 0, 0, 0); }
                const size_t rowg = (size_t)((rg & 1) * SEQ + seg0 + 128 * ((i >> 2) & 1) + blk * 8 + (rg >> 1));
                const v2u uu = uu2[nblk];
                const float z0 = gelu_tanh(y[0] + Dv[0] * bflo(uu.x)), z1 = gelu_tanh(y[1] + Dv[1] * bfhi(uu.x)), z2 = gelu_tanh(y[2] + Dv[2] * bflo(uu.y)), z3 = gelu_tanh(y[3] + Dv[3] * bfhi(uu.y));
                v2u w; w.x = pk2(z0, z1); w.y = pk2(z2, z3); *(v2u*)(zb + rowg * DM + 16 * g + 4 * q4) = w;
            }
            asm volatile("s_waitcnt lgkmcnt(0)" ::: "memory"); __builtin_amdgcn_wave_barrier();
        }
        af = afn;
    }
}
constexpr size_t WS_S5E = 56 * MiB;
__device__ __forceinline__ void phase_s5(const Args& a, LAS unsigned char* lds, int tid) {
    if (blockIdx.x >= 256) return;
    const int wave0 = __builtin_amdgcn_readfirstlane(tid >> 6);
    const int g = (blockIdx.x & 15) * 8 + wave0, seg_wg = blockIdx.x >> 4;
    const int lane = tid & 63, wave = wave0, r = lane & 31, hl = lane >> 5, q4 = lane >> 4, ch = lane & 15;
    const bf16* UG = (const bf16*)(a.ws + WS_UG); bf16* zb = (bf16*)(a.ws + WS_ZB);
    const float step = __expf(a.log_step[g]);
    float lbr[2], lbi[2]; s5_bf16x8 Bf[4], Cf[4];
#pragma unroll
    for (int s2 = 0; s2 < 2; ++s2) { const int p = r + 32 * s2;
        const float lr = fminf(a.lam_re[g * 64 + p], -1e-4f), li = a.lam_im[g * 64 + p];
        const float mag = __expf(lr * step); lbr[s2] = mag * cosf(li * step); lbi[s2] = mag * sinf(li * step);
        const float den = lr * lr + li * li, nr = lbr[s2] - 1.0f, ni = lbi[s2], cr = (nr * lr + ni * li) / den, ci = (ni * lr - nr * li) / den;
        const f32x4 br0 = *(const f32x4*)(a.b_re + (size_t)(g * 64 + p) * 16 + 8 * hl), br1 = *(const f32x4*)(a.b_re + (size_t)(g * 64 + p) * 16 + 8 * hl + 4);
        const f32x4 bi0 = *(const f32x4*)(a.b_im + (size_t)(g * 64 + p) * 16 + 8 * hl), bi1 = *(const f32x4*)(a.b_im + (size_t)(g * 64 + p) * 16 + 8 * hl + 4);
#pragma unroll
        for (int j = 0; j < 8; ++j) { const float br = j < 4 ? br0[j & 3] : br1[j & 3], bi = j < 4 ? bi0[j & 3] : bi1[j & 3];
            Bf[s2][j] = (short)f2bf(cr * br - ci * bi); Bf[2 + s2][j] = (short)f2bf(cr * bi + ci * br); } }
#pragma unroll
    for (int ks = 0; ks < 4; ++ks) { const int st = (ks & 1) * 32 + 8 * q4; const float* src = (ks < 2 ? a.c_re : a.c_im) + (size_t)(g * 16 + ch) * 64 + st;
        const f32x4 c0 = *(const f32x4*)src, c1 = *(const f32x4*)(src + 4);
#pragma unroll
        for (int j = 0; j < 8; ++j) { const float v = j < 4 ? c0[j & 3] : c1[j & 3]; Cf[ks][j] = (short)f2bf(ks < 2 ? v : -v); } }
    const f32x4 Dv = *(const f32x4*)(a.s5_d + g * 16 + 4 * q4);
    LAS unsigned char* xl = lds + wave * 8704; float* Ef = (float*)(a.ws + WS_S5E) + (size_t)g * 32 * 32 * 8;
    const int seg = seg_wg, subseg = 2 * seg + hl;
    s5_f32x2 xr0 = {0.f, 0.f}, xi0 = {0.f, 0.f}, xr1 = {0.f, 0.f}, xi1 = {0.f, 0.f};
    s5_pass<false>(UG, zb, xl, g, seg * 256, lane, Bf, Cf, Dv, lbr[0], lbi[0], lbr[1], lbi[1], xr0, xi0, xr1, xi1, 16);
    {   unsigned long long* E64 = (unsigned long long*)(Ef + (size_t)(subseg * 32 + r) * 8);
        __hip_atomic_store(E64, ((unsigned long long)__float_as_uint(xr0.y) << 32) | __float_as_uint(xr0.x), __ATOMIC_RELAXED, __HIP_MEMORY_SCOPE_AGENT);
        __hip_atomic_store(E64 + 1, ((unsigned long long)__float_as_uint(xi0.y) << 32) | __float_as_uint(xi0.x), __ATOMIC_RELAXED, __HIP_MEMORY_SCOPE_AGENT);
        __hip_atomic_store(E64 + 2, ((unsigned long long)__float_as_uint(xr1.y) << 32) | __float_as_uint(xr1.x), __ATOMIC_RELAXED, __HIP_MEMORY_SCOPE_AGENT);
        __hip_atomic_store(E64 + 3, ((unsigned long long)__float_as_uint(xi1.y) << 32) | __float_as_uint(xi1.x), __ATOMIC_RELAXED, __HIP_MEMORY_SCOPE_AGENT); }
    asm volatile("s_waitcnt vmcnt(0)" ::: "memory"); __syncthreads();
    unsigned* cnt = (unsigned*)(a.ws + WS_BAR + 18432) + 16 * (blockIdx.x & 15);
    if (tid == 0) { __hip_atomic_fetch_add(cnt, 1u, __ATOMIC_RELAXED, __HIP_MEMORY_SCOPE_AGENT);
        unsigned sp = 0; while (__hip_atomic_load(cnt, __ATOMIC_RELAXED, __HIP_MEMORY_SCOPE_AGENT) < 16u) { __builtin_amdgcn_s_sleep(2); if (++sp > (1u << 20)) break; }
        __builtin_amdgcn_fence(__ATOMIC_ACQUIRE, "agent"); asm volatile("s_waitcnt vmcnt(0)" ::: "memory"); }
    __syncthreads();
    {   float p0r = lbr[0], p0i = lbi[0], p1r = lbr[1], p1i = lbi[1];
#pragma unroll
        for (int s = 0; s < 7; ++s) { const float a0 = p0r * p0r - p0i * p0i, b0 = 2.f * p0r * p0i, a1 = p1r * p1r - p1i * p1i, b1 = 2.f * p1r * p1i; p0r = a0; p0i = b0; p1r = a1; p1i = b1; }
        xr0 = (s5_f32x2){0.f, 0.f}; xi0 = xr0; xr1 = xr0; xi1 = xr0;
        for (int s = 0; s < 2 * seg + 1; ++s) { if (s < subseg) { const f32x4 e0 = *(const f32x4*)(Ef + (size_t)(s * 32 + r) * 8), e1 = *(const f32x4*)(Ef + (size_t)(s * 32 + r) * 8 + 4);
            const s5_f32x2 er0 = {e0[0], e0[1]}, ei0 = {e0[2], e0[3]}, er1 = {e1[0], e1[1]}, ei1 = {e1[2], e1[3]};
            const s5_f32x2 n0r = p0r * xr0 - p0i * xi0 + er0, n0i = p0r * xi0 + p0i * xr0 + ei0, n1r = p1r * xr1 - p1i * xi1 + er1, n1i = p1r * xi1 + p1i * xr1 + ei1;
            xr0 = n0r; xi0 = n0i; xr1 = n1r; xi1 = n1i; } }
        s5_pass<true>(UG, zb, xl, g, seg * 256, lane, Bf, Cf, Dv, lbr[0], lbi[0], lbr[1], lbi[1], xr0, xi0, xr1, xi1, 16);
    }
}
constexpr size_t WS_S5E_DUMMY = 0;

typedef short g_bf16x8 __attribute__((ext_vector_type(8)));
typedef float g_f32x16 __attribute__((ext_vector_type(16)));
constexpr size_t WS_QT = 44 * MiB, WS_OINTRA = 52 * MiB, WS_SINT = 221 * MiB, WS_DECAY = WS_PART2;
__device__ __forceinline__ int g_irow(int reg, int hl) { return (reg & 3) + 8 * (reg >> 2) + 4 * hl; }
__device__ __forceinline__ void gla_pass_a(const Args& a, LAS unsigned char* lds, int unit, int tid) {
    const bf16* P = (const bf16*)(a.ws + WS_P); const float* small = (const float*)(a.ws + WS_SMALL);
    bf16* qtg = (bf16*)(a.ws + WS_QT); unsigned* oin = (unsigned*)(a.ws + WS_OINTRA); bf16* kvt = (bf16*)a.out; float* decay = (float*)(a.ws + WS_DECAY);
    const int bh = unit >> 6, n = unit & 63, b = bh >> 2, h = bh & 3; const size_t R0 = (size_t)b * SEQ + 64 * n;
    LAS bf16* QT = (LAS bf16*)lds; LAS bf16* KT = (LAS bf16*)(lds + 17408); LAS bf16* KH = (LAS bf16*)(lds + 34816); LAS bf16* VT = (LAS bf16*)(lds + 53248); LAS bf16* AT = (LAS bf16*)(lds + 90112); LAS float* PART = (LAS float*)(lds + 99328);
    const int lane = tid & 63, w = __builtin_amdgcn_readfirstlane(tid >> 6), r = lane & 31, hl = lane >> 5;
    __syncthreads();
    {
        const int col = tid & 127, qtr = tid >> 7; const float ab = a.alpha_b[128 * h + col]; float au[16];
#pragma unroll
        for (int rr = 0; rr < 16; ++rr) au[rr] = a.alpha_up[rr * 512 + 128 * h + col];
        bf16 qraw[16], kraw[16];
#pragma unroll
        for (int t = 0; t < 16; ++t) { const size_t row = R0 + 16 * qtr + t; qraw[t] = P[row * NP + C_GQ + 128 * h + col]; kraw[t] = P[row * NP + C_GK + 128 * h + col]; }
        float cs[16]; float run = 0.f;
#pragma unroll
        for (int t = 0; t < 16; ++t) { const size_t row = R0 + 16 * qtr + t; const f32x4* sp = (const f32x4*)(small + row * 32); float z = ab;
#pragma unroll
            for (int q = 0; q < 4; ++q) { const f32x4 s4 = sp[q]; z += s4[0] * au[4 * q] + s4[1] * au[4 * q + 1] + s4[2] * au[4 * q + 2] + s4[3] * au[4 * q + 3]; }
            run += logsigmoid_f(z) * (1.0f / 16.0f); cs[t] = run; }
        PART[qtr * 128 + col] = run;
        {   const int dv = tid & 255, half = tid >> 8;
#pragma unroll 8
            for (int t = 0; t < 32; t += 2) { const int tok = 32 * half + t; const unsigned lo = P[(R0 + tok) * NP + C_GV + 256 * h + dv], hi2 = P[(R0 + tok + 1) * NP + C_GV + 256 * h + dv];
                *(LAS unsigned*)(VT + dv * 72 + tok) = lo | (hi2 << 16); } }
        __syncthreads();
        float pre = 0.f, tot = 0.f;
#pragma unroll
        for (int q = 0; q < 4; ++q) { const float v = PART[q * 128 + col]; tot += v; if (q < qtr) pre += v; }
        const float qscale = 0.08838834764831845f;
#pragma unroll
        for (int t = 0; t < 16; t += 2) { float khv[2];
#pragma unroll
            for (int u2 = 0; u2 < 2; ++u2) { const int tok = 16 * qtr + t + u2; const size_t row = R0 + tok; const float bb = pre + cs[t + u2];
                const float qv = bf2f(qraw[t + u2]) * qscale * __expf(bb), kv = bf2f(kraw[t + u2]);
                const bf16 qb = (bf16)f2bf(qv);
                QT[tok * 136 + col] = qb; KT[tok * 136 + col] = (bf16)f2bf(kv * __expf(-bb)); khv[u2] = kv * __expf(tot - bb); qtg[row * 512 + 128 * h + col] = qb; }
            *(LAS unsigned*)(KH + col * 72 + 16 * qtr + t) = pk2(khv[0], khv[1]); }
        if (qtr == 0) decay[(size_t)unit * 128 + col] = __expf(tot);
    }
    __syncthreads();
    if (w < 4) {
        const int bi = w >> 1, bj = w & 1;
        if (bi == 0 && bj == 1) {
#pragma unroll
            for (int reg = 0; reg < 16; ++reg) AT[g_irow(reg, hl) * 72 + 32 + r] = 0;
        } else {
            g_f32x16 acc = g_f32x16{};
#pragma unroll
            for (int ks = 0; ks < 8; ++ks) { const g_bf16x8 af = *(const LAS g_bf16x8*)(QT + (32 * bi + r) * 136 + 16 * ks + 8 * hl), bf = *(const LAS g_bf16x8*)(KT + (32 * bj + r) * 136 + 16 * ks + 8 * hl);
                acc = __builtin_amdgcn_mfma_f32_32x32x16_bf16(af, bf, acc, 0, 0, 0); }
#pragma unroll
            for (int reg = 0; reg < 16; ++reg) { const int i = 32 * bi + g_irow(reg, hl), j = 32 * bj + r; AT[i * 72 + j] = (bf16)f2bf(j <= i ? acc[reg] : 0.f); }
        }
    }
    __syncthreads();
    {
#pragma unroll
        for (int bi = 0; bi < 2; ++bi) { g_f32x16 acc = g_f32x16{};
#pragma unroll
            for (int ks = 0; ks < 4; ++ks) { if (bi == 0 && ks >= 2) continue;
                const g_bf16x8 af = *(const LAS g_bf16x8*)(AT + (32 * bi + r) * 72 + 16 * ks + 8 * hl), bf = *(const LAS g_bf16x8*)(VT + (32 * w + r) * 72 + 16 * ks + 8 * hl);
                acc = __builtin_amdgcn_mfma_f32_32x32x16_bf16(bf, af, acc, 0, 0, 0); }
            v4u o0, o1;
#pragma unroll
            for (int e = 0; e < 4; ++e) { o0[e] = pk2(acc[2 * e], acc[2 * e + 1]); o1[e] = pk2(acc[8 + 2 * e], acc[8 + 2 * e + 1]); }
            v4u* op = (v4u*)(oin + ((size_t)((unit * 8 + w) * 2 + bi) * 64 + lane) * 8); op[0] = o0; op[1] = o1; }
        g_bf16x8 av[4];
#pragma unroll
        for (int ks = 0; ks < 4; ++ks) av[ks] = *(const LAS g_bf16x8*)(VT + (32 * w + r) * 72 + 16 * ks + 8 * hl);
#pragma unroll
        for (int nb = 0; nb < 4; ++nb) { g_f32x16 acc = g_f32x16{};
#pragma unroll
            for (int ks = 0; ks < 4; ++ks) { const g_bf16x8 bf = *(const LAS g_bf16x8*)(KH + (32 * nb + r) * 72 + 16 * ks + 8 * hl); acc = __builtin_amdgcn_mfma_f32_32x32x16_bf16(bf, av[ks], acc, 0, 0, 0); }
#pragma unroll
            for (int g4 = 0; g4 < 4; ++g4) { v2u o; o.x = pk2(acc[4 * g4], acc[4 * g4 + 1]); o.y = pk2(acc[4 * g4 + 2], acc[4 * g4 + 3]);
                *(v2u*)(kvt + ((size_t)unit * 256 + 32 * w + r) * 128 + 32 * nb + 8 * g4 + 4 * hl) = o; } }
    }
}
__device__ __forceinline__ void phase_gla_b(const Args& a, int tid, int gw, int NG) {
    const bf16* kvt = (const bf16*)a.out; const float* decay = (const float*)(a.ws + WS_DECAY); bf16* sint = (bf16*)(a.ws + WS_SINT);
    for (size_t qi = (size_t)gw * NTHR + tid; qi < (size_t)2 * 32768; qi += (size_t)NG * NTHR) {
        const size_t idx = qi * 4; const int bh = (int)(idx >> 15), e = (int)(idx & 32767);
        float s0 = 0.f, s1 = 0.f, s2 = 0.f, s3 = 0.f;
#pragma unroll 8
        for (int n = 0; n < 64; ++n) { const size_t unit = (size_t)bh * 64 + n;
            v2u o; o.x = pk2(s0, s1); o.y = pk2(s2, s3); *(v2u*)(sint + unit * 32768 + e) = o;
            const f32x4 d = *(const f32x4*)(decay + unit * 128 + (e & 127)); const v2u kw = *(const v2u*)(kvt + unit * 32768 + e);
            s0 = d[0] * s0 + bflo(kw.x); s1 = d[1] * s1 + bfhi(kw.x); s2 = d[2] * s2 + bflo(kw.y); s3 = d[3] * s3 + bfhi(kw.y); }
    }
}
__device__ __forceinline__ void phase_gla_b2(const Args& a, int tid, int gw, int NG) {
    typedef float f32x2v __attribute__((ext_vector_type(2)));
    const bf16* kvt = (const bf16*)a.out; const float* decay = (const float*)(a.ws + WS_DECAY); bf16* sint = (bf16*)(a.ws + WS_SINT);
    for (size_t pi = (size_t)gw * NTHR + tid; pi < (size_t)4 * 32768; pi += (size_t)NG * NTHR) {
        const size_t idx = pi * 2; const int bh = (int)(idx >> 15), e = (int)(idx & 32767);
        float s0 = 0.f, s1 = 0.f;
#pragma unroll 8
        for (int n = 0; n < 64; ++n) { const size_t unit = (size_t)bh * 64 + n;
            *(unsigned*)(sint + unit * 32768 + e) = pk2(s0, s1);
            const f32x2v d = *(const f32x2v*)(decay + unit * 128 + (e & 127)); const unsigned kw = *(const unsigned*)(kvt + unit * 32768 + e);
            s0 = d.x * s0 + bflo(kw); s1 = d.y * s1 + bfhi(kw); }
    }
}
__device__ __forceinline__ void gla_pass_c(const Args& a, LAS unsigned char* lds, int unit, int tid) {
    const bf16* P = (const bf16*)(a.ws + WS_P); const bf16* qtg = (const bf16*)(a.ws + WS_QT); const unsigned* oin = (const unsigned*)(a.ws + WS_OINTRA); const bf16* sint = (const bf16*)(a.ws + WS_SINT); bf16* mix = (bf16*)(a.ws + WS_MIX);
    const int bh = unit >> 6, n = unit & 63, b = bh >> 2, h = bh & 3; const size_t R0 = (size_t)b * SEQ + 64 * n;
    const int lane = tid & 63, w = __builtin_amdgcn_readfirstlane(tid >> 6), r = lane & 31, hl = lane >> 5;
    LAS float* RED = (LAS float*)lds; LAS float* RSTD = RED + 1024;
    g_f32x16 acc[2];
#pragma unroll
    for (int bi = 0; bi < 2; ++bi) { const v4u* op = (const v4u*)(oin + ((size_t)((unit * 8 + w) * 2 + bi) * 64 + lane) * 8); const v4u o0 = op[0], o1 = op[1];
#pragma unroll
        for (int e = 0; e < 4; ++e) { acc[bi][2 * e] = bflo(o0[e]); acc[bi][2 * e + 1] = bfhi(o0[e]); acc[bi][8 + 2 * e] = bflo(o1[e]); acc[bi][8 + 2 * e + 1] = bfhi(o1[e]); } }
    v4u gpre[4]; f32x4 hgv[4];
#pragma unroll
    for (int i = 0; i < 4; ++i) { const int p = tid + 512 * i; gpre[i] = *(const v4u*)(P + (R0 + (p >> 5)) * NP + C_GG + 256 * h + (p & 31) * 8); }
#pragma unroll
    for (int g4 = 0; g4 < 4; ++g4) hgv[g4] = *(const f32x4*)(a.head_g + 256 * h + 32 * w + 8 * g4 + 4 * hl);
#pragma unroll
    for (int ks = 0; ks < 8; ++ks) { const g_bf16x8 sf = *(const g_bf16x8*)(sint + ((size_t)unit * 256 + 32 * w + r) * 128 + 16 * ks + 8 * hl);
#pragma unroll
        for (int bi = 0; bi < 2; ++bi) { const g_bf16x8 qf = *(const g_bf16x8*)(qtg + (R0 + 32 * bi + r) * 512 + 128 * h + 16 * ks + 8 * hl); acc[bi] = __builtin_amdgcn_mfma_f32_32x32x16_bf16(sf, qf, acc[bi], 0, 0, 0); } }
    __syncthreads();
#pragma unroll
    for (int bi = 0; bi < 2; ++bi) { float s = 0.f;
#pragma unroll
        for (int reg = 0; reg < 16; ++reg) s += acc[bi][reg] * acc[bi][reg];
        RED[(w * 2 + hl) * 64 + 32 * bi + r] = s; }
    __syncthreads();
    if (tid < 64) { float t = 0.f;
#pragma unroll
        for (int q = 0; q < 16; ++q) t += RED[q * 64 + tid];
        RSTD[tid] = rsqrtf(t * (1.0f / 256.0f) + EPS); }
    __syncthreads();
    LAS bf16* T = (LAS bf16*)(lds + 8192);
#pragma unroll
    for (int bi = 0; bi < 2; ++bi) { const int tok = 32 * bi + r; const float rs = RSTD[tok];
#pragma unroll
        for (int g4 = 0; g4 < 4; ++g4) { const int dv0 = 32 * w + 8 * g4 + 4 * hl; const f32x4 hg = hgv[g4];
            v2u o; o.x = pk2(acc[bi][4 * g4] * rs * hg[0], acc[bi][4 * g4 + 1] * rs * hg[1]); o.y = pk2(acc[bi][4 * g4 + 2] * rs * hg[2], acc[bi][4 * g4 + 3] * rs * hg[3]);
            *(LAS v2u*)(T + tok * 264 + dv0) = o; } }
    __syncthreads();
#pragma unroll
    for (int i = 0; i < 4; ++i) { const int p = tid + 512 * i, tok = p >> 5, c8 = (p & 31) * 8; const v4u ov = *(const LAS v4u*)(T + tok * 264 + c8); const v4u gv = gpre[i]; v4u o;
#pragma unroll
        for (int e = 0; e < 4; ++e) o[e] = pk2(bflo(ov[e]) * silu_f(bflo(gv[e])), bfhi(ov[e]) * silu_f(bfhi(gv[e])));
        *(v4u*)(mix + (R0 + tok) * DM + 256 * h + c8) = o; }
}
__device__ __forceinline__ void phase_gla_c(const Args& a, LAS unsigned char* lds, int tid, int G) {
    for (int unit = blockIdx.x; unit < 512; unit += G) gla_pass_c(a, lds, unit, tid);
}
__device__ __forceinline__ void phase_final_norm(const Args& a, int tid, int G) {
    const int lane = tid & 63, wave = tid >> 6; const int gw = blockIdx.x * NWAVES + wave, NGW = G * NWAVES;
    const float* part2 = (const float*)(a.ws + WS_PART2);
    for (int m = gw; m < MROWS; m += NGW) {
        float s = (lane < 32) ? part2[(size_t)m * 32 + lane] : 0.f; s = wave_sum(s);
        const float r = rsqrtf(s * (1.0f / DM) + EPS);
        f32x4* xr = (f32x4*)(a.out + (size_t)m * DM) + lane; const f32x4* gr = (const f32x4*)a.final_g + lane;
#pragma unroll
        for (int j = 0; j < 8; ++j) { f32x4 v = xr[64 * j]; const f32x4 g = gr[64 * j]; v[0] *= r * g[0]; v[1] *= r * g[1]; v[2] *= r * g[2]; v[3] *= r * g[3]; xr[64 * j] = v; }
    }
}

constexpr int NPHASE = 11;
__global__ void __launch_bounds__(NTHR, 2) trunk_fwd(Args a) {
    extern __shared__ __attribute__((aligned(16))) unsigned char lds_raw[];
    LAS unsigned char* lds = (LAS unsigned char*)lds_raw;
    cg::grid_group grid = cg::this_grid();
    const int tid = threadIdx.x, G = gridDim.x;
    const int lo = a.ph_lo, hi = a.ph_hi;
#define IN(k) (lo <= (k) && (k) < hi)
#define SEAM(k) do { if (IN(k) && IN((k) + 1)) { if (hi > 1000) grid.sync();   xcd_barrier(bar); } } while (0)
    unsigned char* ws = a.ws;
    volatile LAS unsigned* bst = (volatile LAS unsigned*)(lds + LDS_BYTES - 16);
    if (tid < 4) bst[tid] = 0u;
    __syncthreads();
    XcdBarrier bar; bar.bar = (unsigned*)(ws + WS_BAR); bar.x = 0; bar.st = bst;
    if (hi - lo > 1) bar = xcd_barrier_post((unsigned*)(ws + WS_BAR), bst);
    if (IN(0)) { phase_prologue(a, lds, tid, G); } SEAM(0);
    if (IN(1)) {
        pg8::Gemm g{(const pg8::bf16_t*)(ws + WS_XB), (const pg8::bf16_t*)(ws + WS_WIN), MROWS, NP, DM}; pg8::StaticOrder S; S.init(MROWS, NP, G, (int)blockIdx.x);
        pg8::EpiScaleBf16 E{(pg8::bf16_t*)(ws + WS_P), NP, (const float*)(ws + WS_RSTD0), nullptr, C_SMALL / 256, (float*)(ws + WS_SMALL), (float*)(ws + WS_BAR + 20480), C_FQ / 256};
        pg8::gemm_phase<pg8::EpiScaleBf16, pg8::StaticOrder, true, true>(lds, g, S, E);
        { const int nwg = (MROWS / 256) * (NP / 256), rem = nwg % G, first = rem, nidle = G - first;
          if ((int)blockIdx.x >= first) { __syncthreads(); prologue_late(a, lds, tid, (int)blockIdx.x - first, nidle); } }
    } SEAM(1);
    if (IN(3)) { phase_m1(a, lds, tid, G); } SEAM(3);
    if (IN(4)) { phase_m2(a, lds_raw, tid, G); } SEAM(4);
    if (IN(5)) { phase_gla_c(a, lds, tid, G); } SEAM(5);
    if (IN(6)) {
        pg8::Gemm g{(const pg8::bf16_t*)(ws + WS_MIX), (const pg8::bf16_t*)(ws + WS_WOUT), MROWS, DM, DM}; pg8::StaticOrder S; S.init(MROWS, DM, G, (int)blockIdx.x);
        pg8::EpiResid E{a.x, nullptr, (pg8::bf16_t*)(ws + WS_X1), (float*)(ws + WS_PART1), DM};
        pg8::gemm_phase<pg8::EpiResid, pg8::StaticOrder, true, true>(lds, g, S, E);
    } SEAM(6);
    if (IN(7)) {
        pg8::Gemm g{(const pg8::bf16_t*)(ws + WS_X1), (const pg8::bf16_t*)(ws + WS_WCIN), MROWS, 4096, DM}; pg8::StaticOrder S; S.init(MROWS, 4096, G, (int)blockIdx.x);
        pg8::EpiScaleBf16 E{(pg8::bf16_t*)(ws + WS_UG), 4096, nullptr, (const float*)(ws + WS_PART1), -1, nullptr, nullptr, 0};
        pg8::gemm_phase<pg8::EpiScaleBf16, pg8::StaticOrder, true, true>(lds, g, S, E);
    } SEAM(7);
    if (IN(8)) { phase_s5(a, lds, tid); } SEAM(8);
    if (IN(9)) {
        pg8::Gemm g{(const pg8::bf16_t*)(ws + WS_ZB), (const pg8::bf16_t*)(ws + WS_WGLU), MROWS, DM, DM}; pg8::StaticOrder S; S.init(MROWS, DM, G, (int)blockIdx.x);
        pg8::EpiGlu E{(const pg8::bf16_t*)(ws + WS_ZB), (const pg8::bf16_t*)(ws + WS_UG), a.glu_b, (pg8::bf16_t*)(ws + WS_TB)};
        pg8::gemm_phase<pg8::EpiGlu, pg8::StaticOrder, true, true>(lds, g, S, E);
    } SEAM(9);
    if (IN(10)) {
        pg8::Gemm g{(const pg8::bf16_t*)(ws + WS_TB), (const pg8::bf16_t*)(ws + WS_WCOUT), MROWS, DM, DM}; pg8::StaticOrder S; S.init(MROWS, DM, G, (int)blockIdx.x);
        pg8::EpiFinalNorm E{(const pg8::bf16_t*)(ws + WS_X1), a.out, (float*)(ws + WS_PART2), (unsigned*)(ws + WS_BAR + 16384), a.final_g, DM};
        pg8::gemm_phase<pg8::EpiFinalNorm, pg8::StaticOrder, false, true>(lds, g, S, E);
    }
#undef IN
#undef SEAM
}

#ifndef MK_ONE_LAUNCH
#define MK_ONE_LAUNCH 1
#endif
extern "C" void kernel_launch(void* const* d_in, const int* in_sizes, int n_in, void* d_out, int out_size, void* d_ws, size_t ws_size, hipStream_t stream) {
    static int grid = 0;
    if (grid == 0) {
        int dev = 0, cus = 0, per_cu = 0;
        if (hipGetDevice(&dev) != hipSuccess || hipDeviceGetAttribute(&cus, hipDeviceAttributeMultiprocessorCount, dev) != hipSuccess) { fprintf(stderr, "kernel_launch: device query failed\n"); grid = -1; return; }
        if (hipFuncSetAttribute((const void*)trunk_fwd, hipFuncAttributeMaxDynamicSharedMemorySize, LDS_BYTES) != hipSuccess) { fprintf(stderr, "kernel_launch: hipFuncSetAttribute failed\n"); grid = -1; return; }
        if (hipOccupancyMaxActiveBlocksPerMultiprocessor(&per_cu, (const void*)trunk_fwd, NTHR, LDS_BYTES) != hipSuccess || per_cu < 1) { fprintf(stderr, "kernel_launch: occupancy query says %d\n", per_cu); per_cu = 1; }
        (void)hipGetLastError();
        grid = cus;
        if (ws_size < 256 * MiB) { fprintf(stderr, "kernel_launch: workspace too small (%zu)\n", ws_size); grid = -1; return; }
    }
    if (grid < 0) return;
    if (hipMemsetAsync((char*)d_ws + WS_BAR, 0, 24576, stream) != hipSuccess) { fprintf(stderr, "kernel_launch: memset of barrier words failed\n"); return; }
    Args a{};
    const float** ap = (const float**)&a;
    for (int i = 0; i < 22; ++i) ap[i] = (const float*)d_in[i];
    a.out = (float*)d_out; a.ws = (unsigned char*)d_ws;
#if MK_ONE_LAUNCH
    a.ph_lo = 0; a.ph_hi = NPHASE;
    void* args[] = {&a};
    hipError_t e = hipLaunchCooperativeKernel((const void*)trunk_fwd, dim3(grid), dim3(NTHR), args, LDS_BYTES, stream);
    if (e != hipSuccess) fprintf(stderr, "cooperative launch failed: %s (grid %d)\n", hipGetErrorString(e), grid);
#else
    for (int p = 0; p < NPHASE; ++p) { a.ph_lo = p; a.ph_hi = p + 1; hipLaunchKernelGGL(trunk_fwd, dim3(grid), dim3(NTHR), LDS_BYTES, stream, a); }
#endif
}
```

```cpp
#include <hip/hip_runtime.h>
#include <hip/hip_cooperative_groups.h>
#include <cstdio>
#include <cstdint>
namespace cg = cooperative_groups;
namespace pg8 {
#define PG8_LAS __attribute__((address_space(3)))
typedef unsigned short bf16_t;
typedef short bf16x8 __attribute__((ext_vector_type(8)));
typedef float f32x4 __attribute__((ext_vector_type(4)));
typedef unsigned u32x4 __attribute__((ext_vector_type(4)));
constexpr int BM = 256, BK = 64, HALF = 128, HTB = HALF * BK * 2  , STAGE_BYTES = 8 * HTB, NXCD = 8, WGM = 8;

__host__ __device__ __forceinline__ int lds_byte(int r, int c) { const int st = (r >> 4) * 2 + (c >> 5), rr = r & 15, cc = c & 31, ob = rr * 64 + cc * 2; return st * 1024 + (ob ^ (((ob >> 9) & 1) << 5)); }
__host__ __device__ __forceinline__ void stage_rc(int b, int& R, int& C) { const int st = b / 1024, sb = b % 1024, swz = sb ^ (((sb >> 9) & 1) << 5); R = (st >> 1) * 16 + swz / 64; C = (st & 1) * 32 + (swz % 64) / 2; }
__host__ __device__ __forceinline__ int perm32(int rho) { const int n = rho >> 4, i = rho & 15; return 8 * (i >> 2) + 4 * n + (i & 3); }

struct Unit { int pm, pn; };
struct Gemm { const bf16_t* A; const bf16_t* Bt; int M, N, K; };

struct StaticOrder {
    int nM, nN, nwg, G, c;
    __host__ __device__ void init(int M, int N, int G_, int c_) { nM = M / BM; nN = N / BM; nwg = nM * nN; G = G_; c = c_; }
    __host__ __device__ bool next(int i, Unit& u) const {
        const long L = (long)i * G + c; if (L >= nwg) return false;
        int wgid = (int)L; { const int q = nwg / NXCD, r = nwg % NXCD, xcd = wgid % NXCD, off = wgid / NXCD; wgid = (xcd < r ? xcd * (q + 1) : r * (q + 1) + (xcd - r) * q) + off; }
        const int nig = WGM * nN, gid = wgid / nig, fm = gid * WGM, gsz = (nM - fm) < WGM ? (nM - fm) : WGM;
        u.pm = fm + ((wgid % nig) % gsz); u.pn = (wgid % nig) / gsz; return true;
    }
    __device__ __forceinline__ void a_ready(const Unit&) const {}
    __device__ __forceinline__ void done(const Unit&) const {}
};

__device__ __forceinline__ unsigned cvt_pk_bf16(float lo, float hi) { unsigned r; asm volatile("v_cvt_pk_bf16_f32 %0, %1, %2" : "=v"(r) : "v"(lo), "v"(hi)); return r; }
typedef float f32x2 __attribute__((ext_vector_type(2)));
__device__ __forceinline__ float sigmoid_f(float x) { return __builtin_amdgcn_rcpf(1.0f + __expf(-x)); }
__device__ __forceinline__ float silu_f(float x) { return x * __builtin_amdgcn_rcpf(1.0f + __expf(-x)); }
__device__ __forceinline__ float bf2f(unsigned short b) { return __uint_as_float(((unsigned)b) << 16); }
struct EpiScaleBf16 {
    static constexpr bool PERM = true, AFTER_DRAIN = false;
    bf16_t* O; int ldc; const float* rstd; const float* part; int small_pn; float* smallbuf; float* nmax; int q_pn0;
    __device__ __forceinline__ void operator()(const f32x4 (&acc)[2][2][4][2], const Unit& u, int wr, int wc, int fr, int fq) const {
        const int row0 = u.pm * BM + wr * 64 + fr, col0 = u.pn * BM + wc * 32 + 8 * fq;
        const bool nrm = nmax != nullptr && u.pn >= q_pn0 && u.pn < q_pn0 + 8; float rmx[2] = {0.f, 0.f};
#pragma unroll
        for (int ai = 0; ai < 2; ++ai)
#pragma unroll
            for (int m = 0; m < 4; ++m) {
                const int row = row0 + ai * HALF + m * 16; float s;
                if (rstd) s = rstd[row];
                else { const f32x4 a = *(const f32x4*)(part + (size_t)row * 32 + 8 * fq), b = *(const f32x4*)(part + (size_t)row * 32 + 8 * fq + 4);
                    float t = ((a[0] + a[1]) + (a[2] + a[3])) + ((b[0] + b[1]) + (b[2] + b[3])); t += __shfl_xor(t, 16); t += __shfl_xor(t, 32); s = rsqrtf(t * (1.0f / 2048.0f) + 1e-6f); }
                bf16_t* rowp = O + (size_t)row * ldc + col0;
#pragma unroll
                for (int bj = 0; bj < 2; ++bj) { const f32x4 v0 = acc[ai][bj][m][0] * s, v1 = acc[ai][bj][m][1] * s;
                    u32x4 w; w.x = cvt_pk_bf16(v0[0], v0[1]); w.y = cvt_pk_bf16(v0[2], v0[3]); w.z = cvt_pk_bf16(v1[0], v1[1]); w.w = cvt_pk_bf16(v1[2], v1[3]);
                    *(u32x4*)(rowp + bj * HALF) = w;
                    if (nrm) { float ss = ((v0[0] * v0[0] + v0[1] * v0[1]) + (v0[2] * v0[2] + v0[3] * v0[3])) + ((v1[0] * v1[0] + v1[1] * v1[1]) + (v1[2] * v1[2] + v1[3] * v1[3])); ss += __shfl_xor(ss, 16); ss += __shfl_xor(ss, 32); rmx[bj] = fmaxf(rmx[bj], ss); }
                    if (u.pn == small_pn && bj == 0 && wc == 0) { *(f32x4*)(smallbuf + (size_t)row * 32 + 8 * fq) = v0; *(f32x4*)(smallbuf + (size_t)row * 32 + 8 * fq + 4) = v1; } }
            }
        if (nrm) { const int t = u.pn - q_pn0;
#pragma unroll
            for (int bj = 0; bj < 2; ++bj) { float r = rmx[bj]; r = fmaxf(r, __shfl_xor(r, 1)); r = fmaxf(r, __shfl_xor(r, 2)); r = fmaxf(r, __shfl_xor(r, 4)); r = fmaxf(r, __shfl_xor(r, 8));
                if (fr == 0 && fq == 0) __hip_atomic_fetch_max((unsigned*)nmax + ((((u.pm >> 4) * 8 + 2 * (t & 3) + bj) * 2 + (t >> 2)) * 4 + wc), __float_as_uint(r), __ATOMIC_RELAXED, __HIP_MEMORY_SCOPE_AGENT); } }
    }
};
struct EpiResid {
    static constexpr bool PERM = true, AFTER_DRAIN = false;
    const float* base; float* out; bf16_t* outb; float* part; int ldc;
    __device__ __forceinline__ void operator()(const f32x4 (&acc)[2][2][4][2], const Unit& u, int wr, int wc, int fr, int fq) const {
        const int row0 = u.pm * BM + wr * 64 + fr, col0 = u.pn * BM + wc * 32 + 8 * fq;
#pragma unroll
        for (int ai = 0; ai < 2; ++ai)
#pragma unroll
            for (int m = 0; m < 4; ++m) {
                const int row = row0 + ai * HALF + m * 16; const size_t off = (size_t)row * ldc + col0; float ss = 0.f;
#pragma unroll
                for (int bj = 0; bj < 2; ++bj) { const size_t o = off + bj * HALF;
                    const f32x4 v0 = acc[ai][bj][m][0] + __builtin_nontemporal_load((const f32x4*)(base + o)), v1 = acc[ai][bj][m][1] + __builtin_nontemporal_load((const f32x4*)(base + o + 4));
                    if (out) { *(f32x4*)(out + o) = v0; *(f32x4*)(out + o + 4) = v1; }
                    ss += ((v0[0] * v0[0] + v0[1] * v0[1]) + (v0[2] * v0[2] + v0[3] * v0[3])) + ((v1[0] * v1[0] + v1[1] * v1[1]) + (v1[2] * v1[2] + v1[3] * v1[3]));
                    if (outb) { u32x4 w; w.x = cvt_pk_bf16(v0[0], v0[1]); w.y = cvt_pk_bf16(v0[2], v0[3]); w.z = cvt_pk_bf16(v1[0], v1[1]); w.w = cvt_pk_bf16(v1[2], v1[3]); *(u32x4*)(outb + o) = w; } }
                ss += __shfl_xor(ss, 16); ss += __shfl_xor(ss, 32);
                if (fq == 0) part[(size_t)row * 32 + u.pn * 4 + wc] = ss;
            }
    }
};
struct EpiGlu {
    static constexpr bool PERM = true, AFTER_DRAIN = false;
    const bf16_t* zb; const bf16_t* ug; const float* bias; bf16_t* tb;
    __device__ __forceinline__ void operator()(const f32x4 (&acc)[2][2][4][2], const Unit& u, int wr, int wc, int fr, int fq) const {
        const int row0 = u.pm * BM + wr * 64 + fr, col0 = u.pn * BM + wc * 32 + 8 * fq;
#pragma unroll
        for (int ai = 0; ai < 2; ++ai)
#pragma unroll
            for (int m = 0; m < 4; ++m) {
                const int row = row0 + ai * HALF + m * 16;
#pragma unroll
                for (int bj = 0; bj < 2; ++bj) { const int col = col0 + bj * HALF;
                    const f32x4 b0 = *(const f32x4*)(bias + col), b1 = *(const f32x4*)(bias + col + 4);
                    const u32x4 zz = __builtin_nontemporal_load((const u32x4*)(zb + (size_t)row * 2048 + col)), gg = __builtin_nontemporal_load((const u32x4*)(ug + (size_t)row * 4096 + 2048 + col));
                    float r[8];
#pragma unroll
                    for (int e = 0; e < 8; ++e) { const float a = (e < 4 ? acc[ai][bj][m][0][e] : acc[ai][bj][m][1][e - 4]) + (e < 4 ? b0[e] : b1[e - 4]);
                        const unsigned zw = zz[e >> 1], gw = gg[e >> 1];
                        const float z = (e & 1) ? __uint_as_float(zw & 0xffff0000u) : __uint_as_float(zw << 16), g = (e & 1) ? __uint_as_float(gw & 0xffff0000u) : __uint_as_float(gw << 16);
                        r[e] = z * sigmoid_f(a) * silu_f(g); }
                    u32x4 w; w.x = cvt_pk_bf16(r[0], r[1]); w.y = cvt_pk_bf16(r[2], r[3]); w.z = cvt_pk_bf16(r[4], r[5]); w.w = cvt_pk_bf16(r[6], r[7]);
                    *(u32x4*)(tb + (size_t)row * 2048 + col) = w; }
            }
    }
};

struct EpiFinalNorm {
    static constexpr bool PERM = true, AFTER_DRAIN = true;
    const bf16_t* base; float* out; float* part; unsigned* cnt; const float* g; int ldc;
    __device__ __forceinline__ void fused(f32x4 (&acc)[2][2][4][2], const Unit& u, int wr, int wc, int fr, int fq, PG8_LAS unsigned char* lds, int wid, int lane) const {
        const int row0 = u.pm * BM + wr * 64 + fr, col0 = u.pn * BM + wc * 32 + 8 * fq;
#pragma unroll
        for (int ai = 0; ai < 2; ++ai)
#pragma unroll
            for (int m = 0; m < 4; ++m) { const int row = row0 + ai * HALF + m * 16; const size_t off = (size_t)row * ldc + col0; float ss = 0.f;
#pragma unroll
                for (int bj = 0; bj < 2; ++bj) { const u32x4 bw = __builtin_nontemporal_load((const u32x4*)(base + off + bj * HALF));
                    const f32x4 b0 = {__uint_as_float(bw.x << 16), __uint_as_float(bw.x & 0xffff0000u), __uint_as_float(bw.y << 16), __uint_as_float(bw.y & 0xffff0000u)};
                    const f32x4 b1 = {__uint_as_float(bw.z << 16), __uint_as_float(bw.z & 0xffff0000u), __uint_as_float(bw.w << 16), __uint_as_float(bw.w & 0xffff0000u)};
                    const f32x4 v0 = acc[ai][bj][m][0] + b0, v1 = acc[ai][bj][m][1] + b1; acc[ai][bj][m][0] = v0; acc[ai][bj][m][1] = v1;
                    ss += ((v0[0] * v0[0] + v0[1] * v0[1]) + (v0[2] * v0[2] + v0[3] * v0[3])) + ((v1[0] * v1[0] + v1[1] * v1[1]) + (v1[2] * v1[2] + v1[3] * v1[3])); }
                ss += __shfl_xor(ss, 16); ss += __shfl_xor(ss, 32);
                if (fq == 0) __hip_atomic_store((unsigned*)part + (size_t)row * 32 + u.pn * 4 + wc, __float_as_uint(ss), __ATOMIC_RELAXED, __HIP_MEMORY_SCOPE_AGENT); }
        asm volatile("s_waitcnt vmcnt(0)" ::: "memory");
        unsigned* c = cnt + 16 * u.pm;
        if (lane == 0) __hip_atomic_fetch_add(c, 1u, __ATOMIC_RELAXED, __HIP_MEMORY_SCOPE_AGENT);
        { unsigned sp = 0; while ((unsigned)__builtin_amdgcn_readfirstlane(__hip_atomic_load(c, __ATOMIC_RELAXED, __HIP_MEMORY_SCOPE_AGENT)) < 64u) { __builtin_amdgcn_s_sleep(2); if (++sp > (1u << 20)) break; } }
        asm volatile("" ::: "memory");
        f32x4 gv[2][2];
#pragma unroll
        for (int bj = 0; bj < 2; ++bj)
#pragma unroll
            for (int n = 0; n < 2; ++n) gv[bj][n] = *(const f32x4*)(g + col0 + bj * HALF + 4 * n);
#pragma unroll
        for (int ai = 0; ai < 2; ++ai)
#pragma unroll
            for (int m = 0; m < 4; ++m) { const int row = row0 + ai * HALF + m * 16; const size_t off = (size_t)row * ldc + col0;
                const unsigned long long* pp = (const unsigned long long*)part + (size_t)row * 16 + 4 * fq; float t = 0.f;
#pragma unroll
                for (int q = 0; q < 4; ++q) { const unsigned long long w2 = __hip_atomic_load(pp + q, __ATOMIC_RELAXED, __HIP_MEMORY_SCOPE_AGENT); t += __uint_as_float((unsigned)w2) + __uint_as_float((unsigned)(w2 >> 32)); }
                t += __shfl_xor(t, 16); t += __shfl_xor(t, 32);
                const float s = rsqrtf(t * (1.0f / 2048.0f) + 1e-6f);
#pragma unroll
                for (int bj = 0; bj < 2; ++bj)
#pragma unroll
                    for (int n = 0; n < 2; ++n) __builtin_nontemporal_store(acc[ai][bj][m][n] * s * gv[bj][n], (f32x4*)(out + off + bj * HALF + 4 * n)); }
    }
};
template <class Epi, class Sched, bool ALIGN_EPI = false, bool SP2 = false>
__device__ __forceinline__ void gemm_phase(PG8_LAS unsigned char* lds, const Gemm g, const Sched& S, const Epi& E) {
    const int tid = threadIdx.x, wid = __builtin_amdgcn_readfirstlane(tid >> 6), lane = tid & 63, wr = wid >> 2, wc = wid & 3, fr = lane & 15, fq = lane >> 4;
    const int K = g.K, nt = K / BK;
    unsigned voffA[2], voffB[2];
#pragma unroll
    for (int i = 0; i < 2; ++i) { int R, C; stage_rc(tid * 16 + i * 8192, R, C); const int Rb = Epi::PERM ? ((R & ~31) + perm32(R & 31)) : R;
        voffA[i] = (unsigned)(R * K + C) * 2u; voffB[i] = (unsigned)(Rb * K + C) * 2u; }
    const size_t kstep = (size_t)(BK * 2);
    const size_t hstep = (size_t)HALF * K * 2;
    const size_t tstep = 2 * hstep;
    const unsigned ldsw = (unsigned)wid * 1024u;
    const int aoff = lds_byte(wr * 64 + fr, fq * 8), boff = lds_byte(wc * 32 + fr, fq * 8);
#define PG8_SA(b, h) (((b) * 2 + (h)) * HTB)
#define PG8_SB(b, h) ((4 + (b) * 2 + (h)) * HTB)
#define PG8_STAGE(bufoff, gbase, voff) do { _Pragma("unroll") for (int _i = 0; _i < 2; ++_i) \
        __builtin_amdgcn_global_load_lds((const unsigned*)((const char*)(gbase) + (voff)[_i]), (PG8_LAS unsigned*)(lds + (bufoff) + ldsw + _i * 8192), 16, 0, 0); } while (0)
#define PG8_LDA(dst, b, h) do { _Pragma("unroll") for (int m = 0; m < 4; ++m) _Pragma("unroll") for (int k = 0; k < 2; ++k) dst[m][k] = *(const PG8_LAS bf16x8*)(lds + PG8_SA(b, h) + aoff + m * 2048 + k * 1024); } while (0)
#define PG8_LDB(dst, b, h) do { _Pragma("unroll") for (int n = 0; n < 2; ++n) _Pragma("unroll") for (int k = 0; k < 2; ++k) dst[n][k] = *(const PG8_LAS bf16x8*)(lds + PG8_SB(b, h) + boff + n * 2048 + k * 1024); } while (0)
#define PG8_MMA(ai, bj, At, Bt) do { __builtin_amdgcn_s_setprio(1); _Pragma("unroll") for (int m = 0; m < 4; ++m) _Pragma("unroll") for (int n = 0; n < 2; ++n) _Pragma("unroll") for (int k = 0; k < 2; ++k) \
        acc[ai][bj][m][n] = __builtin_amdgcn_mfma_f32_16x16x32_bf16(Bt[n][k], At[m][k], acc[ai][bj][m][n], 0, 0, 0); __builtin_amdgcn_s_setprio(0); } while (0)
#define PG8_WAIT_V(n) asm volatile("s_waitcnt vmcnt(" #n ")" ::: "memory")
#define PG8_WAIT_L(n) asm volatile("s_waitcnt lgkmcnt(" #n ")" ::: "memory")
#define PG8_BAR __builtin_amdgcn_s_barrier()
#define PG8_SCHED __builtin_amdgcn_sched_barrier(0)
    Unit cur, nxt; int ui = 0;
    if (!S.next(0, cur)) return;
    f32x4 acc[2][2][4][2];
#pragma unroll
    for (int a = 0; a < 2; ++a)
#pragma unroll
        for (int b = 0; b < 2; ++b)
#pragma unroll
            for (int m = 0; m < 4; ++m)
#pragma unroll
                for (int n = 0; n < 2; ++n) acc[a][b][m][n] = (f32x4){0.f, 0.f, 0.f, 0.f};
    bf16x8 At[4][2], B0[2][2], B1[2][2];
    const char* cA = (const char*)g.A + (size_t)cur.pm * tstep; const char* cB = (const char*)g.Bt + (size_t)cur.pn * tstep;
    S.a_ready(cur);
    if constexpr (SP2) {
        PG8_STAGE(PG8_SB(0, 0), cB, voffB); PG8_STAGE(PG8_SB(0, 1), cB + hstep, voffB); PG8_STAGE(PG8_SA(0, 0), cA, voffA); PG8_STAGE(PG8_SA(0, 1), cA + hstep, voffA);
        if (wr == 1) PG8_BAR;
        PG8_WAIT_V(2); PG8_BAR;
        PG8_STAGE(PG8_SB(1, 0), cB + kstep, voffB); PG8_STAGE(PG8_SA(1, 0), cA + kstep, voffA); PG8_STAGE(PG8_SB(1, 1), cB + hstep + kstep, voffB);
        PG8_WAIT_V(6); PG8_BAR;
    } else {
        PG8_STAGE(PG8_SB(0, 0), cB, voffB); PG8_STAGE(PG8_SA(0, 0), cA, voffA); PG8_STAGE(PG8_SB(0, 1), cB + hstep, voffB); PG8_STAGE(PG8_SA(0, 1), cA + hstep, voffA);
        if (wr == 1) PG8_BAR;
        PG8_WAIT_V(4); PG8_BAR;
        PG8_STAGE(PG8_SB(1, 0), cB + kstep, voffB); PG8_STAGE(PG8_SA(1, 0), cA + kstep, voffA); PG8_STAGE(PG8_SB(1, 1), cB + hstep + kstep, voffB);
        PG8_WAIT_V(6); PG8_BAR;
    }
    for (;;) {
        const bool has_next = S.next(ui + 1, nxt);
        const char* nA = has_next ? (const char*)g.A + (size_t)nxt.pm * tstep : cA; const char* nB = has_next ? (const char*)g.Bt + (size_t)nxt.pn * tstep : cB;
        for (int t = 0; t < nt; t += 2) {
            const bool last = (t == nt - 2);
            const char* a1 = cA + (size_t)(t + 1) * kstep;
            const char* a2 = last ? nA : cA + (size_t)(t + 2) * kstep; const char* b2 = last ? nB : cB + (size_t)(t + 2) * kstep;
            const char* a3 = a2 + kstep; const char* b3 = b2 + kstep;
            if (last && has_next) S.a_ready(nxt);
            if constexpr (SP2) {
            PG8_LDB(B0, 0, 0); PG8_LDB(B1, 0, 1); PG8_SCHED; PG8_LDA(At, 0, 0); PG8_STAGE(PG8_SA(1, 1), a1 + hstep, voffA);
            PG8_WAIT_V(8); PG8_WAIT_L(0); PG8_BAR; PG8_MMA(0, 0, At, B0); PG8_MMA(0, 1, At, B1); PG8_BAR; PG8_SCHED;
            PG8_LDA(At, 0, 1); PG8_STAGE(PG8_SB(0, 0), b2, voffB); PG8_STAGE(PG8_SB(0, 1), b2 + hstep, voffB); PG8_STAGE(PG8_SA(0, 0), a2, voffA);
            PG8_WAIT_V(8); PG8_WAIT_L(0); PG8_BAR; PG8_MMA(1, 0, At, B0); PG8_MMA(1, 1, At, B1); PG8_BAR; PG8_SCHED;
            PG8_LDB(B0, 1, 0); PG8_LDB(B1, 1, 1); PG8_SCHED; PG8_LDA(At, 1, 0); PG8_STAGE(PG8_SA(0, 1), a2 + hstep, voffA);
            PG8_WAIT_V(8); PG8_WAIT_L(0); PG8_BAR; PG8_MMA(0, 0, At, B0); PG8_MMA(0, 1, At, B1); PG8_BAR; PG8_SCHED;
            PG8_LDA(At, 1, 1); PG8_STAGE(PG8_SB(1, 0), b3, voffB); PG8_STAGE(PG8_SB(1, 1), b3 + hstep, voffB); PG8_STAGE(PG8_SA(1, 0), a3, voffA);
            PG8_WAIT_V(8); PG8_WAIT_L(0); PG8_BAR; PG8_MMA(1, 0, At, B0); PG8_MMA(1, 1, At, B1); PG8_BAR; PG8_SCHED;
            } else {
            PG8_LDB(B0, 0, 0); PG8_SCHED; PG8_LDA(At, 0, 0); PG8_STAGE(PG8_SA(1, 1), a1 + hstep, voffA);
            PG8_WAIT_L(8); PG8_BAR; PG8_WAIT_L(0); PG8_MMA(0, 0, At, B0); PG8_BAR; PG8_SCHED;
            PG8_LDB(B1, 0, 1); PG8_STAGE(PG8_SB(0, 0), b2, voffB);
            PG8_BAR; PG8_WAIT_L(0); PG8_MMA(0, 1, At, B1); PG8_BAR;
            PG8_LDA(At, 0, 1); PG8_STAGE(PG8_SA(0, 0), a2, voffA);
            PG8_BAR; PG8_WAIT_L(0); PG8_MMA(1, 0, At, B0); PG8_BAR; PG8_SCHED;
            PG8_STAGE(PG8_SB(0, 1), b2 + hstep, voffB);
            PG8_WAIT_V(6); PG8_BAR; PG8_MMA(1, 1, At, B1); PG8_BAR;
            PG8_LDB(B0, 1, 0); PG8_SCHED; PG8_LDA(At, 1, 0); PG8_STAGE(PG8_SA(0, 1), a2 + hstep, voffA);
            PG8_WAIT_L(8); PG8_BAR; PG8_WAIT_L(0); PG8_MMA(0, 0, At, B0); PG8_BAR; PG8_SCHED;
            PG8_LDB(B1, 1, 1); PG8_STAGE(PG8_SB(1, 0), b3, voffB);
            PG8_BAR; PG8_WAIT_L(0); PG8_MMA(0, 1, At, B1); PG8_BAR;
            PG8_LDA(At, 1, 1); PG8_STAGE(PG8_SA(1, 0), a3, voffA);
            PG8_BAR; PG8_WAIT_L(0); PG8_MMA(1, 0, At, B0); PG8_BAR; PG8_SCHED;
            PG8_STAGE(PG8_SB(1, 1), b3 + hstep, voffB);
            PG8_WAIT_V(6); PG8_BAR; PG8_MMA(1, 1, At, B1); PG8_BAR;
            }
        }
        if constexpr (ALIGN_EPI) { if (wr == 0) PG8_BAR; }
        if constexpr (!Epi::AFTER_DRAIN) { E(acc, cur, wr, wc, fr, fq); S.done(cur); }
        if (!has_next) break;
#pragma unroll
        for (int a = 0; a < 2; ++a)
#pragma unroll
            for (int b = 0; b < 2; ++b)
#pragma unroll
                for (int m = 0; m < 4; ++m)
#pragma unroll
                    for (int n = 0; n < 2; ++n) acc[a][b][m][n] = (f32x4){0.f, 0.f, 0.f, 0.f};
        cur = nxt; cA = nA; cB = nB; ++ui;
        if constexpr (ALIGN_EPI) { if (wr == 1) PG8_BAR; }
    }
    PG8_WAIT_V(0);
    if constexpr (!ALIGN_EPI) { if (wr == 0) PG8_BAR; }
    PG8_BAR;
    if constexpr (Epi::AFTER_DRAIN) { E.fused(acc, cur, wr, wc, fr, fq, lds, wid, lane); S.done(cur); }
#undef PG8_SA
#undef PG8_SB
#undef PG8_STAGE
#undef PG8_LDA
#undef PG8_LDB
#undef PG8_MMA
#undef PG8_WAIT_V
#undef PG8_WAIT_L
#undef PG8_BAR
#undef PG8_SCHED
}
}
#define LAS __attribute__((address_space(3)))
typedef unsigned short bf16;
typedef float f32x4 __attribute__((ext_vector_type(4)));
typedef unsigned v4u __attribute__((ext_vector_type(4)));
typedef unsigned v2u __attribute__((ext_vector_type(2)));
constexpr int NWAVES = 8, NTHR = 512;
constexpr int BATCH = 2, SEQ = 4096, DM = 2048, MROWS = BATCH * SEQ;
constexpr int NP = 7424;
constexpr int C_GQ = 0, C_GK = 512, C_GV = 1024, C_GG = 2048, C_FQ = 3072, C_FK = 4096, C_FV = 5120, C_FG = 6144, C_SMALL = 7168;
constexpr int AB_IN = 7192;
constexpr float EPS = 1e-6f;
constexpr size_t MiB = 1u << 20;
constexpr size_t WS_RSTD0 = 0, WS_PART1 = 64 * 1024, WS_PART2 = WS_PART1 + MiB, WS_CFOX = 2 * MiB + 512 * 1024, WS_SMALL = 3 * MiB  ;
constexpr size_t WS_WGLU = 4 * MiB, WS_WCOUT = 12 * MiB, WS_WCIN = 20 * MiB, WS_WOUT = 36 * MiB, WS_WIN = 44 * MiB;
constexpr size_t WS_XB = 73 * MiB, WS_MIX = 73 * MiB, WS_ZB = 73 * MiB;
constexpr size_t WS_P = 105 * MiB, WS_X1 = 105 * MiB, WS_UG = 169 * MiB;
constexpr size_t WS_ORAW = 221 * MiB;
constexpr size_t WS_TB = 20 * MiB;
constexpr int LDS_BYTES = 163840;

struct Args {
    const float* x; const float* ab_norm_g; const float* ab_w_in; const float* alpha_up; const float* alpha_b; const float* head_g; const float* fox_f_b; const float* ab_w_out;
    const float* c_norm_g; const float* c_w_in; const float* lam_re; const float* lam_im; const float* log_step; const float* b_re; const float* b_im; const float* c_re; const float* c_im;
    const float* s5_d; const float* glu_w; const float* glu_b; const float* c_w_out; const float* final_g;
    float* out; unsigned char* ws; int ph_lo, ph_hi;
};

typedef float cv_f32x2 __attribute__((ext_vector_type(2))); typedef __bf16 cv_bf16x2 __attribute__((ext_vector_type(2)));
__device__ __forceinline__ unsigned pk2(float lo, float hi) { cv_f32x2 v = {lo, hi}; cv_bf16x2 b = __builtin_convertvector(v, cv_bf16x2); return __builtin_bit_cast(unsigned, b); }
__device__ __forceinline__ unsigned f2bf(float f) { return pk2(f, f) & 0xffffu; }
__device__ __forceinline__ float bflo(unsigned w) { return __uint_as_float(w << 16); }
__device__ __forceinline__ float bfhi(unsigned w) { return __uint_as_float(w & 0xffff0000u); }
__device__ __forceinline__ float bf2f(bf16 b) { return __uint_as_float(((unsigned)b) << 16); }
__device__ __forceinline__ float wave_sum(float v) {
#pragma unroll
    for (int o = 1; o < 64; o <<= 1) v += __shfl_xor(v, o);
    return v;
}
__device__ __forceinline__ float silu_f(float x) { return x * __builtin_amdgcn_rcpf(1.0f + __expf(-x)); }
__device__ __forceinline__ float logsigmoid_f(float z) { return fminf(z, 0.f) - __logf(1.0f + __expf(-fabsf(z))); }
__device__ __forceinline__ float gelu_tanh(float y) { const float y2 = y * y; const float a2 = y * (-2.3022082f - 0.10294324f * y2); return y * __builtin_amdgcn_rcpf(1.0f + __builtin_amdgcn_exp2f(a2)); }

struct TrItem { const float* W; bf16* WT; const float* gk; int Nsrc, srcc, dstr, kb; };
__device__ __forceinline__ void tr_load(const TrItem& t, f32x4 (&v)[16], int lane) {
    const int k0 = 64 * t.kb, c4 = (lane & 15) * 4, kr = lane >> 4;
#pragma unroll
    for (int i = 0; i < 16; ++i) v[i] = __builtin_nontemporal_load((const f32x4*)(t.W + (size_t)(k0 + 4 * i + kr) * t.Nsrc + t.srcc + c4));
}
template <bool NT>
__device__ __forceinline__ void tr_store(const TrItem& t, const f32x4 (&v)[16], LAS float* scr, int lane) {
    const int K = DM, k0 = 64 * t.kb, c4 = (lane & 15) * 4, kr = lane >> 4;
#pragma unroll
    for (int i = 0; i < 16; ++i) { const int kk = 4 * i + kr; const float s = t.gk ? t.gk[k0 + kk] : 1.0f; LAS float* d = scr + kk * 65 + c4; d[0] = v[i][0] * s; d[1] = v[i][1] * s; d[2] = v[i][2] * s; d[3] = v[i][3] * s; }
    asm volatile("s_waitcnt lgkmcnt(0)" ::: "memory");
    const int c = lane & 7;
#pragma unroll
    for (int j = 0; j < 8; ++j) { const int n = (lane >> 3) + 8 * j; const LAS float* s = scr + (8 * c) * 65 + n;
        v4u o; o.x = pk2(s[0 * 65], s[1 * 65]); o.y = pk2(s[2 * 65], s[3 * 65]); o.z = pk2(s[4 * 65], s[5 * 65]); o.w = pk2(s[6 * 65], s[7 * 65]);
        if constexpr (NT) __builtin_nontemporal_store(o, (v4u*)(t.WT + (size_t)(t.dstr + n) * K + k0 + 8 * c)); else *(v4u*)(t.WT + (size_t)(t.dstr + n) * K + k0 + 8 * c) = o; }
    asm volatile("s_waitcnt lgkmcnt(0)" ::: "memory");
}
__device__ __forceinline__ TrItem tr_decode_late(const Args& a, int r) {
    constexpr int I_OUT = 32 * 32, I_CIN = 32 * 64, I_GLU = 32 * 32;
    TrItem t;
    if (r < I_OUT) { t.W = a.ab_w_out; t.WT = (bf16*)(a.ws + WS_WOUT); t.gk = nullptr; t.Nsrc = DM; t.srcc = t.dstr = 64 * (r % 32); t.kb = r / 32; return t; } r -= I_OUT;
    if (r < I_CIN) { t.W = a.c_w_in; t.WT = (bf16*)(a.ws + WS_WCIN); t.gk = a.c_norm_g; t.Nsrc = 4096; t.srcc = t.dstr = 64 * (r % 64); t.kb = r / 64; return t; } r -= I_CIN;
    if (r < I_GLU) { t.W = a.glu_w; t.WT = (bf16*)(a.ws + WS_WGLU); t.gk = nullptr; t.Nsrc = DM; t.srcc = t.dstr = 64 * (r % 32); t.kb = r / 32; return t; } r -= I_GLU;
    t.W = a.c_w_out; t.WT = (bf16*)(a.ws + WS_WCOUT); t.gk = nullptr; t.Nsrc = DM; t.srcc = t.dstr = 64 * (r % 32); t.kb = r / 32; return t;
}
__device__ __forceinline__ TrItem tr_decode_in(const Args& a, int r) {
    TrItem t; const int nb = r % 112, d0 = 64 * nb;
    t.W = a.ab_w_in; t.WT = (bf16*)(a.ws + WS_WIN); t.gk = a.ab_norm_g; t.Nsrc = AB_IN; t.srcc = d0 + (d0 < 2048 ? 0 : (d0 < 6144 ? 16 : 24)); t.dstr = d0; t.kb = r / 112; return t;
}
__device__ __forceinline__ void prologue_late(const Args& a, LAS unsigned char* lds, int tid, int widx, int nidle) {
    const int lane = tid & 63, wave = tid >> 6; LAS float* scr = (LAS float*)(lds + wave * 16640);
    constexpr int NIT = 32 * 32 * 3 + 32 * 64; const int st = nidle * NWAVES;
    int it = widx * NWAVES + wave; if (it >= NIT) return;
    TrItem cur = tr_decode_late(a, it); f32x4 v[16]; tr_load(cur, v, lane);
    for (;;) { const int nx = it + st; const bool more = nx < NIT; TrItem nt = cur; f32x4 vn[16];
        if (more) { nt = tr_decode_late(a, nx); tr_load(nt, vn, lane); }
        tr_store<false>(cur, v, scr, lane);
        if (!more) break;
#pragma unroll
        for (int i = 0; i < 16; ++i) v[i] = vn[i];
        cur = nt; it = nx; }
}
__device__ __forceinline__ void phase_prologue(const Args& a, LAS unsigned char* lds, int tid, int G) {
    const int lane = tid & 63, wave = tid >> 6;
    LAS float* scr = (LAS float*)(lds + wave * 16640);
    const int gw = blockIdx.x * NWAVES + wave, NGW = G * NWAVES;
    bf16* WinT = (bf16*)(a.ws + WS_WIN);
    constexpr int NITEMS = 32 * (7168 / 64);
    if (gw < NITEMS) { int it = gw; TrItem cur = tr_decode_in(a, it); f32x4 v[16]; tr_load(cur, v, lane);
        for (;;) { const int nx = it + NGW; const bool more = nx < NITEMS; TrItem nt = cur; f32x4 vn[16];
            if (more) { nt = tr_decode_in(a, nx); tr_load(nt, vn, lane); }
            tr_store<false>(cur, v, scr, lane);
            if (!more) break;
#pragma unroll
            for (int i = 0; i < 16; ++i) v[i] = vn[i];
            cur = nt; it = nx; } }
    for (int idx = blockIdx.x * NTHR + tid; idx < 256 * DM; idx += G * NTHR) {
        const int rr = idx / DM, k = idx % DM; float w = 0.f;
        if (rr < 16) w = a.ab_w_in[(size_t)k * AB_IN + 2048 + rr] * a.ab_norm_g[k];
        else if (rr < 24) w = a.ab_w_in[(size_t)k * AB_IN + 6160 + (rr - 16)] * a.ab_norm_g[k];
        WinT[(size_t)(C_SMALL + rr) * DM + k] = (bf16)f2bf(w);
    }
    bf16* xb = (bf16*)(a.ws + WS_XB); float* rstd0 = (float*)(a.ws + WS_RSTD0);
    for (int m0 = gw; m0 < MROWS; m0 += 2 * NGW) {
        const int m1 = m0 + NGW; const bool has1 = m1 < MROWS; const int m1c = has1 ? m1 : m0;
        const f32x4* xr0 = (const f32x4*)(a.x + (size_t)m0 * DM) + lane; const f32x4* xr1 = (const f32x4*)(a.x + (size_t)m1c * DM) + lane;
        f32x4 v0[8], v1[8];
#pragma unroll
        for (int j = 0; j < 8; ++j) v0[j] = __builtin_nontemporal_load(xr0 + 64 * j);
#pragma unroll
        for (int j = 0; j < 8; ++j) v1[j] = __builtin_nontemporal_load(xr1 + 64 * j);
        float s0 = 0.f, s1 = 0.f;
#pragma unroll
        for (int j = 0; j < 8; ++j) { s0 += (v0[j][0] * v0[j][0] + v0[j][1] * v0[j][1]) + (v0[j][2] * v0[j][2] + v0[j][3] * v0[j][3]); s1 += (v1[j][0] * v1[j][0] + v1[j][1] * v1[j][1]) + (v1[j][2] * v1[j][2] + v1[j][3] * v1[j][3]); }
        s0 = wave_sum(s0); s1 = wave_sum(s1);
        if (lane == 0) { rstd0[m0] = rsqrtf(s0 * (1.0f / DM) + EPS); if (has1) rstd0[m1] = rsqrtf(s1 * (1.0f / DM) + EPS); }
        v2u* o0 = (v2u*)(xb + (size_t)m0 * DM) + lane; v2u* o1 = (v2u*)(xb + (size_t)m1c * DM) + lane;
#pragma unroll
        for (int j = 0; j < 8; ++j) { v2u w; w.x = pk2(v0[j][0], v0[j][1]); w.y = pk2(v0[j][2], v0[j][3]); o0[64 * j] = w; }
        if (has1) {
#pragma unroll
            for (int j = 0; j < 8; ++j) { v2u w; w.x = pk2(v1[j][0], v1[j][1]); w.y = pk2(v1[j][2], v1[j][3]); o1[64 * j] = w; } }
    }
}

__device__ __forceinline__ void phase_fox_cumsum(const Args& a, LAS unsigned char* lds, int tid, int G) {
    if (blockIdx.x >= 16) return;
    const int bh = blockIdx.x, b = bh >> 3, h = bh & 7, lane = tid & 63, wave = tid >> 6; const float fb = a.fox_f_b[h];
    const float* small = (const float*)(a.ws + WS_SMALL); float* cf = (float*)(a.ws + WS_CFOX) + (size_t)bh * SEQ; LAS float* WT = (LAS float*)lds;
    float v[8]; float run = 0.f;
#pragma unroll
    for (int i = 0; i < 8; ++i) { run += logsigmoid_f(small[(size_t)(b * SEQ + tid * 8 + i) * 32 + 16 + h] + fb); v[i] = run; }
    float inc = run;
#pragma unroll
    for (int o = 1; o < 64; o <<= 1) { const float n = __shfl_up(inc, o); if (lane >= o) inc += n; }
    if (lane == 63) WT[wave] = inc;
    __syncthreads();
    float base = inc - run;
    for (int w = 0; w < wave; ++w) base += WT[w];
#pragma unroll
    for (int i = 0; i < 8; ++i) cf[tid * 8 + i] = base + v[i];
}

#define XB_TMO      128
#define XB_XCNT(j)  (256  + 64 * (j))
#define XB_XSUB(j)  (1280 + 64 * (j))
#define XB_XGEN(j)  (2304 + 64 * (j))
#define XB_TOP      3328
#define XB_TOPGEN   3392
#define XCD_BAR_WORDS 3456
#define XB_SPIN_CAP (1u << 18)

__device__ __forceinline__ unsigned xb_ld(unsigned* p)              { return __hip_atomic_load(p, __ATOMIC_RELAXED, __HIP_MEMORY_SCOPE_AGENT); }
__device__ __forceinline__ unsigned xb_add(unsigned* p, unsigned v) { return __hip_atomic_fetch_add(p, v, __ATOMIC_RELAXED, __HIP_MEMORY_SCOPE_AGENT); }
__device__ __forceinline__ unsigned xb_xcc_id() { return (unsigned)__builtin_amdgcn_s_getreg((3 << 11) | 20) & 0xFu; }
#define XB_SPIN(cond, bar) do { unsigned _sp = 0; while (cond) { __builtin_amdgcn_s_sleep(1); \
    if ((++_sp & 255u) == 0u) { if (xb_ld(&(bar)[XB_TMO])) break; if (_sp > XB_SPIN_CAP) { atomicAdd(&(bar)[XB_TMO], 1u); break; } } } } while (0)

struct XcdBarrier {
    unsigned* bar; unsigned x;
    volatile LAS unsigned* st;
};

__device__ __forceinline__ XcdBarrier xcd_barrier_post(unsigned* bar, volatile LAS unsigned* st) {
    XcdBarrier b; b.bar = bar; b.x = xb_xcc_id(); b.st = st;
    if (threadIdx.x == 0) (void)xb_add(&bar[XB_XCNT(b.x)], 1u);
    return b;
}
__device__ __forceinline__ void xcd_barrier_complete(unsigned* bar, unsigned x, unsigned& nloc, unsigned& nx) {
    const unsigned G = gridDim.x * gridDim.y * gridDim.z;
    unsigned sum, cnt, mine, sp = 0u;
    for (;;) {
        sum = 0u; cnt = 0u; mine = 0u;
#pragma unroll
        for (unsigned j = 0; j < 16; ++j) { const unsigned c = xb_ld(&bar[XB_XCNT(j)]); sum += c; cnt += (c > 0u) ? 1u : 0u; mine = (j == x) ? c : mine; }
        if (sum == G) break;
        __builtin_amdgcn_s_sleep(1);
        if ((++sp & 255u) == 0u) { if (xb_ld(&bar[XB_TMO])) break; if (sp > XB_SPIN_CAP) { atomicAdd(&bar[XB_TMO], 1u); break; } }
    }
    nloc = mine > 0u ? mine : 1u; nx = cnt > 0u ? cnt : 1u;
}

__device__ __forceinline__ void xcd_barrier(const XcdBarrier& b) {
    asm volatile("s_waitcnt vmcnt(0)" ::: "memory");
    __syncthreads();
    if (threadIdx.x == 0) {
        unsigned* bar = b.bar;
        __builtin_amdgcn_s_waitcnt(0);
        unsigned nloc = b.st[0], nx = b.st[1];
        if (nloc == 0u) { xcd_barrier_complete(bar, b.x, nloc, nx); b.st[0] = nloc; b.st[1] = nx; }
        const unsigned old = xb_add(&bar[XB_XSUB(b.x)], 1u);
        const unsigned gen = old / nloc;
        if (old + 1u == (gen + 1u) * nloc) {
            __builtin_amdgcn_fence(__ATOMIC_RELEASE, "agent");
            asm volatile("s_waitcnt vmcnt(0)" ::: "memory");
            const unsigned og = xb_add(&bar[XB_TOP], 1u);
            const unsigned tg = og / nx;
            if (og + 1u == (tg + 1u) * nx) xb_add(&bar[XB_TOPGEN], 1u);
            else XB_SPIN(xb_ld(&bar[XB_TOPGEN]) == tg, bar);
            __builtin_amdgcn_fence(__ATOMIC_ACQUIRE, "agent");
            xb_add(&bar[XB_XGEN(b.x)], 1u);
            asm volatile("s_waitcnt vmcnt(0)" ::: "memory");
        } else {
            XB_SPIN(xb_ld(&bar[XB_XGEN(b.x)]) == gen, bar);
            __builtin_amdgcn_fence(__ATOMIC_ACQUIRE, "agent");
            asm volatile("s_waitcnt vmcnt(0)" ::: "memory");
        }
    }
    __syncthreads();
}


constexpr size_t WS_BAR = 40 * 1024;
namespace fox {
constexpr int D = 128, KVS = 7424, OS = 2048, WINDOW = 4096; constexpr float THR = 8.f; constexpr bool WSKIP = false;
constexpr float SCALE = 0.08838834764831845f;
constexpr int NW = 8, QBLK = 32, KVBLK = 64, QB = NW * QBLK;
constexpr int SHM_V = KVBLK * D * 2, SHM_K = KVBLK * D * 2;
constexpr int LDS_BYTES = 2 * SHM_V + 2 * SHM_K + NW * 64 * 4;


using bf16 = unsigned short;
typedef short bf16x8 __attribute__((ext_vector_type(8)));
typedef short s16x4 __attribute__((ext_vector_type(4)));
typedef float f32x16 __attribute__((ext_vector_type(16)));
typedef float f32x4 __attribute__((ext_vector_type(4)));
typedef unsigned u32x4 __attribute__((ext_vector_type(4)));
template <class A, class Bt> struct same_t { static constexpr bool v = false; };
template <class A> struct same_t<A, A> { static constexpr bool v = true; };

#define KSWZ(row, colB) ((row) * 256 + ((colB) ^ (((row) & 7) << 4)))
#define SBAR() __builtin_amdgcn_sched_barrier(0)
__device__ __forceinline__ int v_st(int k, int c) { const int kk = (k & ~0xC) | ((k & 4) << 1) | ((k & 8) >> 1); return ((kk >> 3) * 4 + (c >> 5)) * 512 + ((kk & 7) * 32 + (c & 31)) * 2; }
__device__ __forceinline__ int v_rd_base(int lane) { return ((lane & 3) << 3) | (((lane >> 2) & 3) << 6) | (((lane >> 4) & 1) << 5) | (((lane >> 5) & 1) << 8); }
constexpr int v_rd_off(int d0, int ks, int half) { return d0 * 512 + ks * 4096 + half * 2048; }
__device__ __forceinline__ int crow(int r, int hi) { return (r & 3) + 8 * (r >> 2) + 4 * hi; }
__device__ __forceinline__ unsigned cvtpk(float lo, float hi) {
    unsigned r; asm volatile("v_cvt_pk_bf16_f32 %0, %1, %2" : "=v"(r) : "v"(lo), "v"(hi)); return r;
}
__device__ __forceinline__ bf16x8 pack8(f32x4 a, f32x4 b) {
    u32x4 w = {cvtpk(a[0], a[1]), cvtpk(a[2], a[3]), cvtpk(b[0], b[1]), cvtpk(b[2], b[3])};
    return *reinterpret_cast<bf16x8*>(&w);
}
template <class T> __device__ __forceinline__ bf16x8 load8(const T* p) {
    if constexpr (same_t<T, float>::v) { return pack8(*(const f32x4*)p, *(const f32x4*)(p + 4)); }
    else { return *reinterpret_cast<const bf16x8*>(p); }
}
typedef __attribute__((address_space(3))) float lds_f32; typedef __attribute__((address_space(3))) f32x4 lds_f32x4;
__device__ __forceinline__ void bias_tile(f32x16& p0, f32x16& p1, const lds_f32* cbk, int hi) {
    const lds_f32* cb0 = cbk + 4 * hi;
#pragma unroll
    for (int g_ = 0; g_ < 4; ++g_) { const f32x4 b0_ = *(const lds_f32x4*)(cb0 + 8 * g_), b1_ = *(const lds_f32x4*)(cb0 + 32 + 8 * g_);
        p0[4 * g_] += b0_[0]; p0[4 * g_ + 1] += b0_[1]; p0[4 * g_ + 2] += b0_[2]; p0[4 * g_ + 3] += b0_[3]; p1[4 * g_] += b1_[0]; p1[4 * g_ + 1] += b1_[1]; p1[4 * g_ + 2] += b1_[2]; p1[4 * g_ + 3] += b1_[3]; }
}
__device__ __forceinline__ void mask_tile(f32x16& p0, f32x16& p1, int dq, unsigned W) {
    const float NEG = -__builtin_inff();
#pragma unroll
    for (int r = 0; r < 16; ++r) {
        const int c = (r & 3) + 8 * (r >> 2);
        if ((unsigned)(dq - c) >= W) p0[r] = NEG;
        if ((unsigned)(dq - c - 32) >= W) p1[r] = NEG;
    }
}
__device__ __forceinline__ void partialSM(f32x16& p0, f32x16& p1, float& m_reg, float& mn, float& alpha) {
    float pmax = p0[0]; for (int r = 1; r < 16; ++r) pmax = fmaxf(pmax, p0[r]); for (int r = 0; r < 16; ++r) pmax = fmaxf(pmax, p1[r]);
    { auto rr = __builtin_amdgcn_permlane32_swap(__float_as_uint(pmax), __float_as_uint(pmax), false, false);
      pmax = fmaxf(__uint_as_float(rr[0]), __uint_as_float(rr[1])); }
    constexpr float C2 = 1.4426950408889634f * SCALE;
    if (__builtin_expect(__all((pmax - m_reg) * SCALE <= THR), 1)) { mn = m_reg; alpha = 1.f; }
    else { mn = fmaxf(m_reg, pmax); alpha = __builtin_amdgcn_exp2f((m_reg - mn) * C2); m_reg = mn; }
    const float mnL = -mn * C2;
    for (int r = 0; r < 16; ++r) p0[r] = fmaf(p0[r], C2, mnL); for (int r = 0; r < 16; ++r) p1[r] = fmaf(p1[r], C2, mnL);
    for (int r = 0; r < 16; ++r) p0[r] = __builtin_amdgcn_exp2f(p0[r]);
}
__device__ __forceinline__ void finishSM(f32x16& p0, f32x16& p1, float alpha, float& l_reg, bf16x8& pa0, bf16x8& pa1, bf16x8& pa2, bf16x8& pa3) {
    for (int r = 0; r < 16; ++r) p1[r] = __builtin_amdgcn_exp2f(p1[r]);
    float ps = 0; for (int r = 0; r < 16; ++r) ps += p0[r]; for (int r = 0; r < 16; ++r) ps += p1[r];
    { auto rr = __builtin_amdgcn_permlane32_swap(__float_as_uint(ps), __float_as_uint(ps), false, false);
      ps = __uint_as_float(rr[0]) + __uint_as_float(rr[1]); }
    l_reg = l_reg * alpha + ps;
#define PK4(P, B_, OUT) do { unsigned a0 = cvtpk(P[B_+0], P[B_+1]), a1 = cvtpk(P[B_+2], P[B_+3]);                          \
        unsigned b0 = cvtpk(P[B_+4], P[B_+5]), b1 = cvtpk(P[B_+6], P[B_+7]);                                             \
        auto r0 = __builtin_amdgcn_permlane32_swap(a0, b0, false, false); auto r1 = __builtin_amdgcn_permlane32_swap(a1, b1, false, false); \
        u32x4 w = {r0[0], r1[0], r0[1], r1[1]}; OUT = *reinterpret_cast<bf16x8*>(&w); } while (0)
    PK4(p0, 0, pa0); PK4(p0, 8, pa1); PK4(p1, 0, pa2); PK4(p1, 8, pa3);
#undef PK4
}
typedef __attribute__((address_space(3))) bf16x8 lds_bf16x8;
constexpr int QLDS_OFF = LDS_BYTES + 16384, QLDS_ROW = 272;
template <int KB, bool SK>
__device__ __forceinline__ void qkt(f32x16& p0, f32x16& p1, const char* K_lds, int r32, int hi, const lds_bf16x8* qp, bool act) {
    if (SK && !act) { const float NEG = -__builtin_inff();
#pragma unroll
        for (int r = 0; r < 16; ++r) { p0[r] = NEG; p1[r] = NEG; } return; }
    p0 = f32x16{}; p1 = f32x16{};
    const char* kb[4];
#pragma unroll
    for (int dd = 0; dd < 4; ++dd) kb[dd] = K_lds + KB * SHM_K + KSWZ(r32, (dd * 16 + hi * 8) * 2);
#pragma unroll
    for (int d0 = 0; d0 < 8; ++d0) { const char* a = kb[d0 & 3] + (d0 >> 2) * 128;
        bf16x8 b0 = *reinterpret_cast<const bf16x8*>(a);
        bf16x8 b1 = *reinterpret_cast<const bf16x8*>(a + 32 * 256); const bf16x8 qf = qp[2 * d0];
        p0 = __builtin_amdgcn_mfma_f32_32x32x16_bf16(b0, qf, p0, 0, 0, 0);
        p1 = __builtin_amdgcn_mfma_f32_32x32x16_bf16(b1, qf, p1, 0, 0, 0); }
}
template <int VB, bool SK>
__device__ __forceinline__ void pv_tile(f32x16* o, int vb0, bf16x8 pa0, bf16x8 pa1, bf16x8 pa2, bf16x8 pa3, bool act) {
    if (SK && !act) return;
#define TRRD(dst, off) asm volatile("ds_read_b64_tr_b16 %0, %1 offset:%2" : "=&v"(dst) : "v"(vb0), "i"(off) : "memory")
#define PV_D0(d0) do { s16x4 l0, l1, l2, l3, h0, h1, h2, h3; constexpr int b_ = VB * SHM_V + v_rd_off(d0, 0, 0);     \
        TRRD(l0, b_); TRRD(h0, b_ + 2048); TRRD(l1, b_ + 4096); TRRD(h1, b_ + 6144); TRRD(l2, b_ + 8192); TRRD(h2, b_ + 10240); TRRD(l3, b_ + 12288); TRRD(h3, b_ + 14336); \
        asm volatile("s_waitcnt lgkmcnt(0)" ::: "memory"); SBAR();                 \
        o[d0] = __builtin_amdgcn_mfma_f32_32x32x16_bf16(pa0, (bf16x8){l0[0], l0[1], l0[2], l0[3], h0[0], h0[1], h0[2], h0[3]}, o[d0], 0, 0, 0);   \
        o[d0] = __builtin_amdgcn_mfma_f32_32x32x16_bf16(pa1, (bf16x8){l1[0], l1[1], l1[2], l1[3], h1[0], h1[1], h1[2], h1[3]}, o[d0], 0, 0, 0);   \
        o[d0] = __builtin_amdgcn_mfma_f32_32x32x16_bf16(pa2, (bf16x8){l2[0], l2[1], l2[2], l2[3], h2[0], h2[1], h2[2], h2[3]}, o[d0], 0, 0, 0);   \
        o[d0] = __builtin_amdgcn_mfma_f32_32x32x16_bf16(pa3, (bf16x8){l3[0], l3[1], l3[2], l3[3], h3[0], h3[1], h3[2], h3[3]}, o[d0], 0, 0, 0); } while (0)
    PV_D0(0); PV_D0(1); PV_D0(2); PV_D0(3);
#undef PV_D0
#undef TRRD
}

template <class TIn, class TOut> struct BlockRef { const TIn* Q; const TIn* K; const TIn* V; TOut* O; const bf16* G; int P0; int jlo; };
template <class TIn> struct Seam {
    bf16x8 qr[8];
    bf16x8 st_v0, st_v1, st_k0, st_k1; f32x4 sf0, sf1, sf2, sf3;
    f32x4 tq[16];
};
__device__ __forceinline__ int swa_jlo(int P0, int W) { const int lowk = P0 - W + 1; return lowk > 0 ? lowk / KVBLK : 0; }
#define ROW(p, k0, rr) ((p) + (size_t)((k0) + (rr)) * KVS + sc)
#define VMW() asm volatile("s_waitcnt vmcnt(0)" ::: "memory")
#define VMWN(n) asm volatile("s_waitcnt vmcnt(%0)" :: "i"(n) : "memory")
#define SLOAD_H(Kp, Vp, k0) do { S.st_v0 = load8<TIn>(ROW(Vp, k0, sr)); S.st_v1 = load8<TIn>(ROW(Vp, k0, 32 + sr));              \
                         S.st_k0 = load8<TIn>(ROW(Kp, k0, sr)); S.st_k1 = load8<TIn>(ROW(Kp, k0, 32 + sr)); } while (0)
#define SWRITE_HK(bf) do { *(bf16x8*)(K_lds + (bf) * SHM_K + kws) = S.st_k0; *(bf16x8*)(K_lds + (bf) * SHM_K + kws + 32 * 256) = S.st_k1; } while (0)
#define SWRITE_HV(bf) do { *(bf16x8*)(V_lds + (bf) * SHM_V + vst0) = S.st_v0; *(bf16x8*)(V_lds + (bf) * SHM_V + vst1) = S.st_v1; } while (0)
#define SWRITE_H(bf) do { SWRITE_HV(bf); SWRITE_HK(bf); } while (0)
#define SLOAD_F(p, k0) do { S.sf0 = *(const f32x4*)ROW(p, k0, sr); S.sf1 = *(const f32x4*)(ROW(p, k0, sr) + 4);                \
                            S.sf2 = *(const f32x4*)ROW(p, k0, 32 + sr); S.sf3 = *(const f32x4*)(ROW(p, k0, 32 + sr) + 4); } while (0)
#define SWRITE_KF(bf) do { *(bf16x8*)(K_lds + (bf) * SHM_K + kws) = pack8(S.sf0, S.sf1); *(bf16x8*)(K_lds + (bf) * SHM_K + kws + 32 * 256) = pack8(S.sf2, S.sf3); } while (0)
#define SWRITE_VF(bf) do { *(bf16x8*)(V_lds + (bf) * SHM_V + vst0) = pack8(S.sf0, S.sf1); *(bf16x8*)(V_lds + (bf) * SHM_V + vst1) = pack8(S.sf2, S.sf3); } while (0)
template <class TIn, class TOut>
__device__ __forceinline__ void causal_swa_prime(const BlockRef<TIn, TOut>& cur, int W, char* lds, Seam<TIn>& S) {
    constexpr bool F32 = same_t<TIn, float>::v;
    const int tid = threadIdx.x, wid = __builtin_amdgcn_readfirstlane(tid >> 6), lane = tid & 63, r32 = lane & 31, hi = lane >> 5;
    const int sr = tid >> 4, sc = (tid & 15) * 8, kws = KSWZ(sr, sc * 2); char* K_lds = lds + 2 * SHM_V;
    const int kb0 = cur.jlo * KVBLK;
    for (int d0 = 0; d0 < 8; ++d0) S.qr[d0] = load8<TIn>(cur.Q + (size_t)(wid * QBLK + r32) * KVS + d0 * 16 + hi * 8);
    { lds_bf16x8* qp = (lds_bf16x8*)(lds + QLDS_OFF + (wid * QBLK + r32) * QLDS_ROW + hi * 16);
#pragma unroll
      for (int d0 = 0; d0 < 8; ++d0) qp[2 * d0] = S.qr[d0]; }
    if constexpr (F32) { SLOAD_F((const float*)cur.K, kb0); VMW(); SWRITE_KF(0); SBAR(); SLOAD_F((const float*)cur.V, kb0); }
    else { SLOAD_H(cur.K, cur.V, kb0); VMW(); SWRITE_HK(0); }
    __syncthreads();
}
template <class TIn, class TOut>
__device__ __forceinline__ void causal_swa_block(const BlockRef<TIn, TOut>& cur, const BlockRef<TIn, TOut>& nxt, int skv, int W, char* lds, Seam<TIn>& S) {
    constexpr bool F32 = same_t<TIn, float>::v;
    const int tid = threadIdx.x, wid = __builtin_amdgcn_readfirstlane(tid >> 6), lane = tid & 63, r32 = lane & 31, hi = lane >> 5;
    const int j_lo = cur.jlo;
    int j_hi = (cur.P0 + QB - 1) / KVBLK + 1; if (j_hi > skv / KVBLK) j_hi = skv / KVBLK;
    const int NT = j_hi - j_lo;
    const int kbn = nxt.jlo * KVBLK;
    const int qlo = cur.P0 + wid * QBLK, qm = qlo + r32 - 4 * hi;
    char* V_lds = lds; char* K_lds = lds + 2 * SHM_V;
    float* ws = (float*)(lds + 2 * SHM_V + 2 * SHM_K) + wid * 64; float* li_l = ws, * al_l = ws + 32;
    lds_bf16x8* qp = (lds_bf16x8*)(lds + QLDS_OFF + (wid * QBLK + r32) * QLDS_ROW + hi * 16);
    lds_f32* cb = (lds_f32*)(lds + 2 * SHM_V + 2 * SHM_K + NW * 64 * 4);
    float m_reg = -1e30f, l_reg = 0; f32x16 o[4] = {};
    const int sr = tid >> 4, sc = (tid & 15) * 8, vst0 = v_st(sr, sc), vst1 = v_st(32 + sr, sc), kws = KSWZ(sr, sc * 2);
    const int vb0 = (int)(uintptr_t)V_lds + v_rd_base(lane);
    const TIn* Kh = cur.K; const TIn* Vh = cur.V;
#define RESC(a) do { if (__any((a) < 1.f)) { if (hi == 0) al_l[r32] = (a); asm volatile("s_waitcnt lgkmcnt(0)" ::: "memory");              \
                     for (int d_ = 0; d_ < 4; ++d_) for (int r = 0; r < 16; ++r) o[d_][r] *= al_l[crow(r, hi)]; } } while (0)
#define KBASE(t) ((j_lo + (t)) * KVBLK)
#define ACT(t) (KBASE(t) <= qlo + QBLK - 1 && KBASE(t) + KVBLK - 1 >= qlo - W + 1)
#define MASKT(P0_, P1_, t) do { const int kb_ = KBASE(t); if ((!SK || ACT(t)) && (kb_ + KVBLK - 1 > qlo || kb_ <= qlo + QBLK - 1 - W)) mask_tile(P0_, P1_, qm - kb_, (unsigned)W); } while (0)
    constexpr int NQL = F32 ? 16 : 8;
    constexpr bool SK = WSKIP && !F32;
#define SEAM_K0() do { VMWN(NQL); if constexpr (F32) { SWRITE_KF(0); SBAR(); SLOAD_F((const float*)nxt.V, kbn); } else { SWRITE_HK(0); } SBAR(); } while (0)
    f32x16 pA0, pA1, pB0, pB1; float mnA, mnB, alA, alB; bf16x8 pa0, pa1, pa2, pa3;
    if constexpr (F32) { VMW(); SWRITE_VF(0); SBAR(); } else { SWRITE_HV(0); SBAR(); }
    if (NT > 1) { if constexpr (F32) SLOAD_F((const float*)Kh, KBASE(1)); else SLOAD_H(Kh, Vh, KBASE(1)); }
    SBAR(); qkt<0, SK>(pA0, pA1, K_lds, r32, hi, qp, ACT(0));
    if constexpr (F32) { if (NT > 1) { VMW(); SWRITE_KF(1); SBAR(); SLOAD_F((const float*)Vh, KBASE(1)); } }
    bias_tile(pA0, pA1, cb + KBASE(0), hi); MASKT(pA0, pA1, 0); partialSM(pA0, pA1, m_reg, mnA, alA);
    if (NT > 1) { VMW(); if constexpr (F32) { SWRITE_VF(1); SBAR(); if (NT > 2) SLOAD_F((const float*)Kh, KBASE(2)); } else SWRITE_H(1); }
    __syncthreads();
#define HALF_STEP(PX0, PX1, mnX, alX, PY0, PY1, alY, t, KB, VB, SB) do {                                                      \
        SBAR(); qkt<KB, SK>(PX0, PX1, K_lds, r32, hi, qp, ACT(t));                                             \
        finishSM(PY0, PY1, alY, l_reg, pa0, pa1, pa2, pa3); SBAR();                                                           \
        if ((t) + 1 < NT) { if constexpr (F32) { VMW(); SWRITE_KF(SB); SBAR(); SLOAD_F((const float*)Vh, KBASE((t) + 1)); }  \
                            else { SLOAD_H(Kh, Vh, KBASE((t) + 1)); } SBAR(); }                                               \
        pv_tile<VB, SK>(o, vb0, pa0, pa1, pa2, pa3, ACT((t) - 1)); bias_tile(PX0, PX1, cb + KBASE(t), hi); MASKT(PX0, PX1, (t)); partialSM(PX0, PX1, m_reg, mnX, alX);                                        \
        __syncthreads();                                                                                                      \
        if ((t) + 1 < NT) { VMW(); if constexpr (F32) { SWRITE_VF(SB); SBAR(); if ((t) + 2 < NT) SLOAD_F((const float*)Kh, KBASE((t) + 2)); } \
                            else { SWRITE_H(SB); } }                                                                          \
        RESC(alX); __syncthreads(); } while (0)
    for (int t = 1; t + 1 < NT; t += 2) {
        HALF_STEP(pB0, pB1, mnB, alB, pA0, pA1, alA, t, 1, 0, 0);
        HALF_STEP(pA0, pA1, mnA, alA, pB0, pB1, alB, t + 1, 0, 1, 1);
    }
    const bool even = (NT & 1) == 0;
    if (even) { SBAR(); qkt<1, SK>(pB0, pB1, K_lds, r32, hi, qp, ACT(NT - 1)); SBAR(); }
#define QROW(e) (nxt.Q + (size_t)(wid * QBLK + r32) * KVS + ((e) >> 1) * 16 + hi * 8 + ((e) & 1) * 4)
    if constexpr (F32) { SLOAD_F((const float*)nxt.K, kbn); SBAR();
#pragma unroll
        for (int e = 0; e < 8; ++e) S.tq[e] = *(const f32x4*)QROW(e); }
    else { SLOAD_H(nxt.K, nxt.V, kbn); SBAR();
#pragma unroll
        for (int d0 = 0; d0 < 8; ++d0) S.qr[d0] = load8<TIn>(nxt.Q + (size_t)(wid * QBLK + r32) * KVS + d0 * 16 + hi * 8); }
    SBAR();
    finishSM(pA0, pA1, alA, l_reg, pa0, pa1, pa2, pa3); SBAR();
    if constexpr (F32) {
#pragma unroll
        for (int e = 8; e < 16; ++e) S.tq[e] = *(const f32x4*)QROW(e); SBAR(); }
#undef QROW
    pv_tile<0, SK>(o, vb0, pa0, pa1, pa2, pa3, ACT(even ? NT - 2 : NT - 1));
    if (even) { bias_tile(pB0, pB1, cb + KBASE(NT - 1), hi); MASKT(pB0, pB1, NT - 1); partialSM(pB0, pB1, m_reg, mnB, alB); __syncthreads(); RESC(alB);
        finishSM(pB0, pB1, alB, l_reg, pa0, pa1, pa2, pa3); SBAR(); pv_tile<1, SK>(o, vb0, pa0, pa1, pa2, pa3, ACT(NT - 1)); }
    SBAR(); SEAM_K0();
    if (hi == 0) li_l[r32] = l_reg; asm volatile("s_waitcnt lgkmcnt(0)" ::: "memory");
    float rli[16];
#pragma unroll
    for (int r = 0; r < 16; ++r) rli[r] = __builtin_amdgcn_rcpf(li_l[crow(r, hi)]);
    TOut* Ow = cur.O + (size_t)(wid * QBLK) * OS;
    {
        typedef __attribute__((address_space(3))) unsigned short lds_u16; typedef __attribute__((address_space(3))) u32x4 lds_u32x4;
        const bf16* Gw = cur.G + (size_t)(wid * QBLK) * KVS;
        u32x4 gt[8];
#pragma unroll
        for (int i = 0; i < 8; ++i) { const int p = lane + 64 * i; gt[i] = __builtin_nontemporal_load((const u32x4*)(Gw + (size_t)(p >> 4) * KVS + (p & 15) * 8)); }
        lds_u16* st = (lds_u16*)(lds + QLDS_OFF + (wid * QBLK) * QLDS_ROW);
#pragma unroll
        for (int r = 0; r < 16; ++r) { const int orow = crow(r, hi);
#pragma unroll
            for (int d0 = 0; d0 < 4; d0 += 2) { const unsigned w2 = cvtpk(o[d0][r] * rli[r], o[d0 + 1][r] * rli[r]);
                st[orow * (QLDS_ROW / 2) + d0 * 32 + r32] = (unsigned short)w2; st[orow * (QLDS_ROW / 2) + (d0 + 1) * 32 + r32] = (unsigned short)(w2 >> 16); } }
        asm volatile("s_waitcnt lgkmcnt(0)" ::: "memory");
#pragma unroll
        for (int i = 0; i < 8; ++i) { const int p = lane + 64 * i, row = p >> 4, c8 = (p & 15) * 8;
            const u32x4 ov = *(const lds_u32x4*)(lds + QLDS_OFF + (wid * QBLK + row) * QLDS_ROW + c8 * 2); u32x4 w;
#pragma unroll
            for (int e = 0; e < 4; ++e) { const float a0 = __uint_as_float(ov[e] << 16), a1 = __uint_as_float(ov[e] & 0xffff0000u), g0 = __uint_as_float(gt[i][e] << 16), g1 = __uint_as_float(gt[i][e] & 0xffff0000u);
                w[e] = cvtpk(a0 * g0 * __builtin_amdgcn_rcpf(1.0f + __expf(-g0)), a1 * g1 * __builtin_amdgcn_rcpf(1.0f + __expf(-g1))); }
            *(u32x4*)(Ow + (size_t)row * OS + c8) = w; }
        asm volatile("s_waitcnt lgkmcnt(0)" ::: "memory");
    }
    if constexpr (F32) {
#pragma unroll
        for (int d0 = 0; d0 < 8; ++d0) S.qr[d0] = pack8(S.tq[2 * d0], S.tq[2 * d0 + 1]); }
#pragma unroll
    for (int d0 = 0; d0 < 8; ++d0) qp[2 * d0] = S.qr[d0];
    __syncthreads();
#undef RESC
#undef KBASE
#undef ACT
#undef MASKT
#undef SEAM_K0
#undef HALF_STEP
}
#undef ROW
#undef VMW
#undef VMWN
#undef SLOAD_H
#undef SWRITE_HK
#undef SWRITE_HV
#undef SWRITE_H
#undef SLOAD_F
#undef SWRITE_KF
#undef SWRITE_VF
}
__device__ __forceinline__ void fox_naive_row(const Args& a, int bh, int t, int lane) {
    const bf16* P = (const bf16*)(a.ws + WS_P); const float* cf = (const float*)(a.ws + WS_CFOX) + (size_t)bh * SEQ; bf16* mix = (bf16*)(a.ws + WS_MIX);
    const int b = bh >> 3, h = bh & 7; const size_t rowb = (size_t)b * SEQ;
    const unsigned qw = *(const unsigned*)(P + (rowb + t) * NP + C_FQ + 128 * h + 2 * lane);
    const float scale = 0.08838834764831845f; const float q0 = bflo(qw) * scale, q1 = bfhi(qw) * scale; const float ct = cf[t];
    float m = -1e30f, l = 0.f, o0 = 0.f, o1 = 0.f;
    for (int s = 0; s <= t; ++s) {
        const unsigned kw = *(const unsigned*)(P + (rowb + s) * NP + C_FK + 128 * h + 2 * lane), vw = *(const unsigned*)(P + (rowb + s) * NP + C_FV + 128 * h + 2 * lane);
        float d = q0 * bflo(kw) + q1 * bfhi(kw); d = wave_sum(d);
        const float logit = d + (ct - cf[s]);
        const float mn = fmaxf(m, logit), corr = __expf(m - mn), p = __expf(logit - mn);
        l = l * corr + p; o0 = o0 * corr + p * bflo(vw); o1 = o1 * corr + p * bfhi(vw); m = mn;
    }
    const unsigned gw_ = *(const unsigned*)(P + (rowb + t) * NP + C_FG + 128 * h + 2 * lane);
    const float inv = 1.0f / l;
    *(unsigned*)(mix + (rowb + t) * DM + 1024 + 128 * h + 2 * lane) = pk2(o0 * inv * silu_f(bflo(gw_)), o1 * inv * silu_f(bfhi(gw_)));
}
__device__ __forceinline__ void gla_naive(const Args& a, LAS unsigned char* lds, int bh, int tid) {
    const bf16* P = (const bf16*)(a.ws + WS_P); const float* small = (const float*)(a.ws + WS_SMALL); float* oraw = (float*)(a.ws + WS_ORAW);
    const int b = bh >> 2, h = bh & 3; const size_t rowb = (size_t)b * SEQ;
    LAS float* A = (LAS float*)lds; LAS float* Kk = A + 8 * 128; LAS float* Qq = Kk + 8 * 128; LAS float* Vv = Qq + 8 * 128; LAS float* OP = Vv + 8 * 256;
    const int dv = tid & 255, kh = tid >> 8;
    float S[64];
#pragma unroll
    for (int j = 0; j < 64; ++j) S[j] = 0.f;
    const float qscale = 0.08838834764831845f;
    for (int tb = 0; tb < SEQ / 8; ++tb) {
        for (int idx = tid; idx < 1024; idx += NTHR) { const int tt = idx >> 7, k = idx & 127; const size_t row = rowb + tb * 8 + tt;
            float z = a.alpha_b[128 * h + k];
#pragma unroll
            for (int r = 0; r < 16; ++r) z += small[row * 32 + r] * a.alpha_up[r * 512 + 128 * h + k];
            A[idx] = __expf(logsigmoid_f(z) * (1.0f / 16.0f)); Kk[idx] = bf2f(P[row * NP + C_GK + 128 * h + k]); Qq[idx] = bf2f(P[row * NP + C_GQ + 128 * h + k]) * qscale; }
        for (int idx = tid; idx < 2048; idx += NTHR) { const int tt = idx >> 8, d = idx & 255; Vv[idx] = bf2f(P[(rowb + tb * 8 + tt) * NP + C_GV + 256 * h + d]); }
        __syncthreads();
        for (int tt = 0; tt < 8; ++tt) { const float v = Vv[tt * 256 + dv]; float o = 0.f;
#pragma unroll
            for (int j = 0; j < 64; ++j) { const int ki = tt * 128 + kh * 64 + j; S[j] = A[ki] * S[j] + Kk[ki] * v; o += Qq[ki] * S[j]; }
            OP[(tt * 2 + kh) * 256 + dv] = o; }
        __syncthreads();
        for (int idx = tid; idx < 2048; idx += NTHR) { const int tt = idx >> 8, d = idx & 255; oraw[(rowb + tb * 8 + tt) * 1024 + 256 * h + d] = OP[(tt * 2) * 256 + d] + OP[(tt * 2 + 1) * 256 + d]; }
    }
}
__device__ __forceinline__ void gla_pass_a(const Args& a, LAS unsigned char* lds, int unit, int tid);
__device__ __forceinline__ void gla_pass_c(const Args& a, LAS unsigned char* lds, int unit, int tid);
__device__ __forceinline__ void phase_gla_b(const Args& a, int tid, int gw, int NG);
__device__ __forceinline__ void phase_gla_b2(const Args& a, int tid, int gw, int NG);
__device__ __forceinline__ void sub_barrier(unsigned* cnt, unsigned target) {
    asm volatile("s_waitcnt vmcnt(0)" ::: "memory"); __syncthreads();
    if (threadIdx.x == 0) {
        __builtin_amdgcn_fence(__ATOMIC_RELEASE, "agent"); asm volatile("s_waitcnt vmcnt(0)" ::: "memory");
        __hip_atomic_fetch_add(cnt, 1u, __ATOMIC_RELAXED, __HIP_MEMORY_SCOPE_AGENT);
        unsigned sp = 0; while (__hip_atomic_load(cnt, __ATOMIC_RELAXED, __HIP_MEMORY_SCOPE_AGENT) < target) { __builtin_amdgcn_s_sleep(2); if (++sp > (1u << 22)) break; }
        __builtin_amdgcn_fence(__ATOMIC_ACQUIRE, "agent"); asm volatile("s_waitcnt vmcnt(0)" ::: "memory");
    }
    __syncthreads();
}
__device__ __forceinline__ fox::BlockRef<bf16, bf16> fox_ref(const Args& a, int bh, int qb, int jlo) {
    const bf16* P = (const bf16*)(a.ws + WS_P); const int b = bh >> 3, h = bh & 7; const size_t row0 = (size_t)b * SEQ + (size_t)qb * 256;
    fox::BlockRef<bf16, bf16> r;
    r.Q = P + row0 * NP + C_FQ + 128 * h; r.K = P + (size_t)b * SEQ * NP + C_FK + 128 * h; r.V = P + (size_t)b * SEQ * NP + C_FV + 128 * h;
    r.O = (bf16*)(a.ws + WS_MIX) + row0 * DM + 1024 + 128 * h; r.G = P + row0 * NP + C_FG + 128 * h; r.P0 = qb * 256; r.jlo = jlo;
    return r;
}
__device__ __forceinline__ void phase_fox(const Args& a, char* lds, int w) {
    const int bh = 2 * (w & 7) + (w >> 7), qb = (w >> 3) & 15, P0 = qb * 256;
    fox::lds_f32* cb = (fox::lds_f32*)(lds + fox::LDS_BYTES);
    {   const float* cf = (const float*)(a.ws + WS_CFOX) + (size_t)bh * SEQ;
        for (int j = threadIdx.x; j < P0 + 256; j += NTHR) cb[j] = cf[j] * (-1.0f / fox::SCALE); }
    __syncthreads();
    int jl0;
    {   const float* nm = (const float*)(a.ws + WS_BAR + 20480) + (size_t)bh * 8;
        const float qn2 = (nm[0] + nm[1]) + (nm[2] + nm[3]), kn2 = (nm[4] + nm[5]) + (nm[6] + nm[7]);
        const float thr = -(50.0f / fox::SCALE) - 2.0f * 1.02f * sqrtf(qn2 * kn2);
        const int lane = threadIdx.x & 63;
        const bool skip = lane < P0 / 64 && (cb[64 * lane + 63] - cb[P0] <= thr);
        jl0 = __builtin_amdgcn_readfirstlane((int)__builtin_popcountll(__ballot(skip)));
    }
    const fox::BlockRef<bf16, bf16> cur = fox_ref(a, bh, qb, jl0);
    fox::Seam<bf16> S;
    fox::causal_swa_prime<bf16, bf16>(cur, SEQ, lds, S);
    fox::causal_swa_block<bf16, bf16>(cur, cur, SEQ, SEQ, lds, S);
}
__device__ __forceinline__ void phase_m1(const Args& a, LAS unsigned char* lds, int tid, int G) {
    for (int unit = blockIdx.x; unit < 512; unit += G) gla_pass_a(a, lds, unit, tid);
    __syncthreads();
    phase_fox_cumsum(a, lds, tid, G);
}
__device__ __forceinline__ void phase_m2(const Args& a, unsigned char* lds_raw, int tid, int G) {
    if (G * NTHR >= 131072) phase_gla_b2(a, tid, blockIdx.x, G); else phase_gla_b(a, tid, blockIdx.x, G);
    if (blockIdx.x < 256) phase_fox(a, (char*)lds_raw, blockIdx.x);
}
__device__ __forceinline__ void phase_gla_finalize(const Args& a, int tid, int G) {
    const int lane = tid & 63, wave = tid >> 6; const int gw = blockIdx.x * NWAVES + wave, NGW = G * NWAVES;
    const bf16* P = (const bf16*)(a.ws + WS_P); const float* oraw = (const float*)(a.ws + WS_ORAW); bf16* mix = (bf16*)(a.ws + WS_MIX);
    for (int it = gw; it < MROWS * 4; it += NGW) { const int row = it >> 2, h = it & 3;
        const f32x4 v = *(const f32x4*)(oraw + (size_t)row * 1024 + 256 * h + 4 * lane);
        float s = (v[0] * v[0] + v[1] * v[1]) + (v[2] * v[2] + v[3] * v[3]); s = wave_sum(s);
        const float r = rsqrtf(s * (1.0f / 256.0f) + EPS);
        const f32x4 g = *(const f32x4*)(a.head_g + 256 * h + 4 * lane);
        const v2u gt = *(const v2u*)(P + (size_t)row * NP + C_GG + 256 * h + 4 * lane);
        v2u w; w.x = pk2(v[0] * r * g[0] * silu_f(bflo(gt.x)), v[1] * r * g[1] * silu_f(bfhi(gt.x))); w.y = pk2(v[2] * r * g[2] * silu_f(bflo(gt.y)), v[3] * r * g[3] * silu_f(bfhi(gt.y)));
        *(v2u*)(mix + (size_t)row * DM + 256 * h + 4 * lane) = w; }
    for (int row0 = gw; row0 < MROWS; row0 += 4 * NGW) {
        v4u m[4][2], g[4][2];
#pragma unroll
        for (int rr = 0; rr < 4; ++rr) { const int row = row0 + rr * NGW; if (row < MROWS) { const v4u* mp = (const v4u*)(mix + (size_t)row * DM + 1024 + 16 * lane); const v4u* gp = (const v4u*)(P + (size_t)row * NP + C_FG + 16 * lane);
            m[rr][0] = mp[0]; m[rr][1] = mp[1]; g[rr][0] = gp[0]; g[rr][1] = gp[1]; } }
#pragma unroll
        for (int rr = 0; rr < 4; ++rr) { const int row = row0 + rr * NGW; if (row < MROWS) { v4u* mp = (v4u*)(mix + (size_t)row * DM + 1024 + 16 * lane);
#pragma unroll
            for (int q = 0; q < 2; ++q) { v4u o;
#pragma unroll
                for (int e = 0; e < 4; ++e) o[e] = pk2(bflo(m[rr][q][e]) * silu_f(bflo(g[rr][q][e])), bfhi(m[rr][q][e]) * silu_f(bfhi(g[rr][q][e])));
                mp[q] = o; } } }
    }
}
__device__ __forceinline__ void phase_s5_naive(const Args& a, int tid, int G) {
    const int lane = tid & 63, wave = tid >> 6; const int gw = blockIdx.x * NWAVES + wave;
    if (gw >= 256) return;
    const int b = gw >> 7, g = gw & 127, p = lane;
    const bf16* UG = (const bf16*)(a.ws + WS_UG); bf16* zb = (bf16*)(a.ws + WS_ZB);
    const float lr = fminf(a.lam_re[g * 64 + p], -1e-4f), li = a.lam_im[g * 64 + p], step = __expf(a.log_step[g]);
    const float mag = __expf(lr * step), lbr = mag * cosf(li * step), lbi = mag * sinf(li * step);
    const float den = lr * lr + li * li, nr = lbr - 1.0f, ni = lbi, cr = (nr * lr + ni * li) / den, ci = (ni * lr - nr * li) / den;
    float bbr[16], bbi[16], ccr[16], cci[16];
#pragma unroll
    for (int c = 0; c < 16; ++c) { const float br = a.b_re[(g * 64 + p) * 16 + c], bi = a.b_im[(g * 64 + p) * 16 + c]; bbr[c] = cr * br - ci * bi; bbi[c] = cr * bi + ci * br;
        ccr[c] = a.c_re[(g * 16 + c) * 64 + p]; cci[c] = a.c_im[(g * 16 + c) * 64 + p]; }
    const float dd = a.s5_d[g * 16 + (lane & 15)];
    float xr = 0.f, xi = 0.f;
    for (int t = 0; t < SEQ; ++t) { const size_t row = (size_t)b * SEQ + t;
        const v4u u0 = *(const v4u*)(UG + row * 4096 + 16 * g), u1 = *(const v4u*)(UG + row * 4096 + 16 * g + 8);
        float u[16];
#pragma unroll
        for (int e = 0; e < 4; ++e) { u[2 * e] = bflo(u0[e]); u[2 * e + 1] = bfhi(u0[e]); u[8 + 2 * e] = bflo(u1[e]); u[8 + 2 * e + 1] = bfhi(u1[e]); }
        float br = 0.f, bi = 0.f;
#pragma unroll
        for (int c = 0; c < 16; ++c) { br += bbr[c] * u[c]; bi += bbi[c] * u[c]; }
        const float nxr = lbr * xr - lbi * xi + br, nxi = lbr * xi + lbi * xr + bi; xr = nxr; xi = nxi;
        float ymine = 0.f, umine = 0.f;
#pragma unroll
        for (int c = 0; c < 16; ++c) { const float y = wave_sum(ccr[c] * xr - cci[c] * xi); if ((lane & 15) == c) { ymine = y; umine = u[c]; } }
        if (lane < 16) { const float y = ymine + dd * umine; zb[row * DM + 16 * g + lane] = (bf16)f2bf(gelu_tanh(y)); }
    }
}

typedef short s5_bf16x8 __attribute__((ext_vector_type(8)));
typedef float s5_f32x16 __attribute__((ext_vector_type(16)));
typedef float s5_f32x2 __attribute__((ext_vector_type(2)));
template <bool PASS2>
__device__ __forceinline__ void s5_pass(const bf16* UG, bf16* zb, LAS unsigned char* xl, int g, int seg0, int lane, const s5_bf16x8 (&Bf)[4], const s5_bf16x8 (&Cf)[4], f32x4 Dv,
                                        float lbr0, float lbi0, float lbr1, float lbi1, s5_f32x2& xr0, s5_f32x2& xi0, s5_f32x2& xr1, s5_f32x2& xi1, int nblk) {
    const int r = lane & 31, hl = lane >> 5, q4 = lane >> 4;
    const int rgA = 4 * (r >> 3) + (r & 3);
    const bf16* ap = UG + ((size_t)((rgA & 1) * SEQ + seg0 + 128 * ((r >> 2) & 1) + (rgA >> 1))) * 4096 + 16 * g + 8 * hl;
    s5_bf16x8 af = *(const s5_bf16x8*)ap;
    for (int blk = 0; blk < nblk; ++blk) {
        const s5_bf16x8 afn = *(const s5_bf16x8*)(ap + (size_t)((blk < nblk - 1 ? blk + 1 : blk) * 8) * 4096);
        v2u uu2[2] = {};
        if constexpr (PASS2) {
#pragma unroll
            for (int nblk = 0; nblk < 2; ++nblk) { const int i = 16 * nblk + (lane & 15), rg = 4 * (i >> 3) + (i & 3); const size_t rowg = (size_t)((rg & 1) * SEQ + seg0 + 128 * ((i >> 2) & 1) + blk * 8 + (rg >> 1));
                uu2[nblk] = *(const v2u*)(UG + rowg * 4096 + 16 * g + 4 * q4); } }
        s5_f32x16 acc[4];
#pragma unroll
        for (int nb = 0; nb < 4; ++nb) { acc[nb] = s5_f32x16{}; acc[nb] = __builtin_amdgcn_mfma_f32_32x32x16_bf16(af, Bf[nb], acc[nb], 0, 0, 0); }
#pragma unroll
        for (int k = 0; k < 8; ++k) {
            const s5_f32x2 b0r = {acc[0][2 * k], acc[0][2 * k + 1]}, b0i = {acc[2][2 * k], acc[2][2 * k + 1]}, b1r = {acc[1][2 * k], acc[1][2 * k + 1]}, b1i = {acc[3][2 * k], acc[3][2 * k + 1]};
            const s5_f32x2 n0r = lbr0 * xr0 - lbi0 * xi0 + b0r, n0i = lbr0 * xi0 + lbi0 * xr0 + b0i;
            const s5_f32x2 n1r = lbr1 * xr1 - lbi1 * xi1 + b1r, n1i = lbr1 * xi1 + lbi1 * xr1 + b1i;
            xr0 = n0r; xi0 = n0i; xr1 = n1r; xi1 = n1i;
            acc[0][2 * k] = n0r.x; acc[0][2 * k + 1] = n0r.y; acc[2][2 * k] = n0i.x; acc[2][2 * k + 1] = n0i.y; acc[1][2 * k] = n1r.x; acc[1][2 * k + 1] = n1r.y; acc[3][2 * k] = n1i.x; acc[3][2 * k + 1] = n1i.y;
        }
        if constexpr (PASS2) {
#pragma unroll
            for (int nb = 0; nb < 4; ++nb)
#pragma unroll
                for (int t = 0; t < 16; t += 2) { const int i = (t & 3) + 8 * (t >> 2) + 4 * hl; const unsigned pw = pk2(acc[nb][t], acc[nb][t + 1]);
                    *(LAS unsigned short*)(xl + i * 272 + (32 * nb + r) * 2) = (unsigned short)pw; *(LAS unsigned short*)(xl + (i + 1) * 272 + (32 * nb + r) * 2) = (unsigned short)(pw >> 16); }
            asm volatile("s_waitcnt lgkmcnt(0)" ::: "memory"); __builtin_amdgcn_wave_barrier();
#pragma unroll
            for (int nblk = 0; nblk < 2; ++nblk) {
                const int i = 16 * nblk + (lane & 15), rg = 4 * (i >> 3) + (i & 3);
                f32x4 y = {0.f, 0.f, 0.f, 0.f};
#pragma unroll
                for (int ks = 0; ks < 4; ++ks) { const s5_bf16x8 xf = *(const LAS s5_bf16x8*)(xl + i * 272 + 64 * ks + 16 * q4); y = __builtin_amdgcn_mfma_f32_16x16x32_bf16(Cf[ks], xf, y, 0, 0, 0); }
                const size_t rowg = (size_t)((rg & 1) * SEQ + seg0 + 128 * ((i >> 2) & 1) + blk * 8 + (rg >> 1));
                const v2u uu = uu2[nblk];
                const float z0 = gelu_tanh(y[0] + Dv[0] * bflo(uu.x)), z1 = gelu_tanh(y[1] + Dv[1] * bfhi(uu.x)), z2 = gelu_tanh(y[2] + Dv[2] * bflo(uu.y)), z3 = gelu_tanh(y[3] + Dv[3] * bfhi(uu.y));
                v2u w; w.x = pk2(z0, z1); w.y = pk2(z2, z3); *(v2u*)(zb + rowg * DM + 16 * g + 4 * q4) = w;
            }
            asm volatile("s_waitcnt lgkmcnt(0)" ::: "memory"); __builtin_amdgcn_wave_barrier();
        }
        af = afn;
    }
}
constexpr size_t WS_S5E = 56 * MiB;
__device__ __forceinline__ void phase_s5(const Args& a, LAS unsigned char* lds, int tid) {
    if (blockIdx.x >= 256) return;
    const int wave0 = __builtin_amdgcn_readfirstlane(tid >> 6);
    const int g = (blockIdx.x & 15) * 8 + wave0, seg_wg = blockIdx.x >> 4;
    const int lane = tid & 63, wave = wave0, r = lane & 31, hl = lane >> 5, q4 = lane >> 4, ch = lane & 15;
    const bf16* UG = (const bf16*)(a.ws + WS_UG); bf16* zb = (bf16*)(a.ws + WS_ZB);
    const float step = __expf(a.log_step[g]);
    float lbr[2], lbi[2]; s5_bf16x8 Bf[4], Cf[4];
#pragma unroll
    for (int s2 = 0; s2 < 2; ++s2) { const int p = r + 32 * s2;
        const float lr = fminf(a.lam_re[g * 64 + p], -1e-4f), li = a.lam_im[g * 64 + p];
        const float mag = __expf(lr * step); lbr[s2] = mag * cosf(li * step); lbi[s2] = mag * sinf(li * step);
        const float den = lr * lr + li * li, nr = lbr[s2] - 1.0f, ni = lbi[s2], cr = (nr * lr + ni * li) / den, ci = (ni * lr - nr * li) / den;
        const f32x4 br0 = *(const f32x4*)(a.b_re + (size_t)(g * 64 + p) * 16 + 8 * hl), br1 = *(const f32x4*)(a.b_re + (size_t)(g * 64 + p) * 16 + 8 * hl + 4);
        const f32x4 bi0 = *(const f32x4*)(a.b_im + (size_t)(g * 64 + p) * 16 + 8 * hl), bi1 = *(const f32x4*)(a.b_im + (size_t)(g * 64 + p) * 16 + 8 * hl + 4);
#pragma unroll
        for (int j = 0; j < 8; ++j) { const float br = j < 4 ? br0[j & 3] : br1[j & 3], bi = j < 4 ? bi0[j & 3] : bi1[j & 3];
            Bf[s2][j] = (short)f2bf(cr * br - ci * bi); Bf[2 + s2][j] = (short)f2bf(cr * bi + ci * br); } }
#pragma unroll
    for (int ks = 0; ks < 4; ++ks) { const int st = (ks & 1) * 32 + 8 * q4; const float* src = (ks < 2 ? a.c_re : a.c_im) + (size_t)(g * 16 + ch) * 64 + st;
        const f32x4 c0 = *(const f32x4*)src, c1 = *(const f32x4*)(src + 4);
#pragma unroll
        for (int j = 0; j < 8; ++j) { const float v = j < 4 ? c0[j & 3] : c1[j & 3]; Cf[ks][j] = (short)f2bf(ks < 2 ? v : -v); } }
    const f32x4 Dv = *(const f32x4*)(a.s5_d + g * 16 + 4 * q4);
    LAS unsigned char* xl = lds + wave * 8704; float* Ef = (float*)(a.ws + WS_S5E) + (size_t)g * 32 * 32 * 8;
    const int seg = seg_wg, subseg = 2 * seg + hl;
    s5_f32x2 xr0 = {0.f, 0.f}, xi0 = {0.f, 0.f}, xr1 = {0.f, 0.f}, xi1 = {0.f, 0.f};
    s5_pass<false>(UG, zb, xl, g, seg * 256, lane, Bf, Cf, Dv, lbr[0], lbi[0], lbr[1], lbi[1], xr0, xi0, xr1, xi1, 16);
    {   unsigned long long* E64 = (unsigned long long*)(Ef + (size_t)(subseg * 32 + r) * 8);
        __hip_atomic_store(E64, ((unsigned long long)__float_as_uint(xr0.y) << 32) | __float_as_uint(xr0.x), __ATOMIC_RELAXED, __HIP_MEMORY_SCOPE_AGENT);
        __hip_atomic_store(E64 + 1, ((unsigned long long)__float_as_uint(xi0.y) << 32) | __float_as_uint(xi0.x), __ATOMIC_RELAXED, __HIP_MEMORY_SCOPE_AGENT);
        __hip_atomic_store(E64 + 2, ((unsigned long long)__float_as_uint(xr1.y) << 32) | __float_as_uint(xr1.x), __ATOMIC_RELAXED, __HIP_MEMORY_SCOPE_AGENT);
        __hip_atomic_store(E64 + 3, ((unsigned long long)__float_as_uint(xi1.y) << 32) | __float_as_uint(xi1.x), __ATOMIC_RELAXED, __HIP_MEMORY_SCOPE_AGENT); }
    asm volatile("s_waitcnt vmcnt(0)" ::: "memory"); __syncthreads();
    unsigned* cnt = (unsigned*)(a.ws + WS_BAR + 18432) + 16 * (blockIdx.x & 15);
    if (tid == 0) { __hip_atomic_fetch_add(cnt, 1u, __ATOMIC_RELAXED, __HIP_MEMORY_SCOPE_AGENT);
        unsigned sp = 0; while (__hip_atomic_load(cnt, __ATOMIC_RELAXED, __HIP_MEMORY_SCOPE_AGENT) < 16u) { __builtin_amdgcn_s_sleep(2); if (++sp > (1u << 20)) break; }
        __builtin_amdgcn_fence(__ATOMIC_ACQUIRE, "agent"); asm volatile("s_waitcnt vmcnt(0)" ::: "memory"); }
    __syncthreads();
    {   float p0r = lbr[0], p0i = lbi[0], p1r = lbr[1], p1i = lbi[1];
#pragma unroll
        for (int s = 0; s < 7; ++s) { const float a0 = p0r * p0r - p0i * p0i, b0 = 2.f * p0r * p0i, a1 = p1r * p1r - p1i * p1i, b1 = 2.f * p1r * p1i; p0r = a0; p0i = b0; p1r = a1; p1i = b1; }
        xr0 = (s5_f32x2){0.f, 0.f}; xi0 = xr0; xr1 = xr0; xi1 = xr0;
        for (int s = 0; s < 2 * seg + 1; ++s) { if (s < subseg) { const f32x4 e0 = *(const f32x4*)(Ef + (size_t)(s * 32 + r) * 8), e1 = *(const f32x4*)(Ef + (size_t)(s * 32 + r) * 8 + 4);
            const s5_f32x2 er0 = {e0[0], e0[1]}, ei0 = {e0[2], e0[3]}, er1 = {e1[0], e1[1]}, ei1 = {e1[2], e1[3]};
            const s5_f32x2 n0r = p0r * xr0 - p0i * xi0 + er0, n0i = p0r * xi0 + p0i * xr0 + ei0, n1r = p1r * xr1 - p1i * xi1 + er1, n1i = p1r * xi1 + p1i * xr1 + ei1;
            xr0 = n0r; xi0 = n0i; xr1 = n1r; xi1 = n1i; } }
        s5_pass<true>(UG, zb, xl, g, seg * 256, lane, Bf, Cf, Dv, lbr[0], lbi[0], lbr[1], lbi[1], xr0, xi0, xr1, xi1, 16);
    }
}
constexpr size_t WS_S5E_DUMMY = 0;

typedef short g_bf16x8 __attribute__((ext_vector_type(8)));
typedef float g_f32x16 __attribute__((ext_vector_type(16)));
constexpr size_t WS_QT = 44 * MiB, WS_OINTRA = 52 * MiB, WS_SINT = 221 * MiB, WS_DECAY = WS_PART2;
__device__ __forceinline__ int g_irow(int reg, int hl) { return (reg & 3) + 8 * (reg >> 2) + 4 * hl; }
__device__ __forceinline__ void gla_pass_a(const Args& a, LAS unsigned char* lds, int unit, int tid) {
    const bf16* P = (const bf16*)(a.ws + WS_P); const float* small = (const float*)(a.ws + WS_SMALL);
    bf16* qtg = (bf16*)(a.ws + WS_QT); unsigned* oin = (unsigned*)(a.ws + WS_OINTRA); bf16* kvt = (bf16*)a.out; float* decay = (float*)(a.ws + WS_DECAY);
    const int bh = unit >> 6, n = unit & 63, b = bh >> 2, h = bh & 3; const size_t R0 = (size_t)b * SEQ + 64 * n;
    LAS bf16* QT = (LAS bf16*)lds; LAS bf16* KT = (LAS bf16*)(lds + 17408); LAS bf16* KH = (LAS bf16*)(lds + 34816); LAS bf16* VT = (LAS bf16*)(lds + 53248); LAS bf16* AT = (LAS bf16*)(lds + 90112); LAS float* PART = (LAS float*)(lds + 99328);
    const int lane = tid & 63, w = __builtin_amdgcn_readfirstlane(tid >> 6), r = lane & 31, hl = lane >> 5;
    __syncthreads();
    {
        const int col = tid & 127, qtr = tid >> 7; const float ab = a.alpha_b[128 * h + col]; float au[16];
#pragma unroll
        for (int rr = 0; rr < 16; ++rr) au[rr] = a.alpha_up[rr * 512 + 128 * h + col];
        bf16 qraw[16], kraw[16];
#pragma unroll
        for (int t = 0; t < 16; ++t) { const size_t row = R0 + 16 * qtr + t; qraw[t] = P[row * NP + C_GQ + 128 * h + col]; kraw[t] = P[row * NP + C_GK + 128 * h + col]; }
        float cs[16]; float run = 0.f;
#pragma unroll
        for (int t = 0; t < 16; ++t) { const size_t row = R0 + 16 * qtr + t; const f32x4* sp = (const f32x4*)(small + row * 32); float z = ab;
#pragma unroll
            for (int q = 0; q < 4; ++q) { const f32x4 s4 = sp[q]; z += s4[0] * au[4 * q] + s4[1] * au[4 * q + 1] + s4[2] * au[4 * q + 2] + s4[3] * au[4 * q + 3]; }
            run += logsigmoid_f(z) * (1.0f / 16.0f); cs[t] = run; }
        PART[qtr * 128 + col] = run;
        {   const int dv = tid & 255, half = tid >> 8;
#pragma unroll 8
            for (int t = 0; t < 32; t += 2) { const int tok = 32 * half + t; const unsigned lo = P[(R0 + tok) * NP + C_GV + 256 * h + dv], hi2 = P[(R0 + tok + 1) * NP + C_GV + 256 * h + dv];
                *(LAS unsigned*)(VT + dv * 72 + tok) = lo | (hi2 << 16); } }
        __syncthreads();
        float pre = 0.f, tot = 0.f;
#pragma unroll
        for (int q = 0; q < 4; ++q) { const float v = PART[q * 128 + col]; tot += v; if (q < qtr) pre += v; }
        const float qscale = 0.08838834764831845f;
#pragma unroll
        for (int t = 0; t < 16; t += 2) { float khv[2];
#pragma unroll
            for (int u2 = 0; u2 < 2; ++u2) { const int tok = 16 * qtr + t + u2; const size_t row = R0 + tok; const float bb = pre + cs[t + u2];
                const float qv = bf2f(qraw[t + u2]) * qscale * __expf(bb), kv = bf2f(kraw[t + u2]);
                const bf16 qb = (bf16)f2bf(qv);
                QT[tok * 136 + col] = qb; KT[tok * 136 + col] = (bf16)f2bf(kv * __expf(-bb)); khv[u2] = kv * __expf(tot - bb); qtg[row * 512 + 128 * h + col] = qb; }
            *(LAS unsigned*)(KH + col * 72 + 16 * qtr + t) = pk2(khv[0], khv[1]); }
        if (qtr == 0) decay[(size_t)unit * 128 + col] = __expf(tot);
    }
    __syncthreads();
    if (w < 4) {
        const int bi = w >> 1, bj = w & 1;
        if (bi == 0 && bj == 1) {
#pragma unroll
            for (int reg = 0; reg < 16; ++reg) AT[g_irow(reg, hl) * 72 + 32 + r] = 0;
        } else {
            g_f32x16 acc = g_f32x16{};
#pragma unroll
            for (int ks = 0; ks < 8; ++ks) { const g_bf16x8 af = *(const LAS g_bf16x8*)(QT + (32 * bi + r) * 136 + 16 * ks + 8 * hl), bf = *(const LAS g_bf16x8*)(KT + (32 * bj + r) * 136 + 16 * ks + 8 * hl);
                acc = __builtin_amdgcn_mfma_f32_32x32x16_bf16(af, bf, acc, 0, 0, 0); }
#pragma unroll
            for (int reg = 0; reg < 16; ++reg) { const int i = 32 * bi + g_irow(reg, hl), j = 32 * bj + r; AT[i * 72 + j] = (bf16)f2bf(j <= i ? acc[reg] : 0.f); }
        }
    }
    __syncthreads();
    {
#pragma unroll
        for (int bi = 0; bi < 2; ++bi) { g_f32x16 acc = g_f32x16{};
#pragma unroll
            for (int ks = 0; ks < 4; ++ks) { if (bi == 0 && ks >= 2) continue;
                const g_bf16x8 af = *(const LAS g_bf16x8*)(AT + (32 * bi + r) * 72 + 16 * ks + 8 * hl), bf = *(const LAS g_bf16x8*)(VT + (32 * w + r) * 72 + 16 * ks + 8 * hl);
                acc = __builtin_amdgcn_mfma_f32_32x32x16_bf16(bf, af, acc, 0, 0, 0); }
            v4u o0, o1;
#pragma unroll
            for (int e = 0; e < 4; ++e) { o0[e] = pk2(acc[2 * e], acc[2 * e + 1]); o1[e] = pk2(acc[8 + 2 * e], acc[8 + 2 * e + 1]); }
            v4u* op = (v4u*)(oin + ((size_t)((unit * 8 + w) * 2 + bi) * 64 + lane) * 8); op[0] = o0; op[1] = o1; }
        g_bf16x8 av[4];
#pragma unroll
        for (int ks = 0; ks < 4; ++ks) av[ks] = *(const LAS g_bf16x8*)(VT + (32 * w + r) * 72 + 16 * ks + 8 * hl);
        LAS unsigned char* slab = lds + w * 4096;
#pragma unroll
        for (int pr = 0; pr < 2; ++pr) {
#pragma unroll
            for (int nbl = 0; nbl < 2; ++nbl) { const int nb = 2 * pr + nbl; g_f32x16 acc = g_f32x16{};
#pragma unroll
                for (int ks = 0; ks < 4; ++ks) { const g_bf16x8 bf = *(const LAS g_bf16x8*)(KH + (32 * nb + r) * 72 + 16 * ks + 8 * hl); acc = __builtin_amdgcn_mfma_f32_32x32x16_bf16(bf, av[ks], acc, 0, 0, 0); }
#pragma unroll
                for (int g4 = 0; g4 < 4; ++g4) { v2u o; o.x = pk2(acc[4 * g4], acc[4 * g4 + 1]); o.y = pk2(acc[4 * g4 + 2], acc[4 * g4 + 3]);
                    *(LAS v2u*)(slab + r * 128 + (((4 * nbl + g4) ^ (r & 7)) * 16) + hl * 8) = o; } }
            asm volatile("s_waitcnt lgkmcnt(0)" ::: "memory"); __builtin_amdgcn_wave_barrier();
#pragma unroll
            for (int i = 0; i < 4; ++i) { const int p = lane + 64 * i, rr = p >> 3, q = p & 7;
                *(v4u*)(kvt + ((size_t)unit * 256 + 32 * w + rr) * 128 + 64 * pr + 8 * q) = *(const LAS v4u*)(slab + rr * 128 + ((q ^ (rr & 7)) * 16)); }
            asm volatile("s_waitcnt lgkmcnt(0)" ::: "memory"); __builtin_amdgcn_wave_barrier();
        }
    }
}
__device__ __forceinline__ void phase_gla_b(const Args& a, int tid, int gw, int NG) {
    const bf16* kvt = (const bf16*)a.out; const float* decay = (const float*)(a.ws + WS_DECAY); bf16* sint = (bf16*)(a.ws + WS_SINT);
    for (size_t qi = (size_t)gw * NTHR + tid; qi < (size_t)2 * 32768; qi += (size_t)NG * NTHR) {
        const size_t idx = qi * 4; const int bh = (int)(idx >> 15), e = (int)(idx & 32767);
        float s0 = 0.f, s1 = 0.f, s2 = 0.f, s3 = 0.f;
#pragma unroll 8
        for (int n = 0; n < 64; ++n) { const size_t unit = (size_t)bh * 64 + n;
            v2u o; o.x = pk2(s0, s1); o.y = pk2(s2, s3); *(v2u*)(sint + unit * 32768 + e) = o;
            const f32x4 d = *(const f32x4*)(decay + unit * 128 + (e & 127)); const v2u kw = *(const v2u*)(kvt + unit * 32768 + e);
            s0 = d[0] * s0 + bflo(kw.x); s1 = d[1] * s1 + bfhi(kw.x); s2 = d[2] * s2 + bflo(kw.y); s3 = d[3] * s3 + bfhi(kw.y); }
    }
}
__device__ __forceinline__ void phase_gla_b2(const Args& a, int tid, int gw, int NG) {
    typedef float f32x2v __attribute__((ext_vector_type(2)));
    const bf16* kvt = (const bf16*)a.out; const float* decay = (const float*)(a.ws + WS_DECAY); bf16* sint = (bf16*)(a.ws + WS_SINT);
    for (size_t pi = (size_t)gw * NTHR + tid; pi < (size_t)4 * 32768; pi += (size_t)NG * NTHR) {
        const size_t idx = pi * 2; const int bh = (int)(idx >> 15), e = (int)(idx & 32767);
        float s0 = 0.f, s1 = 0.f;
#pragma unroll 8
        for (int n = 0; n < 64; ++n) { const size_t unit = (size_t)bh * 64 + n;
            *(unsigned*)(sint + unit * 32768 + e) = pk2(s0, s1);
            const f32x2v d = *(const f32x2v*)(decay + unit * 128 + (e & 127)); const unsigned kw = *(const unsigned*)(kvt + unit * 32768 + e);
            s0 = d.x * s0 + bflo(kw); s1 = d.y * s1 + bfhi(kw); }
    }
}
__device__ __forceinline__ void gla_pass_c(const Args& a, LAS unsigned char* lds, int unit, int tid) {
    const bf16* P = (const bf16*)(a.ws + WS_P); const bf16* qtg = (const bf16*)(a.ws + WS_QT); const unsigned* oin = (const unsigned*)(a.ws + WS_OINTRA); const bf16* sint = (const bf16*)(a.ws + WS_SINT); bf16* mix = (bf16*)(a.ws + WS_MIX);
    const int bh = unit >> 6, n = unit & 63, b = bh >> 2, h = bh & 3; const size_t R0 = (size_t)b * SEQ + 64 * n;
    const int lane = tid & 63, w = __builtin_amdgcn_readfirstlane(tid >> 6), r = lane & 31, hl = lane >> 5;
    LAS float* RED = (LAS float*)lds; LAS float* RSTD = RED + 1024;
    g_f32x16 acc[2];
#pragma unroll
    for (int bi = 0; bi < 2; ++bi) { const v4u* op = (const v4u*)(oin + ((size_t)((unit * 8 + w) * 2 + bi) * 64 + lane) * 8); const v4u o0 = op[0], o1 = op[1];
#pragma unroll
        for (int e = 0; e < 4; ++e) { acc[bi][2 * e] = bflo(o0[e]); acc[bi][2 * e + 1] = bfhi(o0[e]); acc[bi][8 + 2 * e] = bflo(o1[e]); acc[bi][8 + 2 * e + 1] = bfhi(o1[e]); } }
    v4u gpre[4]; f32x4 hgv[4];
#pragma unroll
    for (int i = 0; i < 4; ++i) { const int p = tid + 512 * i; gpre[i] = *(const v4u*)(P + (R0 + (p >> 5)) * NP + C_GG + 256 * h + (p & 31) * 8); }
#pragma unroll
    for (int g4 = 0; g4 < 4; ++g4) hgv[g4] = *(const f32x4*)(a.head_g + 256 * h + 32 * w + 8 * g4 + 4 * hl);
#pragma unroll
    for (int ks = 0; ks < 8; ++ks) { const g_bf16x8 sf = *(const g_bf16x8*)(sint + ((size_t)unit * 256 + 32 * w + r) * 128 + 16 * ks + 8 * hl);
#pragma unroll
        for (int bi = 0; bi < 2; ++bi) { const g_bf16x8 qf = *(const g_bf16x8*)(qtg + (R0 + 32 * bi + r) * 512 + 128 * h + 16 * ks + 8 * hl); acc[bi] = __builtin_amdgcn_mfma_f32_32x32x16_bf16(sf, qf, acc[bi], 0, 0, 0); } }
    __syncthreads();
#pragma unroll
    for (int bi = 0; bi < 2; ++bi) { float s = 0.f;
#pragma unroll
        for (int reg = 0; reg < 16; ++reg) s += acc[bi][reg] * acc[bi][reg];
        RED[(w * 2 + hl) * 64 + 32 * bi + r] = s; }
    __syncthreads();
    if (tid < 64) { float t = 0.f;
#pragma unroll
        for (int q = 0; q < 16; ++q) t += RED[q * 64 + tid];
        RSTD[tid] = rsqrtf(t * (1.0f / 256.0f) + EPS); }
    __syncthreads();
    LAS bf16* T = (LAS bf16*)(lds + 8192);
#pragma unroll
    for (int bi = 0; bi < 2; ++bi) { const int tok = 32 * bi + r; const float rs = RSTD[tok];
#pragma unroll
        for (int g4 = 0; g4 < 4; ++g4) { const int dv0 = 32 * w + 8 * g4 + 4 * hl; const f32x4 hg = hgv[g4];
            v2u o; o.x = pk2(acc[bi][4 * g4] * rs * hg[0], acc[bi][4 * g4 + 1] * rs * hg[1]); o.y = pk2(acc[bi][4 * g4 + 2] * rs * hg[2], acc[bi][4 * g4 + 3] * rs * hg[3]);
            *(LAS v2u*)(T + tok * 264 + dv0) = o; } }
    __syncthreads();
#pragma unroll
    for (int i = 0; i < 4; ++i) { const int p = tid + 512 * i, tok = p >> 5, c8 = (p & 31) * 8; const v4u ov = *(const LAS v4u*)(T + tok * 264 + c8); const v4u gv = gpre[i]; v4u o;
#pragma unroll
        for (int e = 0; e < 4; ++e) o[e] = pk2(bflo(ov[e]) * silu_f(bflo(gv[e])), bfhi(ov[e]) * silu_f(bfhi(gv[e])));
        *(v4u*)(mix + (R0 + tok) * DM + 256 * h + c8) = o; }
}
__device__ __forceinline__ void phase_gla_c(const Args& a, LAS unsigned char* lds, int tid, int G) {
    for (int unit = blockIdx.x; unit < 512; unit += G) gla_pass_c(a, lds, unit, tid);
}
__device__ __forceinline__ void phase_final_norm(const Args& a, int tid, int G) {
    const int lane = tid & 63, wave = tid >> 6; const int gw = blockIdx.x * NWAVES + wave, NGW = G * NWAVES;
    const float* part2 = (const float*)(a.ws + WS_PART2);
    for (int m = gw; m < MROWS; m += NGW) {
        float s = (lane < 32) ? part2[(size_t)m * 32 + lane] : 0.f; s = wave_sum(s);
        const float r = rsqrtf(s * (1.0f / DM) + EPS);
        f32x4* xr = (f32x4*)(a.out + (size_t)m * DM) + lane; const f32x4* gr = (const f32x4*)a.final_g + lane;
#pragma unroll
        for (int j = 0; j < 8; ++j) { f32x4 v = xr[64 * j]; const f32x4 g = gr[64 * j]; v[0] *= r * g[0]; v[1] *= r * g[1]; v[2] *= r * g[2]; v[3] *= r * g[3]; xr[64 * j] = v; }
    }
}

constexpr int NPHASE = 11;
__global__ void __launch_bounds__(NTHR, 2) trunk_fwd(Args a) {
    extern __shared__ __attribute__((aligned(16))) unsigned char lds_raw[];
    LAS unsigned char* lds = (LAS unsigned char*)lds_raw;
    cg::grid_group grid = cg::this_grid();
    const int tid = threadIdx.x, G = gridDim.x;
    const int lo = a.ph_lo, hi = a.ph_hi;
#define IN(k) (lo <= (k) && (k) < hi)
#define SEAM(k) do { if (IN(k) && IN((k) + 1)) { if (hi > 1000) grid.sync();   xcd_barrier(bar); } } while (0)
    unsigned char* ws = a.ws;
    volatile LAS unsigned* bst = (volatile LAS unsigned*)(lds + LDS_BYTES - 16);
    if (tid < 4) bst[tid] = 0u;
    __syncthreads();
    XcdBarrier bar; bar.bar = (unsigned*)(ws + WS_BAR); bar.x = 0; bar.st = bst;
    if (hi - lo > 1) bar = xcd_barrier_post((unsigned*)(ws + WS_BAR), bst);
    if (IN(0)) { phase_prologue(a, lds, tid, G); } SEAM(0);
    if (IN(1)) {
        pg8::Gemm g{(const pg8::bf16_t*)(ws + WS_XB), (const pg8::bf16_t*)(ws + WS_WIN), MROWS, NP, DM}; pg8::StaticOrder S; S.init(MROWS, NP, G, (int)blockIdx.x);
        pg8::EpiScaleBf16 E{(pg8::bf16_t*)(ws + WS_P), NP, (const float*)(ws + WS_RSTD0), nullptr, C_SMALL / 256, (float*)(ws + WS_SMALL), (float*)(ws + WS_BAR + 20480), C_FQ / 256};
        pg8::gemm_phase<pg8::EpiScaleBf16, pg8::StaticOrder, true, true>(lds, g, S, E);
        { const int nwg = (MROWS / 256) * (NP / 256), rem = nwg % G, first = rem, nidle = G - first;
          if ((int)blockIdx.x >= first) { __syncthreads(); prologue_late(a, lds, tid, (int)blockIdx.x - first, nidle); } }
    } SEAM(1);
    if (IN(3)) { phase_m1(a, lds, tid, G); } SEAM(3);
    if (IN(4)) { phase_m2(a, lds_raw, tid, G); } SEAM(4);
    if (IN(5)) { phase_gla_c(a, lds, tid, G); } SEAM(5);
    if (IN(6)) {
        pg8::Gemm g{(const pg8::bf16_t*)(ws + WS_MIX), (const pg8::bf16_t*)(ws + WS_WOUT), MROWS, DM, DM}; pg8::StaticOrder S; S.init(MROWS, DM, G, (int)blockIdx.x);
        pg8::EpiResid E{a.x, nullptr, (pg8::bf16_t*)(ws + WS_X1), (float*)(ws + WS_PART1), DM};
        pg8::gemm_phase<pg8::EpiResid, pg8::StaticOrder, true, true>(lds, g, S, E);
    } SEAM(6);
    if (IN(7)) {
        pg8::Gemm g{(const pg8::bf16_t*)(ws + WS_X1), (const pg8::bf16_t*)(ws + WS_WCIN), MROWS, 4096, DM}; pg8::StaticOrder S; S.init(MROWS, 4096, G, (int)blockIdx.x);
        pg8::EpiScaleBf16 E{(pg8::bf16_t*)(ws + WS_UG), 4096, nullptr, (const float*)(ws + WS_PART1), -1, nullptr, nullptr, 0};
        pg8::gemm_phase<pg8::EpiScaleBf16, pg8::StaticOrder, true, true>(lds, g, S, E);
    } SEAM(7);
    if (IN(8)) { phase_s5(a, lds, tid); } SEAM(8);
    if (IN(9)) {
        pg8::Gemm g{(const pg8::bf16_t*)(ws + WS_ZB), (const pg8::bf16_t*)(ws + WS_WGLU), MROWS, DM, DM}; pg8::StaticOrder S; S.init(MROWS, DM, G, (int)blockIdx.x);
        pg8::EpiGlu E{(const pg8::bf16_t*)(ws + WS_ZB), (const pg8::bf16_t*)(ws + WS_UG), a.glu_b, (pg8::bf16_t*)(ws + WS_TB)};
        pg8::gemm_phase<pg8::EpiGlu, pg8::StaticOrder, true, true>(lds, g, S, E);
    } SEAM(9);
    if (IN(10)) {
        pg8::Gemm g{(const pg8::bf16_t*)(ws + WS_TB), (const pg8::bf16_t*)(ws + WS_WCOUT), MROWS, DM, DM}; pg8::StaticOrder S; S.init(MROWS, DM, G, (int)blockIdx.x);
        pg8::EpiFinalNorm E{(const pg8::bf16_t*)(ws + WS_X1), a.out, (float*)(ws + WS_PART2), (unsigned*)(ws + WS_BAR + 16384), a.final_g, DM};
        pg8::gemm_phase<pg8::EpiFinalNorm, pg8::StaticOrder, false, true>(lds, g, S, E);
    }
#undef IN
#undef SEAM
}

#ifndef MK_ONE_LAUNCH
#define MK_ONE_LAUNCH 1
#endif
extern "C" void kernel_launch(void* const* d_in, const int* in_sizes, int n_in, void* d_out, int out_size, void* d_ws, size_t ws_size, hipStream_t stream) {
    static int grid = 0;
    if (grid == 0) {
        int dev = 0, cus = 0, per_cu = 0;
        if (hipGetDevice(&dev) != hipSuccess || hipDeviceGetAttribute(&cus, hipDeviceAttributeMultiprocessorCount, dev) != hipSuccess) { fprintf(stderr, "kernel_launch: device query failed\n"); grid = -1; return; }
        if (hipFuncSetAttribute((const void*)trunk_fwd, hipFuncAttributeMaxDynamicSharedMemorySize, LDS_BYTES) != hipSuccess) { fprintf(stderr, "kernel_launch: hipFuncSetAttribute failed\n"); grid = -1; return; }
        if (hipOccupancyMaxActiveBlocksPerMultiprocessor(&per_cu, (const void*)trunk_fwd, NTHR, LDS_BYTES) != hipSuccess || per_cu < 1) { fprintf(stderr, "kernel_launch: occupancy query says %d\n", per_cu); per_cu = 1; }
        (void)hipGetLastError();
        grid = cus;
        if (ws_size < 256 * MiB) { fprintf(stderr, "kernel_launch: workspace too small (%zu)\n", ws_size); grid = -1; return; }
    }
    if (grid < 0) return;
    if (hipMemsetAsync((char*)d_ws + WS_BAR, 0, 24576, stream) != hipSuccess) { fprintf(stderr, "kernel_launch: memset of barrier words failed\n"); return; }
    Args a{};
    const float** ap = (const float**)&a;
    for (int i = 0; i < 22; ++i) ap[i] = (const float*)d_in[i];
    a.out = (float*)d_out; a.ws = (unsigned char*)d_ws;
#if MK_ONE_LAUNCH
    a.ph_lo = 0; a.ph_hi = NPHASE;
    void* args[] = {&a};
    hipError_t e = hipLaunchCooperativeKernel((const void*)trunk_fwd, dim3(grid), dim3(NTHR), args, LDS_BYTES, stream);
    if (e != hipSuccess) fprintf(stderr, "cooperative launch failed: %s (grid %d)\n", hipGetErrorString(e), grid);
#else
    for (int p = 0; p < NPHASE; ++p) { a.ph_lo = p; a.ph_hi = p + 1; hipLaunchKernelGGL(trunk_fwd, dim3(grid), dim3(NTHR), LDS_BYTES, stream, a); }
#endif
}
```

```cpp
#include <hip/hip_runtime.h>
#include <hip/hip_cooperative_groups.h>
#include <cstdio>
#include <cstdint>
namespace cg = cooperative_groups;
namespace pg8 {
#define PG8_LAS __attribute__((address_space(3)))
typedef unsigned short bf16_t;
typedef short bf16x8 __attribute__((ext_vector_type(8)));
typedef float f32x4 __attribute__((ext_vector_type(4)));
typedef unsigned u32x4 __attribute__((ext_vector_type(4)));
constexpr int BM = 256, BK = 64, HALF = 128, HTB = HALF * BK * 2  , STAGE_BYTES = 8 * HTB, NXCD = 8, WGM = 8;

__host__ __device__ __forceinline__ int lds_byte(int r, int c) { const int st = (r >> 4) * 2 + (c >> 5), rr = r & 15, cc = c & 31, ob = rr * 64 + cc * 2; return st * 1024 + (ob ^ (((ob >> 9) & 1) << 5)); }
__host__ __device__ __forceinline__ void stage_rc(int b, int& R, int& C) { const int st = b / 1024, sb = b % 1024, swz = sb ^ (((sb >> 9) & 1) << 5); R = (st >> 1) * 16 + swz / 64; C = (st & 1) * 32 + (swz % 64) / 2; }
__host__ __device__ __forceinline__ int perm32(int rho) { const int n = rho >> 4, i = rho & 15; return 8 * (i >> 2) + 4 * n + (i & 3); }

struct Unit { int pm, pn; };
struct Gemm { const bf16_t* A; const bf16_t* Bt; int M, N, K; };

struct StaticOrder {
    int nM, nN, nwg, G, c;
    __host__ __device__ void init(int M, int N, int G_, int c_) { nM = M / BM; nN = N / BM; nwg = nM * nN; G = G_; c = c_; }
    __host__ __device__ bool next(int i, Unit& u) const {
        const long L = (long)i * G + c; if (L >= nwg) return false;
        int wgid = (int)L; { const int q = nwg / NXCD, r = nwg % NXCD, xcd = wgid % NXCD, off = wgid / NXCD; wgid = (xcd < r ? xcd * (q + 1) : r * (q + 1) + (xcd - r) * q) + off; }
        const int nig = WGM * nN, gid = wgid / nig, fm = gid * WGM, gsz = (nM - fm) < WGM ? (nM - fm) : WGM;
        u.pm = fm + ((wgid % nig) % gsz); u.pn = (wgid % nig) / gsz; return true;
    }
    __device__ __forceinline__ void a_ready(const Unit&) const {}
    __device__ __forceinline__ void done(const Unit&) const {}
};

__device__ __forceinline__ unsigned cvt_pk_bf16(float lo, float hi) { unsigned r; asm volatile("v_cvt_pk_bf16_f32 %0, %1, %2" : "=v"(r) : "v"(lo), "v"(hi)); return r; }
typedef float f32x2 __attribute__((ext_vector_type(2)));
__device__ __forceinline__ float sigmoid_f(float x) { return __builtin_amdgcn_rcpf(1.0f + __expf(-x)); }
__device__ __forceinline__ float silu_f(float x) { return x * __builtin_amdgcn_rcpf(1.0f + __expf(-x)); }
__device__ __forceinline__ float bf2f(unsigned short b) { return __uint_as_float(((unsigned)b) << 16); }
struct EpiScaleBf16 {
    static constexpr bool PERM = true, AFTER_DRAIN = false;
    bf16_t* O; int ldc; const float* rstd; const float* part; int small_pn; float* smallbuf; float* nmax; int q_pn0;
    __device__ __forceinline__ void operator()(const f32x4 (&acc)[2][2][4][2], const Unit& u, int wr, int wc, int fr, int fq) const {
        const int row0 = u.pm * BM + wr * 64 + fr, col0 = u.pn * BM + wc * 32 + 8 * fq;
        const bool nrm = nmax != nullptr && u.pn >= q_pn0 && u.pn < q_pn0 + 8; float rmx[2] = {0.f, 0.f};
#pragma unroll
        for (int ai = 0; ai < 2; ++ai)
#pragma unroll
            for (int m = 0; m < 4; ++m) {
                const int row = row0 + ai * HALF + m * 16; float s;
                if (rstd) s = rstd[row];
                else { const f32x4 a = *(const f32x4*)(part + (size_t)row * 32 + 8 * fq), b = *(const f32x4*)(part + (size_t)row * 32 + 8 * fq + 4);
                    float t = ((a[0] + a[1]) + (a[2] + a[3])) + ((b[0] + b[1]) + (b[2] + b[3])); t += __shfl_xor(t, 16); t += __shfl_xor(t, 32); s = rsqrtf(t * (1.0f / 2048.0f) + 1e-6f); }
                bf16_t* rowp = O + (size_t)row * ldc + col0;
#pragma unroll
                for (int bj = 0; bj < 2; ++bj) { const f32x4 v0 = acc[ai][bj][m][0] * s, v1 = acc[ai][bj][m][1] * s;
                    u32x4 w; w.x = cvt_pk_bf16(v0[0], v0[1]); w.y = cvt_pk_bf16(v0[2], v0[3]); w.z = cvt_pk_bf16(v1[0], v1[1]); w.w = cvt_pk_bf16(v1[2], v1[3]);
                    *(u32x4*)(rowp + bj * HALF) = w;
                    if (nrm) { float ss = ((v0[0] * v0[0] + v0[1] * v0[1]) + (v0[2] * v0[2] + v0[3] * v0[3])) + ((v1[0] * v1[0] + v1[1] * v1[1]) + (v1[2] * v1[2] + v1[3] * v1[3])); ss += __shfl_xor(ss, 16); ss += __shfl_xor(ss, 32); rmx[bj] = fmaxf(rmx[bj], ss); }
                    if (u.pn == small_pn && bj == 0 && wc == 0) { *(f32x4*)(smallbuf + (size_t)row * 32 + 8 * fq) = v0; *(f32x4*)(smallbuf + (size_t)row * 32 + 8 * fq + 4) = v1; } }
            }
        if (nrm) { const int t = u.pn - q_pn0;
#pragma unroll
            for (int bj = 0; bj < 2; ++bj) { float r = rmx[bj]; r = fmaxf(r, __shfl_xor(r, 1)); r = fmaxf(r, __shfl_xor(r, 2)); r = fmaxf(r, __shfl_xor(r, 4)); r = fmaxf(r, __shfl_xor(r, 8));
                if (fr == 0 && fq == 0) __hip_atomic_fetch_max((unsigned*)nmax + ((((u.pm >> 4) * 8 + 2 * (t & 3) + bj) * 2 + (t >> 2)) * 4 + wc), __float_as_uint(r), __ATOMIC_RELAXED, __HIP_MEMORY_SCOPE_AGENT); } }
    }
};
struct EpiResid {
    static constexpr bool PERM = true, AFTER_DRAIN = false;
    const float* base; float* out; bf16_t* outb; float* part; int ldc;
    __device__ __forceinline__ void operator()(const f32x4 (&acc)[2][2][4][2], const Unit& u, int wr, int wc, int fr, int fq) const {
        const int row0 = u.pm * BM + wr * 64 + fr, col0 = u.pn * BM + wc * 32 + 8 * fq;
#pragma unroll
        for (int ai = 0; ai < 2; ++ai)
#pragma unroll
            for (int m = 0; m < 4; ++m) {
                const int row = row0 + ai * HALF + m * 16; const size_t off = (size_t)row * ldc + col0; float ss = 0.f;
#pragma unroll
                for (int bj = 0; bj < 2; ++bj) { const size_t o = off + bj * HALF;
                    const f32x4 v0 = acc[ai][bj][m][0] + __builtin_nontemporal_load((const f32x4*)(base + o)), v1 = acc[ai][bj][m][1] + __builtin_nontemporal_load((const f32x4*)(base + o + 4));
                    if (out) { *(f32x4*)(out + o) = v0; *(f32x4*)(out + o + 4) = v1; }
                    ss += ((v0[0] * v0[0] + v0[1] * v0[1]) + (v0[2] * v0[2] + v0[3] * v0[3])) + ((v1[0] * v1[0] + v1[1] * v1[1]) + (v1[2] * v1[2] + v1[3] * v1[3]));
                    if (outb) { u32x4 w; w.x = cvt_pk_bf16(v0[0], v0[1]); w.y = cvt_pk_bf16(v0[2], v0[3]); w.z = cvt_pk_bf16(v1[0], v1[1]); w.w = cvt_pk_bf16(v1[2], v1[3]); *(u32x4*)(outb + o) = w; } }
                ss += __shfl_xor(ss, 16); ss += __shfl_xor(ss, 32);
                if (fq == 0) part[(size_t)row * 32 + u.pn * 4 + wc] = ss;
            }
    }
};
struct EpiGlu {
    static constexpr bool PERM = true, AFTER_DRAIN = false;
    const bf16_t* zb; const bf16_t* ug; const float* bias; bf16_t* tb;
    __device__ __forceinline__ void operator()(const f32x4 (&acc)[2][2][4][2], const Unit& u, int wr, int wc, int fr, int fq) const {
        const int row0 = u.pm * BM + wr * 64 + fr, col0 = u.pn * BM + wc * 32 + 8 * fq;
#pragma unroll
        for (int ai = 0; ai < 2; ++ai)
#pragma unroll
            for (int m = 0; m < 4; ++m) {
                const int row = row0 + ai * HALF + m * 16;
#pragma unroll
                for (int bj = 0; bj < 2; ++bj) { const int col = col0 + bj * HALF;
                    const f32x4 b0 = *(const f32x4*)(bias + col), b1 = *(const f32x4*)(bias + col + 4);
                    const u32x4 zz = __builtin_nontemporal_load((const u32x4*)(zb + (size_t)row * 2048 + col)), gg = __builtin_nontemporal_load((const u32x4*)(ug + (size_t)row * 4096 + 2048 + col));
                    float r[8];
#pragma unroll
                    for (int e = 0; e < 8; ++e) { const float a = (e < 4 ? acc[ai][bj][m][0][e] : acc[ai][bj][m][1][e - 4]) + (e < 4 ? b0[e] : b1[e - 4]);
                        const unsigned zw = zz[e >> 1], gw = gg[e >> 1];
                        const float z = (e & 1) ? __uint_as_float(zw & 0xffff0000u) : __uint_as_float(zw << 16), g = (e & 1) ? __uint_as_float(gw & 0xffff0000u) : __uint_as_float(gw << 16);
                        r[e] = z * sigmoid_f(a) * silu_f(g); }
                    u32x4 w; w.x = cvt_pk_bf16(r[0], r[1]); w.y = cvt_pk_bf16(r[2], r[3]); w.z = cvt_pk_bf16(r[4], r[5]); w.w = cvt_pk_bf16(r[6], r[7]);
                    *(u32x4*)(tb + (size_t)row * 2048 + col) = w; }
            }
    }
};

struct EpiFinalNorm {
    static constexpr bool PERM = true, AFTER_DRAIN = true;
    const bf16_t* base; float* out; float* part; unsigned* cnt; const float* g; int ldc;
    __device__ __forceinline__ void fused(f32x4 (&acc)[2][2][4][2], const Unit& u, int wr, int wc, int fr, int fq, PG8_LAS unsigned char* lds, int wid, int lane) const {
        const int row0 = u.pm * BM + wr * 64 + fr, col0 = u.pn * BM + wc * 32 + 8 * fq;
#pragma unroll
        for (int ai = 0; ai < 2; ++ai)
#pragma unroll
            for (int m = 0; m < 4; ++m) { const int row = row0 + ai * HALF + m * 16; const size_t off = (size_t)row * ldc + col0; float ss = 0.f;
#pragma unroll
                for (int bj = 0; bj < 2; ++bj) { const u32x4 bw = __builtin_nontemporal_load((const u32x4*)(base + off + bj * HALF));
                    const f32x4 b0 = {__uint_as_float(bw.x << 16), __uint_as_float(bw.x & 0xffff0000u), __uint_as_float(bw.y << 16), __uint_as_float(bw.y & 0xffff0000u)};
                    const f32x4 b1 = {__uint_as_float(bw.z << 16), __uint_as_float(bw.z & 0xffff0000u), __uint_as_float(bw.w << 16), __uint_as_float(bw.w & 0xffff0000u)};
                    const f32x4 v0 = acc[ai][bj][m][0] + b0, v1 = acc[ai][bj][m][1] + b1; acc[ai][bj][m][0] = v0; acc[ai][bj][m][1] = v1;
                    ss += ((v0[0] * v0[0] + v0[1] * v0[1]) + (v0[2] * v0[2] + v0[3] * v0[3])) + ((v1[0] * v1[0] + v1[1] * v1[1]) + (v1[2] * v1[2] + v1[3] * v1[3])); }
                ss += __shfl_xor(ss, 16); ss += __shfl_xor(ss, 32);
                if (fq == 0) __hip_atomic_store((unsigned*)part + (size_t)row * 32 + u.pn * 4 + wc, __float_as_uint(ss), __ATOMIC_RELAXED, __HIP_MEMORY_SCOPE_AGENT); }
        asm volatile("s_waitcnt vmcnt(0)" ::: "memory");
        unsigned* c = cnt + 16 * u.pm;
        if (lane == 0) __hip_atomic_fetch_add(c, 1u, __ATOMIC_RELAXED, __HIP_MEMORY_SCOPE_AGENT);
        { unsigned sp = 0; while ((unsigned)__builtin_amdgcn_readfirstlane(__hip_atomic_load(c, __ATOMIC_RELAXED, __HIP_MEMORY_SCOPE_AGENT)) < 64u) { __builtin_amdgcn_s_sleep(2); if (++sp > (1u << 20)) break; } }
        asm volatile("" ::: "memory");
        f32x4 gv[2][2];
#pragma unroll
        for (int bj = 0; bj < 2; ++bj)
#pragma unroll
            for (int n = 0; n < 2; ++n) gv[bj][n] = *(const f32x4*)(g + col0 + bj * HALF + 4 * n);
#pragma unroll
        for (int ai = 0; ai < 2; ++ai)
#pragma unroll
            for (int m = 0; m < 4; ++m) { const int row = row0 + ai * HALF + m * 16; const size_t off = (size_t)row * ldc + col0;
                const unsigned long long* pp = (const unsigned long long*)part + (size_t)row * 16 + 4 * fq; float t = 0.f;
#pragma unroll
                for (int q = 0; q < 4; ++q) { const unsigned long long w2 = __hip_atomic_load(pp + q, __ATOMIC_RELAXED, __HIP_MEMORY_SCOPE_AGENT); t += __uint_as_float((unsigned)w2) + __uint_as_float((unsigned)(w2 >> 32)); }
                t += __shfl_xor(t, 16); t += __shfl_xor(t, 32);
                const float s = rsqrtf(t * (1.0f / 2048.0f) + 1e-6f);
#pragma unroll
                for (int bj = 0; bj < 2; ++bj)
#pragma unroll
                    for (int n = 0; n < 2; ++n) __builtin_nontemporal_store(acc[ai][bj][m][n] * s * gv[bj][n], (f32x4*)(out + off + bj * HALF + 4 * n)); }
    }
};
template <class Epi, class Sched, bool ALIGN_EPI = false, bool SP2 = false>
__device__ __forceinline__ void gemm_phase(PG8_LAS unsigned char* lds, const Gemm g, const Sched& S, const Epi& E) {
    const int tid = threadIdx.x, wid = __builtin_amdgcn_readfirstlane(tid >> 6), lane = tid & 63, wr = wid >> 2, wc = wid & 3, fr = lane & 15, fq = lane >> 4;
    const int K = g.K, nt = K / BK;
    unsigned voffA[2], voffB[2];
#pragma unroll
    for (int i = 0; i < 2; ++i) { int R, C; stage_rc(tid * 16 + i * 8192, R, C); const int Rb = Epi::PERM ? ((R & ~31) + perm32(R & 31)) : R;
        voffA[i] = (unsigned)(R * K + C) * 2u; voffB[i] = (unsigned)(Rb * K + C) * 2u; }
    const size_t kstep = (size_t)(BK * 2);
    const size_t hstep = (size_t)HALF * K * 2;
    const size_t tstep = 2 * hstep;
    const unsigned ldsw = (unsigned)wid * 1024u;
    const int aoff = lds_byte(wr * 64 + fr, fq * 8), boff = lds_byte(wc * 32 + fr, fq * 8);
#define PG8_SA(b, h) (((b) * 2 + (h)) * HTB)
#define PG8_SB(b, h) ((4 + (b) * 2 + (h)) * HTB)
#define PG8_STAGE(bufoff, gbase, voff) do { _Pragma("unroll") for (int _i = 0; _i < 2; ++_i) \
        __builtin_amdgcn_global_load_lds((const unsigned*)((const char*)(gbase) + (voff)[_i]), (PG8_LAS unsigned*)(lds + (bufoff) + ldsw + _i * 8192), 16, 0, 0); } while (0)
#define PG8_LDA(dst, b, h) do { _Pragma("unroll") for (int m = 0; m < 4; ++m) _Pragma("unroll") for (int k = 0; k < 2; ++k) dst[m][k] = *(const PG8_LAS bf16x8*)(lds + PG8_SA(b, h) + aoff + m * 2048 + k * 1024); } while (0)
#define PG8_LDB(dst, b, h) do { _Pragma("unroll") for (int n = 0; n < 2; ++n) _Pragma("unroll") for (int k = 0; k < 2; ++k) dst[n][k] = *(const PG8_LAS bf16x8*)(lds + PG8_SB(b, h) + boff + n * 2048 + k * 1024); } while (0)
#define PG8_MMA(ai, bj, At, Bt) do { __builtin_amdgcn_s_setprio(1); _Pragma("unroll") for (int m = 0; m < 4; ++m) _Pragma("unroll") for (int n = 0; n < 2; ++n) _Pragma("unroll") for (int k = 0; k < 2; ++k) \
        acc[ai][bj][m][n] = __builtin_amdgcn_mfma_f32_16x16x32_bf16(Bt[n][k], At[m][k], acc[ai][bj][m][n], 0, 0, 0); __builtin_amdgcn_s_setprio(0); } while (0)
#define PG8_WAIT_V(n) asm volatile("s_waitcnt vmcnt(" #n ")" ::: "memory")
#define PG8_WAIT_L(n) asm volatile("s_waitcnt lgkmcnt(" #n ")" ::: "memory")
#define PG8_BAR __builtin_amdgcn_s_barrier()
#define PG8_SCHED __builtin_amdgcn_sched_barrier(0)
    Unit cur, nxt; int ui = 0;
    if (!S.next(0, cur)) return;
    f32x4 acc[2][2][4][2];
#pragma unroll
    for (int a = 0; a < 2; ++a)
#pragma unroll
        for (int b = 0; b < 2; ++b)
#pragma unroll
            for (int m = 0; m < 4; ++m)
#pragma unroll
                for (int n = 0; n < 2; ++n) acc[a][b][m][n] = (f32x4){0.f, 0.f, 0.f, 0.f};
    bf16x8 At[4][2], B0[2][2], B1[2][2];
    const char* cA = (const char*)g.A + (size_t)cur.pm * tstep; const char* cB = (const char*)g.Bt + (size_t)cur.pn * tstep;
    S.a_ready(cur);
    if constexpr (SP2) {
        PG8_STAGE(PG8_SB(0, 0), cB, voffB); PG8_STAGE(PG8_SB(0, 1), cB + hstep, voffB); PG8_STAGE(PG8_SA(0, 0), cA, voffA); PG8_STAGE(PG8_SA(0, 1), cA + hstep, voffA);
        if (wr == 1) PG8_BAR;
        PG8_WAIT_V(2); PG8_BAR;
        PG8_STAGE(PG8_SB(1, 0), cB + kstep, voffB); PG8_STAGE(PG8_SA(1, 0), cA + kstep, voffA); PG8_STAGE(PG8_SB(1, 1), cB + hstep + kstep, voffB);
        PG8_WAIT_V(6); PG8_BAR;
    } else {
        PG8_STAGE(PG8_SB(0, 0), cB, voffB); PG8_STAGE(PG8_SA(0, 0), cA, voffA); PG8_STAGE(PG8_SB(0, 1), cB + hstep, voffB); PG8_STAGE(PG8_SA(0, 1), cA + hstep, voffA);
        if (wr == 1) PG8_BAR;
        PG8_WAIT_V(4); PG8_BAR;
        PG8_STAGE(PG8_SB(1, 0), cB + kstep, voffB); PG8_STAGE(PG8_SA(1, 0), cA + kstep, voffA); PG8_STAGE(PG8_SB(1, 1), cB + hstep + kstep, voffB);
        PG8_WAIT_V(6); PG8_BAR;
    }
    for (;;) {
        const bool has_next = S.next(ui + 1, nxt);
        const char* nA = has_next ? (const char*)g.A + (size_t)nxt.pm * tstep : cA; const char* nB = has_next ? (const char*)g.Bt + (size_t)nxt.pn * tstep : cB;
        for (int t = 0; t < nt; t += 2) {
            const bool last = (t == nt - 2);
            const char* a1 = cA + (size_t)(t + 1) * kstep;
            const char* a2 = last ? nA : cA + (size_t)(t + 2) * kstep; const char* b2 = last ? nB : cB + (size_t)(t + 2) * kstep;
            const char* a3 = a2 + kstep; const char* b3 = b2 + kstep;
            if (last && has_next) S.a_ready(nxt);
            if constexpr (SP2) {
            PG8_LDB(B0, 0, 0); PG8_LDB(B1, 0, 1); PG8_SCHED; PG8_LDA(At, 0, 0); PG8_STAGE(PG8_SA(1, 1), a1 + hstep, voffA);
            PG8_WAIT_V(8); PG8_WAIT_L(0); PG8_BAR; PG8_MMA(0, 0, At, B0); PG8_MMA(0, 1, At, B1); PG8_BAR; PG8_SCHED;
            PG8_LDA(At, 0, 1); PG8_STAGE(PG8_SB(0, 0), b2, voffB); PG8_STAGE(PG8_SB(0, 1), b2 + hstep, voffB); PG8_STAGE(PG8_SA(0, 0), a2, voffA);
            PG8_WAIT_V(8); PG8_WAIT_L(0); PG8_BAR; PG8_MMA(1, 0, At, B0); PG8_MMA(1, 1, At, B1); PG8_BAR; PG8_SCHED;
            PG8_LDB(B0, 1, 0); PG8_LDB(B1, 1, 1); PG8_SCHED; PG8_LDA(At, 1, 0); PG8_STAGE(PG8_SA(0, 1), a2 + hstep, voffA);
            PG8_WAIT_V(8); PG8_WAIT_L(0); PG8_BAR; PG8_MMA(0, 0, At, B0); PG8_MMA(0, 1, At, B1); PG8_BAR; PG8_SCHED;
            PG8_LDA(At, 1, 1); PG8_STAGE(PG8_SB(1, 0), b3, voffB); PG8_STAGE(PG8_SB(1, 1), b3 + hstep, voffB); PG8_STAGE(PG8_SA(1, 0), a3, voffA);
            PG8_WAIT_V(8); PG8_WAIT_L(0); PG8_BAR; PG8_MMA(1, 0, At, B0); PG8_MMA(1, 1, At, B1); PG8_BAR; PG8_SCHED;
            } else {
            PG8_LDB(B0, 0, 0); PG8_SCHED; PG8_LDA(At, 0, 0); PG8_STAGE(PG8_SA(1, 1), a1 + hstep, voffA);
            PG8_WAIT_L(8); PG8_BAR; PG8_WAIT_L(0); PG8_MMA(0, 0, At, B0); PG8_BAR; PG8_SCHED;
            PG8_LDB(B1, 0, 1); PG8_STAGE(PG8_SB(0, 0), b2, voffB);
            PG8_BAR; PG8_WAIT_L(0); PG8_MMA(0, 1, At, B1); PG8_BAR;
            PG8_LDA(At, 0, 1); PG8_STAGE(PG8_SA(0, 0), a2, voffA);
            PG8_BAR; PG8_WAIT_L(0); PG8_MMA(1, 0, At, B0); PG8_BAR; PG8_SCHED;
            PG8_STAGE(PG8_SB(0, 1), b2 + hstep, voffB);
            PG8_WAIT_V(6); PG8_BAR; PG8_MMA(1, 1, At, B1); PG8_BAR;
            PG8_LDB(B0, 1, 0); PG8_SCHED; PG8_LDA(At, 1, 0); PG8_STAGE(PG8_SA(0, 1), a2 + hstep, voffA);
            PG8_WAIT_L(8); PG8_BAR; PG8_WAIT_L(0); PG8_MMA(0, 0, At, B0); PG8_BAR; PG8_SCHED;
            PG8_LDB(B1, 1, 1); PG8_STAGE(PG8_SB(1, 0), b3, voffB);
            PG8_BAR; PG8_WAIT_L(0); PG8_MMA(0, 1, At, B1); PG8_BAR;
            PG8_LDA(At, 1, 1); PG8_STAGE(PG8_SA(1, 0), a3, voffA);
            PG8_BAR; PG8_WAIT_L(0); PG8_MMA(1, 0, At, B0); PG8_BAR; PG8_SCHED;
            PG8_STAGE(PG8_SB(1, 1), b3 + hstep, voffB);
            PG8_WAIT_V(6); PG8_BAR; PG8_MMA(1, 1, At, B1); PG8_BAR;
            }
        }
        if constexpr (ALIGN_EPI) { if (wr == 0) PG8_BAR; }
        if constexpr (!Epi::AFTER_DRAIN) { E(acc, cur, wr, wc, fr, fq); S.done(cur); }
        if (!has_next) break;
#pragma unroll
        for (int a = 0; a < 2; ++a)
#pragma unroll
            for (int b = 0; b < 2; ++b)
#pragma unroll
                for (int m = 0; m < 4; ++m)
#pragma unroll
                    for (int n = 0; n < 2; ++n) acc[a][b][m][n] = (f32x4){0.f, 0.f, 0.f, 0.f};
        cur = nxt; cA = nA; cB = nB; ++ui;
        if constexpr (ALIGN_EPI) { if (wr == 1) PG8_BAR; }
    }
    PG8_WAIT_V(0);
    if constexpr (!ALIGN_EPI) { if (wr == 0) PG8_BAR; }
    PG8_BAR;
    if constexpr (Epi::AFTER_DRAIN) { E.fused(acc, cur, wr, wc, fr, fq, lds, wid, lane); S.done(cur); }
#undef PG8_SA
#undef PG8_SB
#undef PG8_STAGE
#undef PG8_LDA
#undef PG8_LDB
#undef PG8_MMA
#undef PG8_WAIT_V
#undef PG8_WAIT_L
#undef PG8_BAR
#undef PG8_SCHED
}
}
#define LAS __attribute__((address_space(3)))
typedef unsigned short bf16;
typedef float f32x4 __attribute__((ext_vector_type(4)));
typedef unsigned v4u __attribute__((ext_vector_type(4)));
typedef unsigned v2u __attribute__((ext_vector_type(2)));
constexpr int NWAVES = 8, NTHR = 512;
constexpr int BATCH = 2, SEQ = 4096, DM = 2048, MROWS = BATCH * SEQ;
constexpr int NP = 7424;
constexpr int C_GQ = 0, C_GK = 512, C_GV = 1024, C_GG = 2048, C_FQ = 3072, C_FK = 4096, C_FV = 5120, C_FG = 6144, C_SMALL = 7168;
constexpr int AB_IN = 7192;
constexpr float EPS = 1e-6f;
constexpr size_t MiB = 1u << 20;
constexpr size_t WS_RSTD0 = 0, WS_PART1 = 64 * 1024, WS_PART2 = WS_PART1 + MiB, WS_CFOX = 2 * MiB + 512 * 1024, WS_SMALL = 3 * MiB  ;
constexpr size_t WS_WGLU = 4 * MiB, WS_WCOUT = 12 * MiB, WS_WCIN = 20 * MiB, WS_WOUT = 36 * MiB, WS_WIN = 44 * MiB;
constexpr size_t WS_XB = 73 * MiB, WS_MIX = 73 * MiB, WS_ZB = 73 * MiB;
constexpr size_t WS_P = 105 * MiB, WS_X1 = 105 * MiB, WS_UG = 169 * MiB;
constexpr size_t WS_ORAW = 221 * MiB;
constexpr size_t WS_TB = 20 * MiB;
constexpr int LDS_BYTES = 163840;

struct Args {
    const float* x; const float* ab_norm_g; const float* ab_w_in; const float* alpha_up; const float* alpha_b; const float* head_g; const float* fox_f_b; const float* ab_w_out;
    const float* c_norm_g; const float* c_w_in; const float* lam_re; const float* lam_im; const float* log_step; const float* b_re; const float* b_im; const float* c_re; const float* c_im;
    const float* s5_d; const float* glu_w; const float* glu_b; const float* c_w_out; const float* final_g;
    float* out; unsigned char* ws; int ph_lo, ph_hi;
};

typedef float cv_f32x2 __attribute__((ext_vector_type(2))); typedef __bf16 cv_bf16x2 __attribute__((ext_vector_type(2)));
__device__ __forceinline__ unsigned pk2(float lo, float hi) { cv_f32x2 v = {lo, hi}; cv_bf16x2 b = __builtin_convertvector(v, cv_bf16x2); return __builtin_bit_cast(unsigned, b); }
__device__ __forceinline__ unsigned f2bf(float f) { return pk2(f, f) & 0xffffu; }
__device__ __forceinline__ float bflo(unsigned w) { return __uint_as_float(w << 16); }
__device__ __forceinline__ float bfhi(unsigned w) { return __uint_as_float(w & 0xffff0000u); }
__device__ __forceinline__ float bf2f(bf16 b) { return __uint_as_float(((unsigned)b) << 16); }
__device__ __forceinline__ float wave_sum(float v) {
#pragma unroll
    for (int o = 1; o < 64; o <<= 1) v += __shfl_xor(v, o);
    return v;
}
__device__ __forceinline__ float silu_f(float x) { return x * __builtin_amdgcn_rcpf(1.0f + __expf(-x)); }
__device__ __forceinline__ float logsigmoid_f(float z) { return fminf(z, 0.f) - __logf(1.0f + __expf(-fabsf(z))); }
__device__ __forceinline__ float gelu_tanh(float y) { const float y2 = y * y; const float a2 = y * (-2.3022082f - 0.10294324f * y2); return y * __builtin_amdgcn_rcpf(1.0f + __builtin_amdgcn_exp2f(a2)); }

struct TrItem { const float* W; bf16* WT; const float* gk; int Nsrc, srcc, dstr, kb; };
__device__ __forceinline__ void tr_load(const TrItem& t, f32x4 (&v)[16], int lane) {
    const int k0 = 64 * t.kb, c4 = (lane & 15) * 4, kr = lane >> 4;
#pragma unroll
    for (int i = 0; i < 16; ++i) v[i] = __builtin_nontemporal_load((const f32x4*)(t.W + (size_t)(k0 + 4 * i + kr) * t.Nsrc + t.srcc + c4));
}
template <bool NT>
__device__ __forceinline__ void tr_store(const TrItem& t, const f32x4 (&v)[16], LAS float* scr, int lane) {
    const int K = DM, k0 = 64 * t.kb, c4 = (lane & 15) * 4, kr = lane >> 4;
#pragma unroll
    for (int i = 0; i < 16; ++i) { const int kk = 4 * i + kr; const float s = t.gk ? t.gk[k0 + kk] : 1.0f; LAS float* d = scr + kk * 65 + c4; d[0] = v[i][0] * s; d[1] = v[i][1] * s; d[2] = v[i][2] * s; d[3] = v[i][3] * s; }
    asm volatile("s_waitcnt lgkmcnt(0)" ::: "memory");
    const int c = lane & 7;
#pragma unroll
    for (int j = 0; j < 8; ++j) { const int n = (lane >> 3) + 8 * j; const LAS float* s = scr + (8 * c) * 65 + n;
        v4u o; o.x = pk2(s[0 * 65], s[1 * 65]); o.y = pk2(s[2 * 65], s[3 * 65]); o.z = pk2(s[4 * 65], s[5 * 65]); o.w = pk2(s[6 * 65], s[7 * 65]);
        if constexpr (NT) __builtin_nontemporal_store(o, (v4u*)(t.WT + (size_t)(t.dstr + n) * K + k0 + 8 * c)); else *(v4u*)(t.WT + (size_t)(t.dstr + n) * K + k0 + 8 * c) = o; }
    asm volatile("s_waitcnt lgkmcnt(0)" ::: "memory");
}
__device__ __forceinline__ TrItem tr_decode_late(const Args& a, int r) {
    constexpr int I_OUT = 32 * 32, I_CIN = 32 * 64, I_GLU = 32 * 32;
    TrItem t;
    if (r < I_OUT) { t.W = a.ab_w_out; t.WT = (bf16*)(a.ws + WS_WOUT); t.gk = nullptr; t.Nsrc = DM; t.srcc = t.dstr = 64 * (r % 32); t.kb = r / 32; return t; } r -= I_OUT;
    if (r < I_CIN) { t.W = a.c_w_in; t.WT = (bf16*)(a.ws + WS_WCIN); t.gk = a.c_norm_g; t.Nsrc = 4096; t.srcc = t.dstr = 64 * (r % 64); t.kb = r / 64; return t; } r -= I_CIN;
    if (r < I_GLU) { t.W = a.glu_w; t.WT = (bf16*)(a.ws + WS_WGLU); t.gk = nullptr; t.Nsrc = DM; t.srcc = t.dstr = 64 * (r % 32); t.kb = r / 32; return t; } r -= I_GLU;
    t.W = a.c_w_out; t.WT = (bf16*)(a.ws + WS_WCOUT); t.gk = nullptr; t.Nsrc = DM; t.srcc = t.dstr = 64 * (r % 32); t.kb = r / 32; return t;
}
__device__ __forceinline__ TrItem tr_decode_in(const Args& a, int r) {
    TrItem t; const int nb = r % 112, d0 = 64 * nb;
    t.W = a.ab_w_in; t.WT = (bf16*)(a.ws + WS_WIN); t.gk = a.ab_norm_g; t.Nsrc = AB_IN; t.srcc = d0 + (d0 < 2048 ? 0 : (d0 < 6144 ? 16 : 24)); t.dstr = d0; t.kb = r / 112; return t;
}
__device__ __forceinline__ void prologue_late(const Args& a, LAS unsigned char* lds, int tid, int widx, int nidle) {
    const int lane = tid & 63, wave = tid >> 6; LAS float* scr = (LAS float*)(lds + wave * 16640);
    constexpr int NIT = 32 * 32 * 3 + 32 * 64; const int st = nidle * NWAVES;
    int it = widx * NWAVES + wave; if (it >= NIT) return;
    TrItem cur = tr_decode_late(a, it); f32x4 v[16]; tr_load(cur, v, lane);
    for (;;) { const int nx = it + st; const bool more = nx < NIT; TrItem nt = cur; f32x4 vn[16];
        if (more) { nt = tr_decode_late(a, nx); tr_load(nt, vn, lane); }
        tr_store<false>(cur, v, scr, lane);
        if (!more) break;
#pragma unroll
        for (int i = 0; i < 16; ++i) v[i] = vn[i];
        cur = nt; it = nx; }
}
__device__ __forceinline__ void phase_prologue(const Args& a, LAS unsigned char* lds, int tid, int G) {
    const int lane = tid & 63, wave = tid >> 6;
    LAS float* scr = (LAS float*)(lds + wave * 16640);
    const int gw = blockIdx.x * NWAVES + wave, NGW = G * NWAVES;
    bf16* WinT = (bf16*)(a.ws + WS_WIN);
    constexpr int NITEMS = 32 * (7168 / 64);
    if (gw < NITEMS) { int it = gw; TrItem cur = tr_decode_in(a, it); f32x4 v[16]; tr_load(cur, v, lane);
        for (;;) { const int nx = it + NGW; const bool more = nx < NITEMS; TrItem nt = cur; f32x4 vn[16];
            if (more) { nt = tr_decode_in(a, nx); tr_load(nt, vn, lane); }
            tr_store<false>(cur, v, scr, lane);
            if (!more) break;
#pragma unroll
            for (int i = 0; i < 16; ++i) v[i] = vn[i];
            cur = nt; it = nx; } }
    for (int idx = blockIdx.x * NTHR + tid; idx < 256 * DM; idx += G * NTHR) {
        const int rr = idx / DM, k = idx % DM; float w = 0.f;
        if (rr < 16) w = a.ab_w_in[(size_t)k * AB_IN + 2048 + rr] * a.ab_norm_g[k];
        else if (rr < 24) w = a.ab_w_in[(size_t)k * AB_IN + 6160 + (rr - 16)] * a.ab_norm_g[k];
        WinT[(size_t)(C_SMALL + rr) * DM + k] = (bf16)f2bf(w);
    }
    bf16* xb = (bf16*)(a.ws + WS_XB); float* rstd0 = (float*)(a.ws + WS_RSTD0);
    for (int m0 = gw; m0 < MROWS; m0 += 2 * NGW) {
        const int m1 = m0 + NGW; const bool has1 = m1 < MROWS; const int m1c = has1 ? m1 : m0;
        const f32x4* xr0 = (const f32x4*)(a.x + (size_t)m0 * DM) + lane; const f32x4* xr1 = (const f32x4*)(a.x + (size_t)m1c * DM) + lane;
        f32x4 v0[8], v1[8];
#pragma unroll
        for (int j = 0; j < 8; ++j) v0[j] = __builtin_nontemporal_load(xr0 + 64 * j);
#pragma unroll
        for (int j = 0; j < 8; ++j) v1[j] = __builtin_nontemporal_load(xr1 + 64 * j);
        float s0 = 0.f, s1 = 0.f;
#pragma unroll
        for (int j = 0; j < 8; ++j) { s0 += (v0[j][0] * v0[j][0] + v0[j][1] * v0[j][1]) + (v0[j][2] * v0[j][2] + v0[j][3] * v0[j][3]); s1 += (v1[j][0] * v1[j][0] + v1[j][1] * v1[j][1]) + (v1[j][2] * v1[j][2] + v1[j][3] * v1[j][3]); }
        s0 = wave_sum(s0); s1 = wave_sum(s1);
        if (lane == 0) { rstd0[m0] = rsqrtf(s0 * (1.0f / DM) + EPS); if (has1) rstd0[m1] = rsqrtf(s1 * (1.0f / DM) + EPS); }
        v2u* o0 = (v2u*)(xb + (size_t)m0 * DM) + lane; v2u* o1 = (v2u*)(xb + (size_t)m1c * DM) + lane;
#pragma unroll
        for (int j = 0; j < 8; ++j) { v2u w; w.x = pk2(v0[j][0], v0[j][1]); w.y = pk2(v0[j][2], v0[j][3]); o0[64 * j] = w; }
        if (has1) {
#pragma unroll
            for (int j = 0; j < 8; ++j) { v2u w; w.x = pk2(v1[j][0], v1[j][1]); w.y = pk2(v1[j][2], v1[j][3]); o1[64 * j] = w; } }
    }
}

__device__ __forceinline__ void phase_fox_cumsum(const Args& a, LAS unsigned char* lds, int tid, int G) {
    if (blockIdx.x >= 16) return;
    const int bh = blockIdx.x, b = bh >> 3, h = bh & 7, lane = tid & 63, wave = tid >> 6; const float fb = a.fox_f_b[h];
    const float* small = (const float*)(a.ws + WS_SMALL); float* cf = (float*)(a.ws + WS_CFOX) + (size_t)bh * SEQ; LAS float* WT = (LAS float*)lds;
    float v[8]; float run = 0.f;
#pragma unroll
    for (int i = 0; i < 8; ++i) { run += logsigmoid_f(small[(size_t)(b * SEQ + tid * 8 + i) * 32 + 16 + h] + fb); v[i] = run; }
    float inc = run;
#pragma unroll
    for (int o = 1; o < 64; o <<= 1) { const float n = __shfl_up(inc, o); if (lane >= o) inc += n; }
    if (lane == 63) WT[wave] = inc;
    __syncthreads();
    float base = inc - run;
    for (int w = 0; w < wave; ++w) base += WT[w];
#pragma unroll
    for (int i = 0; i < 8; ++i) cf[tid * 8 + i] = base + v[i];
}

#define XB_TMO      128
#define XB_XCNT(j)  (256  + 64 * (j))
#define XB_XSUB(j)  (1280 + 64 * (j))
#define XB_XGEN(j)  (2304 + 64 * (j))
#define XB_TOP      3328
#define XB_TOPGEN   3392
#define XCD_BAR_WORDS 3456
#define XB_SPIN_CAP (1u << 18)

__device__ __forceinline__ unsigned xb_ld(unsigned* p)              { return __hip_atomic_load(p, __ATOMIC_RELAXED, __HIP_MEMORY_SCOPE_AGENT); }
__device__ __forceinline__ unsigned xb_add(unsigned* p, unsigned v) { return __hip_atomic_fetch_add(p, v, __ATOMIC_RELAXED, __HIP_MEMORY_SCOPE_AGENT); }
__device__ __forceinline__ unsigned xb_xcc_id() { return (unsigned)__builtin_amdgcn_s_getreg((3 << 11) | 20) & 0xFu; }
#define XB_SPIN(cond, bar) do { unsigned _sp = 0; while (cond) { __builtin_amdgcn_s_sleep(1); \
    if ((++_sp & 255u) == 0u) { if (xb_ld(&(bar)[XB_TMO])) break; if (_sp > XB_SPIN_CAP) { atomicAdd(&(bar)[XB_TMO], 1u); break; } } } } while (0)

struct XcdBarrier {
    unsigned* bar; unsigned x;
    volatile LAS unsigned* st;
};

__device__ __forceinline__ XcdBarrier xcd_barrier_post(unsigned* bar, volatile LAS unsigned* st) {
    XcdBarrier b; b.bar = bar; b.x = xb_xcc_id(); b.st = st;
    if (threadIdx.x == 0) (void)xb_add(&bar[XB_XCNT(b.x)], 1u);
    return b;
}
__device__ __forceinline__ void xcd_barrier_complete(unsigned* bar, unsigned x, unsigned& nloc, unsigned& nx) {
    const unsigned G = gridDim.x * gridDim.y * gridDim.z;
    unsigned sum, cnt, mine, sp = 0u;
    for (;;) {
        sum = 0u; cnt = 0u; mine = 0u;
#pragma unroll
        for (unsigned j = 0; j < 16; ++j) { const unsigned c = xb_ld(&bar[XB_XCNT(j)]); sum += c; cnt += (c > 0u) ? 1u : 0u; mine = (j == x) ? c : mine; }
        if (sum == G) break;
        __builtin_amdgcn_s_sleep(1);
        if ((++sp & 255u) == 0u) { if (xb_ld(&bar[XB_TMO])) break; if (sp > XB_SPIN_CAP) { atomicAdd(&bar[XB_TMO], 1u); break; } }
    }
    nloc = mine > 0u ? mine : 1u; nx = cnt > 0u ? cnt : 1u;
}

__device__ __forceinline__ void xcd_barrier(const XcdBarrier& b) {
    asm volatile("s_waitcnt vmcnt(0)" ::: "memory");
    __syncthreads();
    if (threadIdx.x == 0) {
        unsigned* bar = b.bar;
        __builtin_amdgcn_s_waitcnt(0);
        unsigned nloc = b.st[0], nx = b.st[1];
        if (nloc == 0u) { xcd_barrier_complete(bar, b.x, nloc, nx); b.st[0] = nloc; b.st[1] = nx; }
        const unsigned old = xb_add(&bar[XB_XSUB(b.x)], 1u);
        const unsigned gen = old / nloc;
        if (old + 1u == (gen + 1u) * nloc) {
            __builtin_amdgcn_fence(__ATOMIC_RELEASE, "agent");
            asm volatile("s_waitcnt vmcnt(0)" ::: "memory");
            const unsigned og = xb_add(&bar[XB_TOP], 1u);
            const unsigned tg = og / nx;
            if (og + 1u == (tg + 1u) * nx) xb_add(&bar[XB_TOPGEN], 1u);
            else XB_SPIN(xb_ld(&bar[XB_TOPGEN]) == tg, bar);
            __builtin_amdgcn_fence(__ATOMIC_ACQUIRE, "agent");
            xb_add(&bar[XB_XGEN(b.x)], 1u);
            asm volatile("s_waitcnt vmcnt(0)" ::: "memory");
        } else {
            XB_SPIN(xb_ld(&bar[XB_XGEN(b.x)]) == gen, bar);
            __builtin_amdgcn_fence(__ATOMIC_ACQUIRE, "agent");
            asm volatile("s_waitcnt vmcnt(0)" ::: "memory");
        }
    }
    __syncthreads();
}


constexpr size_t WS_BAR = 40 * 1024;
namespace fox {
constexpr int D = 128, KVS = 7424, OS = 2048, WINDOW = 4096; constexpr float THR = 8.f; constexpr bool WSKIP = false;
constexpr float SCALE = 0.08838834764831845f;
constexpr int NW = 8, QBLK = 32, KVBLK = 64, QB = NW * QBLK;
constexpr int SHM_V = KVBLK * D * 2, SHM_K = KVBLK * D * 2;
constexpr int LDS_BYTES = 2 * SHM_V + 2 * SHM_K + NW * 64 * 4;


using bf16 = unsigned short;
typedef short bf16x8 __attribute__((ext_vector_type(8)));
typedef short s16x4 __attribute__((ext_vector_type(4)));
typedef float f32x16 __attribute__((ext_vector_type(16)));
typedef float f32x4 __attribute__((ext_vector_type(4)));
typedef unsigned u32x4 __attribute__((ext_vector_type(4)));
template <class A, class Bt> struct same_t { static constexpr bool v = false; };
template <class A> struct same_t<A, A> { static constexpr bool v = true; };

#define KSWZ(row, colB) ((row) * 256 + ((colB) ^ (((row) & 7) << 4)))
#define SBAR() __builtin_amdgcn_sched_barrier(0)
__device__ __forceinline__ int v_st(int k, int c) { const int kk = (k & ~0xC) | ((k & 4) << 1) | ((k & 8) >> 1); return ((kk >> 3) * 4 + (c >> 5)) * 512 + ((kk & 7) * 32 + (c & 31)) * 2; }
__device__ __forceinline__ int v_rd_base(int lane) { return ((lane & 3) << 3) | (((lane >> 2) & 3) << 6) | (((lane >> 4) & 1) << 5) | (((lane >> 5) & 1) << 8); }
constexpr int v_rd_off(int d0, int ks, int half) { return d0 * 512 + ks * 4096 + half * 2048; }
__device__ __forceinline__ int crow(int r, int hi) { return (r & 3) + 8 * (r >> 2) + 4 * hi; }
__device__ __forceinline__ unsigned cvtpk(float lo, float hi) {
    unsigned r; asm volatile("v_cvt_pk_bf16_f32 %0, %1, %2" : "=v"(r) : "v"(lo), "v"(hi)); return r;
}
__device__ __forceinline__ bf16x8 pack8(f32x4 a, f32x4 b) {
    u32x4 w = {cvtpk(a[0], a[1]), cvtpk(a[2], a[3]), cvtpk(b[0], b[1]), cvtpk(b[2], b[3])};
    return *reinterpret_cast<bf16x8*>(&w);
}
template <class T> __device__ __forceinline__ bf16x8 load8(const T* p) {
    if constexpr (same_t<T, float>::v) { return pack8(*(const f32x4*)p, *(const f32x4*)(p + 4)); }
    else { return *reinterpret_cast<const bf16x8*>(p); }
}
typedef __attribute__((address_space(3))) float lds_f32; typedef __attribute__((address_space(3))) f32x4 lds_f32x4;
__device__ __forceinline__ void bias_tile(f32x16& p0, f32x16& p1, const lds_f32* cbk, int hi) {
    const lds_f32* cb0 = cbk + 4 * hi;
#pragma unroll
    for (int g_ = 0; g_ < 4; ++g_) { const f32x4 b0_ = *(const lds_f32x4*)(cb0 + 8 * g_), b1_ = *(const lds_f32x4*)(cb0 + 32 + 8 * g_);
        p0[4 * g_] += b0_[0]; p0[4 * g_ + 1] += b0_[1]; p0[4 * g_ + 2] += b0_[2]; p0[4 * g_ + 3] += b0_[3]; p1[4 * g_] += b1_[0]; p1[4 * g_ + 1] += b1_[1]; p1[4 * g_ + 2] += b1_[2]; p1[4 * g_ + 3] += b1_[3]; }
}
__device__ __forceinline__ void mask_tile(f32x16& p0, f32x16& p1, int dq, unsigned W) {
    const float NEG = -__builtin_inff();
#pragma unroll
    for (int r = 0; r < 16; ++r) {
        const int c = (r & 3) + 8 * (r >> 2);
        if ((unsigned)(dq - c) >= W) p0[r] = NEG;
        if ((unsigned)(dq - c - 32) >= W) p1[r] = NEG;
    }
}
__device__ __forceinline__ void partialSM(f32x16& p0, f32x16& p1, float& m_reg, float& mn, float& alpha) {
    float pmax = p0[0]; for (int r = 1; r < 16; ++r) pmax = fmaxf(pmax, p0[r]); for (int r = 0; r < 16; ++r) pmax = fmaxf(pmax, p1[r]);
    { auto rr = __builtin_amdgcn_permlane32_swap(__float_as_uint(pmax), __float_as_uint(pmax), false, false);
      pmax = fmaxf(__uint_as_float(rr[0]), __uint_as_float(rr[1])); }
    constexpr float C2 = 1.4426950408889634f * SCALE;
    if (__builtin_expect(__all((pmax - m_reg) * SCALE <= THR), 1)) { mn = m_reg; alpha = 1.f; }
    else { mn = fmaxf(m_reg, pmax); alpha = __builtin_amdgcn_exp2f((m_reg - mn) * C2); m_reg = mn; }
    const float mnL = -mn * C2;
    for (int r = 0; r < 16; ++r) p0[r] = fmaf(p0[r], C2, mnL); for (int r = 0; r < 16; ++r) p1[r] = fmaf(p1[r], C2, mnL);
    for (int r = 0; r < 16; ++r) p0[r] = __builtin_amdgcn_exp2f(p0[r]);
}
__device__ __forceinline__ void finishSM(f32x16& p0, f32x16& p1, float alpha, float& l_reg, bf16x8& pa0, bf16x8& pa1, bf16x8& pa2, bf16x8& pa3) {
    for (int r = 0; r < 16; ++r) p1[r] = __builtin_amdgcn_exp2f(p1[r]);
    float ps = 0; for (int r = 0; r < 16; ++r) ps += p0[r]; for (int r = 0; r < 16; ++r) ps += p1[r];
    { auto rr = __builtin_amdgcn_permlane32_swap(__float_as_uint(ps), __float_as_uint(ps), false, false);
      ps = __uint_as_float(rr[0]) + __uint_as_float(rr[1]); }
    l_reg = l_reg * alpha + ps;
#define PK4(P, B_, OUT) do { unsigned a0 = cvtpk(P[B_+0], P[B_+1]), a1 = cvtpk(P[B_+2], P[B_+3]);                          \
        unsigned b0 = cvtpk(P[B_+4], P[B_+5]), b1 = cvtpk(P[B_+6], P[B_+7]);                                             \
        auto r0 = __builtin_amdgcn_permlane32_swap(a0, b0, false, false); auto r1 = __builtin_amdgcn_permlane32_swap(a1, b1, false, false); \
        u32x4 w = {r0[0], r1[0], r0[1], r1[1]}; OUT = *reinterpret_cast<bf16x8*>(&w); } while (0)
    PK4(p0, 0, pa0); PK4(p0, 8, pa1); PK4(p1, 0, pa2); PK4(p1, 8, pa3);
#undef PK4
}
typedef __attribute__((address_space(3))) bf16x8 lds_bf16x8;
constexpr int QLDS_OFF = LDS_BYTES + 16384, QLDS_ROW = 272;
template <int KB, bool SK>
__device__ __forceinline__ void qkt(f32x16& p0, f32x16& p1, const char* K_lds, int r32, int hi, const lds_bf16x8* qp, bool act) {
    if (SK && !act) { const float NEG = -__builtin_inff();
#pragma unroll
        for (int r = 0; r < 16; ++r) { p0[r] = NEG; p1[r] = NEG; } return; }
    p0 = f32x16{}; p1 = f32x16{};
    const char* kb[4];
#pragma unroll
    for (int dd = 0; dd < 4; ++dd) kb[dd] = K_lds + KB * SHM_K + KSWZ(r32, (dd * 16 + hi * 8) * 2);
#pragma unroll
    for (int d0 = 0; d0 < 8; ++d0) { const char* a = kb[d0 & 3] + (d0 >> 2) * 128;
        bf16x8 b0 = *reinterpret_cast<const bf16x8*>(a);
        bf16x8 b1 = *reinterpret_cast<const bf16x8*>(a + 32 * 256); const bf16x8 qf = qp[2 * d0];
        p0 = __builtin_amdgcn_mfma_f32_32x32x16_bf16(b0, qf, p0, 0, 0, 0);
        p1 = __builtin_amdgcn_mfma_f32_32x32x16_bf16(b1, qf, p1, 0, 0, 0); }
}
template <int VB, bool SK>
__device__ __forceinline__ void pv_tile(f32x16* o, int vb0, bf16x8 pa0, bf16x8 pa1, bf16x8 pa2, bf16x8 pa3, bool act) {
    if (SK && !act) return;
#define TRRD(dst, off) asm volatile("ds_read_b64_tr_b16 %0, %1 offset:%2" : "=&v"(dst) : "v"(vb0), "i"(off) : "memory")
#define PV_D0(d0) do { s16x4 l0, l1, l2, l3, h0, h1, h2, h3; constexpr int b_ = VB * SHM_V + v_rd_off(d0, 0, 0);     \
        TRRD(l0, b_); TRRD(h0, b_ + 2048); TRRD(l1, b_ + 4096); TRRD(h1, b_ + 6144); TRRD(l2, b_ + 8192); TRRD(h2, b_ + 10240); TRRD(l3, b_ + 12288); TRRD(h3, b_ + 14336); \
        asm volatile("s_waitcnt lgkmcnt(0)" ::: "memory"); SBAR();                 \
        o[d0] = __builtin_amdgcn_mfma_f32_32x32x16_bf16(pa0, (bf16x8){l0[0], l0[1], l0[2], l0[3], h0[0], h0[1], h0[2], h0[3]}, o[d0], 0, 0, 0);   \
        o[d0] = __builtin_amdgcn_mfma_f32_32x32x16_bf16(pa1, (bf16x8){l1[0], l1[1], l1[2], l1[3], h1[0], h1[1], h1[2], h1[3]}, o[d0], 0, 0, 0);   \
        o[d0] = __builtin_amdgcn_mfma_f32_32x32x16_bf16(pa2, (bf16x8){l2[0], l2[1], l2[2], l2[3], h2[0], h2[1], h2[2], h2[3]}, o[d0], 0, 0, 0);   \
        o[d0] = __builtin_amdgcn_mfma_f32_32x32x16_bf16(pa3, (bf16x8){l3[0], l3[1], l3[2], l3[3], h3[0], h3[1], h3[2], h3[3]}, o[d0], 0, 0, 0); } while (0)
    PV_D0(0); PV_D0(1); PV_D0(2); PV_D0(3);
#undef PV_D0
#undef TRRD
}

template <class TIn, class TOut> struct BlockRef { const TIn* Q; const TIn* K; const TIn* V; TOut* O; const bf16* G; int P0; int jlo; };
template <class TIn> struct Seam {
    bf16x8 qr[8];
    bf16x8 st_v0, st_v1, st_k0, st_k1; f32x4 sf0, sf1, sf2, sf3;
    f32x4 tq[16];
};
__device__ __forceinline__ int swa_jlo(int P0, int W) { const int lowk = P0 - W + 1; return lowk > 0 ? lowk / KVBLK : 0; }
#define ROW(p, k0, rr) ((p) + (size_t)((k0) + (rr)) * KVS + sc)
#define VMW() asm volatile("s_waitcnt vmcnt(0)" ::: "memory")
#define VMWN(n) asm volatile("s_waitcnt vmcnt(%0)" :: "i"(n) : "memory")
#define SLOAD_H(Kp, Vp, k0) do { S.st_v0 = load8<TIn>(ROW(Vp, k0, sr)); S.st_v1 = load8<TIn>(ROW(Vp, k0, 32 + sr));              \
                         S.st_k0 = load8<TIn>(ROW(Kp, k0, sr)); S.st_k1 = load8<TIn>(ROW(Kp, k0, 32 + sr)); } while (0)
#define SWRITE_HK(bf) do { *(bf16x8*)(K_lds + (bf) * SHM_K + kws) = S.st_k0; *(bf16x8*)(K_lds + (bf) * SHM_K + kws + 32 * 256) = S.st_k1; } while (0)
#define SWRITE_HV(bf) do { *(bf16x8*)(V_lds + (bf) * SHM_V + vst0) = S.st_v0; *(bf16x8*)(V_lds + (bf) * SHM_V + vst1) = S.st_v1; } while (0)
#define SWRITE_H(bf) do { SWRITE_HV(bf); SWRITE_HK(bf); } while (0)
#define SLOAD_F(p, k0) do { S.sf0 = *(const f32x4*)ROW(p, k0, sr); S.sf1 = *(const f32x4*)(ROW(p, k0, sr) + 4);                \
                            S.sf2 = *(const f32x4*)ROW(p, k0, 32 + sr); S.sf3 = *(const f32x4*)(ROW(p, k0, 32 + sr) + 4); } while (0)
#define SWRITE_KF(bf) do { *(bf16x8*)(K_lds + (bf) * SHM_K + kws) = pack8(S.sf0, S.sf1); *(bf16x8*)(K_lds + (bf) * SHM_K + kws + 32 * 256) = pack8(S.sf2, S.sf3); } while (0)
#define SWRITE_VF(bf) do { *(bf16x8*)(V_lds + (bf) * SHM_V + vst0) = pack8(S.sf0, S.sf1); *(bf16x8*)(V_lds + (bf) * SHM_V + vst1) = pack8(S.sf2, S.sf3); } while (0)
template <class TIn, class TOut>
__device__ __forceinline__ void causal_swa_prime(const BlockRef<TIn, TOut>& cur, int W, char* lds, Seam<TIn>& S) {
    constexpr bool F32 = same_t<TIn, float>::v;
    const int tid = threadIdx.x, wid = __builtin_amdgcn_readfirstlane(tid >> 6), lane = tid & 63, r32 = lane & 31, hi = lane >> 5;
    const int sr = tid >> 4, sc = (tid & 15) * 8, kws = KSWZ(sr, sc * 2); char* K_lds = lds + 2 * SHM_V;
    const int kb0 = cur.jlo * KVBLK;
    for (int d0 = 0; d0 < 8; ++d0) S.qr[d0] = load8<TIn>(cur.Q + (size_t)(wid * QBLK + r32) * KVS + d0 * 16 + hi * 8);
    { lds_bf16x8* qp = (lds_bf16x8*)(lds + QLDS_OFF + (wid * QBLK + r32) * QLDS_ROW + hi * 16);
#pragma unroll
      for (int d0 = 0; d0 < 8; ++d0) qp[2 * d0] = S.qr[d0]; }
    if constexpr (F32) { SLOAD_F((const float*)cur.K, kb0); VMW(); SWRITE_KF(0); SBAR(); SLOAD_F((const float*)cur.V, kb0); }
    else { SLOAD_H(cur.K, cur.V, kb0); VMW(); SWRITE_HK(0); }
    __syncthreads();
}
template <class TIn, class TOut>
__device__ __forceinline__ void causal_swa_block(const BlockRef<TIn, TOut>& cur, const BlockRef<TIn, TOut>& nxt, int skv, int W, char* lds, Seam<TIn>& S) {
    constexpr bool F32 = same_t<TIn, float>::v;
    const int tid = threadIdx.x, wid = __builtin_amdgcn_readfirstlane(tid >> 6), lane = tid & 63, r32 = lane & 31, hi = lane >> 5;
    const int j_lo = cur.jlo;
    int j_hi = (cur.P0 + QB - 1) / KVBLK + 1; if (j_hi > skv / KVBLK) j_hi = skv / KVBLK;
    const int NT = j_hi - j_lo;
    const int kbn = nxt.jlo * KVBLK;
    const int qlo = cur.P0 + wid * QBLK, qm = qlo + r32 - 4 * hi;
    char* V_lds = lds; char* K_lds = lds + 2 * SHM_V;
    float* ws = (float*)(lds + 2 * SHM_V + 2 * SHM_K) + wid * 64; float* li_l = ws, * al_l = ws + 32;
    lds_bf16x8* qp = (lds_bf16x8*)(lds + QLDS_OFF + (wid * QBLK + r32) * QLDS_ROW + hi * 16);
    lds_f32* cb = (lds_f32*)(lds + 2 * SHM_V + 2 * SHM_K + NW * 64 * 4);
    float m_reg = -1e30f, l_reg = 0; f32x16 o[4] = {};
    const int sr = tid >> 4, sc = (tid & 15) * 8, vst0 = v_st(sr, sc), vst1 = v_st(32 + sr, sc), kws = KSWZ(sr, sc * 2);
    const int vb0 = (int)(uintptr_t)V_lds + v_rd_base(lane);
    const TIn* Kh = cur.K; const TIn* Vh = cur.V;
#define RESC(a) do { if (__any((a) < 1.f)) { if (hi == 0) al_l[r32] = (a); asm volatile("s_waitcnt lgkmcnt(0)" ::: "memory");              \
                     for (int d_ = 0; d_ < 4; ++d_) for (int r = 0; r < 16; ++r) o[d_][r] *= al_l[crow(r, hi)]; } } while (0)
#define KBASE(t) ((j_lo + (t)) * KVBLK)
#define ACT(t) (KBASE(t) <= qlo + QBLK - 1 && KBASE(t) + KVBLK - 1 >= qlo - W + 1)
#define MASKT(P0_, P1_, t) do { const int kb_ = KBASE(t); if ((!SK || ACT(t)) && (kb_ + KVBLK - 1 > qlo || kb_ <= qlo + QBLK - 1 - W)) mask_tile(P0_, P1_, qm - kb_, (unsigned)W); } while (0)
    constexpr int NQL = F32 ? 16 : 8;
    constexpr bool SK = WSKIP && !F32;
#define SEAM_K0() do { VMWN(NQL); if constexpr (F32) { SWRITE_KF(0); SBAR(); SLOAD_F((const float*)nxt.V, kbn); } else { SWRITE_HK(0); } SBAR(); } while (0)
    f32x16 pA0, pA1, pB0, pB1; float mnA, mnB, alA, alB; bf16x8 pa0, pa1, pa2, pa3;
    if constexpr (F32) { VMW(); SWRITE_VF(0); SBAR(); } else { SWRITE_HV(0); SBAR(); }
    if (NT > 1) { if constexpr (F32) SLOAD_F((const float*)Kh, KBASE(1)); else SLOAD_H(Kh, Vh, KBASE(1)); }
    SBAR(); qkt<0, SK>(pA0, pA1, K_lds, r32, hi, qp, ACT(0));
    if constexpr (F32) { if (NT > 1) { VMW(); SWRITE_KF(1); SBAR(); SLOAD_F((const float*)Vh, KBASE(1)); } }
    bias_tile(pA0, pA1, cb + KBASE(0), hi); MASKT(pA0, pA1, 0); partialSM(pA0, pA1, m_reg, mnA, alA);
    if (NT > 1) { VMW(); if constexpr (F32) { SWRITE_VF(1); SBAR(); if (NT > 2) SLOAD_F((const float*)Kh, KBASE(2)); } else SWRITE_H(1); }
    __syncthreads();
#define HALF_STEP(PX0, PX1, mnX, alX, PY0, PY1, alY, t, KB, VB, SB) do {                                                      \
        SBAR(); qkt<KB, SK>(PX0, PX1, K_lds, r32, hi, qp, ACT(t));                                             \
        finishSM(PY0, PY1, alY, l_reg, pa0, pa1, pa2, pa3); SBAR();                                                           \
        if ((t) + 1 < NT) { if constexpr (F32) { VMW(); SWRITE_KF(SB); SBAR(); SLOAD_F((const float*)Vh, KBASE((t) + 1)); }  \
                            else { SLOAD_H(Kh, Vh, KBASE((t) + 1)); } SBAR(); }                                               \
        pv_tile<VB, SK>(o, vb0, pa0, pa1, pa2, pa3, ACT((t) - 1)); bias_tile(PX0, PX1, cb + KBASE(t), hi); MASKT(PX0, PX1, (t)); partialSM(PX0, PX1, m_reg, mnX, alX);                                        \
        __syncthreads();                                                                                                      \
        if ((t) + 1 < NT) { VMW(); if constexpr (F32) { SWRITE_VF(SB); SBAR(); if ((t) + 2 < NT) SLOAD_F((const float*)Kh, KBASE((t) + 2)); } \
                            else { SWRITE_H(SB); } }                                                                          \
        RESC(alX); __syncthreads(); } while (0)
    for (int t = 1; t + 1 < NT; t += 2) {
        HALF_STEP(pB0, pB1, mnB, alB, pA0, pA1, alA, t, 1, 0, 0);
        HALF_STEP(pA0, pA1, mnA, alA, pB0, pB1, alB, t + 1, 0, 1, 1);
    }
    const bool even = (NT & 1) == 0;
    if (even) { SBAR(); qkt<1, SK>(pB0, pB1, K_lds, r32, hi, qp, ACT(NT - 1)); SBAR(); }
#define QROW(e) (nxt.Q + (size_t)(wid * QBLK + r32) * KVS + ((e) >> 1) * 16 + hi * 8 + ((e) & 1) * 4)
    if constexpr (F32) { SLOAD_F((const float*)nxt.K, kbn); SBAR();
#pragma unroll
        for (int e = 0; e < 8; ++e) S.tq[e] = *(const f32x4*)QROW(e); }
    else { SLOAD_H(nxt.K, nxt.V, kbn); SBAR();
#pragma unroll
        for (int d0 = 0; d0 < 8; ++d0) S.qr[d0] = load8<TIn>(nxt.Q + (size_t)(wid * QBLK + r32) * KVS + d0 * 16 + hi * 8); }
    SBAR();
    finishSM(pA0, pA1, alA, l_reg, pa0, pa1, pa2, pa3); SBAR();
    if constexpr (F32) {
#pragma unroll
        for (int e = 8; e < 16; ++e) S.tq[e] = *(const f32x4*)QROW(e); SBAR(); }
#undef QROW
    pv_tile<0, SK>(o, vb0, pa0, pa1, pa2, pa3, ACT(even ? NT - 2 : NT - 1));
    if (even) { bias_tile(pB0, pB1, cb + KBASE(NT - 1), hi); MASKT(pB0, pB1, NT - 1); partialSM(pB0, pB1, m_reg, mnB, alB); __syncthreads(); RESC(alB);
        finishSM(pB0, pB1, alB, l_reg, pa0, pa1, pa2, pa3); SBAR(); pv_tile<1, SK>(o, vb0, pa0, pa1, pa2, pa3, ACT(NT - 1)); }
    SBAR(); SEAM_K0();
    if (hi == 0) li_l[r32] = l_reg; asm volatile("s_waitcnt lgkmcnt(0)" ::: "memory");
    float rli[16];
#pragma unroll
    for (int r = 0; r < 16; ++r) rli[r] = __builtin_amdgcn_rcpf(li_l[crow(r, hi)]);
    TOut* Ow = cur.O + (size_t)(wid * QBLK) * OS;
    {
        typedef __attribute__((address_space(3))) unsigned short lds_u16; typedef __attribute__((address_space(3))) u32x4 lds_u32x4;
        const bf16* Gw = cur.G + (size_t)(wid * QBLK) * KVS;
        u32x4 gt[8];
#pragma unroll
        for (int i = 0; i < 8; ++i) { const int p = lane + 64 * i; gt[i] = __builtin_nontemporal_load((const u32x4*)(Gw + (size_t)(p >> 4) * KVS + (p & 15) * 8)); }
        lds_u16* st = (lds_u16*)(lds + QLDS_OFF + (wid * QBLK) * QLDS_ROW);
#pragma unroll
        for (int r = 0; r < 16; ++r) { const int orow = crow(r, hi);
#pragma unroll
            for (int d0 = 0; d0 < 4; d0 += 2) { const unsigned w2 = cvtpk(o[d0][r] * rli[r], o[d0 + 1][r] * rli[r]);
                st[orow * (QLDS_ROW / 2) + d0 * 32 + r32] = (unsigned short)w2; st[orow * (QLDS_ROW / 2) + (d0 + 1) * 32 + r32] = (unsigned short)(w2 >> 16); } }
        asm volatile("s_waitcnt lgkmcnt(0)" ::: "memory");
#pragma unroll
        for (int i = 0; i < 8; ++i) { const int p = lane + 64 * i, row = p >> 4, c8 = (p & 15) * 8;
            const u32x4 ov = *(const lds_u32x4*)(lds + QLDS_OFF + (wid * QBLK + row) * QLDS_ROW + c8 * 2); u32x4 w;
#pragma unroll
            for (int e = 0; e < 4; ++e) { const float a0 = __uint_as_float(ov[e] << 16), a1 = __uint_as_float(ov[e] & 0xffff0000u), g0 = __uint_as_float(gt[i][e] << 16), g1 = __uint_as_float(gt[i][e] & 0xffff0000u);
                w[e] = cvtpk(a0 * g0 * __builtin_amdgcn_rcpf(1.0f + __expf(-g0)), a1 * g1 * __builtin_amdgcn_rcpf(1.0f + __expf(-g1))); }
            *(u32x4*)(Ow + (size_t)row * OS + c8) = w; }
        asm volatile("s_waitcnt lgkmcnt(0)" ::: "memory");
    }
    if constexpr (F32) {
#pragma unroll
        for (int d0 = 0; d0 < 8; ++d0) S.qr[d0] = pack8(S.tq[2 * d0], S.tq[2 * d0 + 1]); }
#pragma unroll
    for (int d0 = 0; d0 < 8; ++d0) qp[2 * d0] = S.qr[d0];
    __syncthreads();
#undef RESC
#undef KBASE
#undef ACT
#undef MASKT
#undef SEAM_K0
#undef HALF_STEP
}
#undef ROW
#undef VMW
#undef VMWN
#undef SLOAD_H
#undef SWRITE_HK
#undef SWRITE_HV
#undef SWRITE_H
#undef SLOAD_F
#undef SWRITE_KF
#undef SWRITE_VF
}
__device__ __forceinline__ void fox_naive_row(const Args& a, int bh, int t, int lane) {
    const bf16* P = (const bf16*)(a.ws + WS_P); const float* cf = (const float*)(a.ws + WS_CFOX) + (size_t)bh * SEQ; bf16* mix = (bf16*)(a.ws + WS_MIX);
    const int b = bh >> 3, h = bh & 7; const size_t rowb = (size_t)b * SEQ;
    const unsigned qw = *(const unsigned*)(P + (rowb + t) * NP + C_FQ + 128 * h + 2 * lane);
    const float scale = 0.08838834764831845f; const float q0 = bflo(qw) * scale, q1 = bfhi(qw) * scale; const float ct = cf[t];
    float m = -1e30f, l = 0.f, o0 = 0.f, o1 = 0.f;
    for (int s = 0; s <= t; ++s) {
        const unsigned kw = *(const unsigned*)(P + (rowb + s) * NP + C_FK + 128 * h + 2 * lane), vw = *(const unsigned*)(P + (rowb + s) * NP + C_FV + 128 * h + 2 * lane);
        float d = q0 * bflo(kw) + q1 * bfhi(kw); d = wave_sum(d);
        const float logit = d + (ct - cf[s]);
        const float mn = fmaxf(m, logit), corr = __expf(m - mn), p = __expf(logit - mn);
        l = l * corr + p; o0 = o0 * corr + p * bflo(vw); o1 = o1 * corr + p * bfhi(vw); m = mn;
    }
    const unsigned gw_ = *(const unsigned*)(P + (rowb + t) * NP + C_FG + 128 * h + 2 * lane);
    const float inv = 1.0f / l;
    *(unsigned*)(mix + (rowb + t) * DM + 1024 + 128 * h + 2 * lane) = pk2(o0 * inv * silu_f(bflo(gw_)), o1 * inv * silu_f(bfhi(gw_)));
}
__device__ __forceinline__ void gla_naive(const Args& a, LAS unsigned char* lds, int bh, int tid) {
    const bf16* P = (const bf16*)(a.ws + WS_P); const float* small = (const float*)(a.ws + WS_SMALL); float* oraw = (float*)(a.ws + WS_ORAW);
    const int b = bh >> 2, h = bh & 3; const size_t rowb = (size_t)b * SEQ;
    LAS float* A = (LAS float*)lds; LAS float* Kk = A + 8 * 128; LAS float* Qq = Kk + 8 * 128; LAS float* Vv = Qq + 8 * 128; LAS float* OP = Vv + 8 * 256;
    const int dv = tid & 255, kh = tid >> 8;
    float S[64];
#pragma unroll
    for (int j = 0; j < 64; ++j) S[j] = 0.f;
    const float qscale = 0.08838834764831845f;
    for (int tb = 0; tb < SEQ / 8; ++tb) {
        for (int idx = tid; idx < 1024; idx += NTHR) { const int tt = idx >> 7, k = idx & 127; const size_t row = rowb + tb * 8 + tt;
            float z = a.alpha_b[128 * h + k];
#pragma unroll
            for (int r = 0; r < 16; ++r) z += small[row * 32 + r] * a.alpha_up[r * 512 + 128 * h + k];
            A[idx] = __expf(logsigmoid_f(z) * (1.0f / 16.0f)); Kk[idx] = bf2f(P[row * NP + C_GK + 128 * h + k]); Qq[idx] = bf2f(P[row * NP + C_GQ + 128 * h + k]) * qscale; }
        for (int idx = tid; idx < 2048; idx += NTHR) { const int tt = idx >> 8, d = idx & 255; Vv[idx] = bf2f(P[(rowb + tb * 8 + tt) * NP + C_GV + 256 * h + d]); }
        __syncthreads();
        for (int tt = 0; tt < 8; ++tt) { const float v = Vv[tt * 256 + dv]; float o = 0.f;
#pragma unroll
            for (int j = 0; j < 64; ++j) { const int ki = tt * 128 + kh * 64 + j; S[j] = A[ki] * S[j] + Kk[ki] * v; o += Qq[ki] * S[j]; }
            OP[(tt * 2 + kh) * 256 + dv] = o; }
        __syncthreads();
        for (int idx = tid; idx < 2048; idx += NTHR) { const int tt = idx >> 8, d = idx & 255; oraw[(rowb + tb * 8 + tt) * 1024 + 256 * h + d] = OP[(tt * 2) * 256 + d] + OP[(tt * 2 + 1) * 256 + d]; }
    }
}
__device__ __forceinline__ void gla_pass_a(const Args& a, LAS unsigned char* lds, int unit, int tid);
__device__ __forceinline__ void gla_pass_c(const Args& a, LAS unsigned char* lds, int unit, int tid);
__device__ __forceinline__ void phase_gla_b(const Args& a, int tid, int gw, int NG);
__device__ __forceinline__ void phase_gla_b2(const Args& a, int tid, int gw, int NG);
__device__ __forceinline__ void sub_barrier(unsigned* cnt, unsigned target) {
    asm volatile("s_waitcnt vmcnt(0)" ::: "memory"); __syncthreads();
    if (threadIdx.x == 0) {
        __builtin_amdgcn_fence(__ATOMIC_RELEASE, "agent"); asm volatile("s_waitcnt vmcnt(0)" ::: "memory");
        __hip_atomic_fetch_add(cnt, 1u, __ATOMIC_RELAXED, __HIP_MEMORY_SCOPE_AGENT);
        unsigned sp = 0; while (__hip_atomic_load(cnt, __ATOMIC_RELAXED, __HIP_MEMORY_SCOPE_AGENT) < target) { __builtin_amdgcn_s_sleep(2); if (++sp > (1u << 22)) break; }
        __builtin_amdgcn_fence(__ATOMIC_ACQUIRE, "agent"); asm volatile("s_waitcnt vmcnt(0)" ::: "memory");
    }
    __syncthreads();
}
__device__ __forceinline__ fox::BlockRef<bf16, bf16> fox_ref(const Args& a, int bh, int qb, int jlo) {
    const bf16* P = (const bf16*)(a.ws + WS_P); const int b = bh >> 3, h = bh & 7; const size_t row0 = (size_t)b * SEQ + (size_t)qb * 256;
    fox::BlockRef<bf16, bf16> r;
    r.Q = P + row0 * NP + C_FQ + 128 * h; r.K = P + (size_t)b * SEQ * NP + C_FK + 128 * h; r.V = P + (size_t)b * SEQ * NP + C_FV + 128 * h;
    r.O = (bf16*)(a.ws + WS_MIX) + row0 * DM + 1024 + 128 * h; r.G = P + row0 * NP + C_FG + 128 * h; r.P0 = qb * 256; r.jlo = jlo;
    return r;
}
__device__ __forceinline__ void phase_fox(const Args& a, char* lds, int w) {
    const int bh = 2 * (w & 7) + (w >> 7), qb = (w >> 3) & 15, P0 = qb * 256;
    fox::lds_f32* cb = (fox::lds_f32*)(lds + fox::LDS_BYTES);
    {   const float* cf = (const float*)(a.ws + WS_CFOX) + (size_t)bh * SEQ;
        for (int j = threadIdx.x; j < P0 + 256; j += NTHR) cb[j] = cf[j] * (-1.0f / fox::SCALE); }
    __syncthreads();
    int jl0;
    {   const float* nm = (const float*)(a.ws + WS_BAR + 20480) + (size_t)bh * 8;
        const float qn2 = (nm[0] + nm[1]) + (nm[2] + nm[3]), kn2 = (nm[4] + nm[5]) + (nm[6] + nm[7]);
        const float thr = -(50.0f / fox::SCALE) - 2.0f * 1.02f * sqrtf(qn2 * kn2);
        const int lane = threadIdx.x & 63;
        const bool skip = lane < P0 / 64 && (cb[64 * lane + 63] - cb[P0] <= thr);
        jl0 = __builtin_amdgcn_readfirstlane((int)__builtin_popcountll(__ballot(skip)));
    }
    const fox::BlockRef<bf16, bf16> cur = fox_ref(a, bh, qb, jl0);
    fox::Seam<bf16> S;
    fox::causal_swa_prime<bf16, bf16>(cur, SEQ, lds, S);
    fox::causal_swa_block<bf16, bf16>(cur, cur, SEQ, SEQ, lds, S);
}
__device__ __forceinline__ void phase_m1(const Args& a, LAS unsigned char* lds, int tid, int G) {
    for (int unit = blockIdx.x; unit < 512; unit += G) gla_pass_a(a, lds, unit, tid);
    __syncthreads();
    phase_fox_cumsum(a, lds, tid, G);
}
__device__ __forceinline__ void phase_m2(const Args& a, unsigned char* lds_raw, int tid, int G) {
    if (G * NTHR >= 131072) phase_gla_b2(a, tid, blockIdx.x, G); else phase_gla_b(a, tid, blockIdx.x, G);
    if (blockIdx.x < 256) phase_fox(a, (char*)lds_raw, blockIdx.x);
}
__device__ __forceinline__ void phase_gla_finalize(const Args& a, int tid, int G) {
    const int lane = tid & 63, wave = tid >> 6; const int gw = blockIdx.x * NWAVES + wave, NGW = G * NWAVES;
    const bf16* P = (const bf16*)(a.ws + WS_P); const float* oraw = (const float*)(a.ws + WS_ORAW); bf16* mix = (bf16*)(a.ws + WS_MIX);
    for (int it = gw; it < MROWS * 4; it += NGW) { const int row = it >> 2, h = it & 3;
        const f32x4 v = *(const f32x4*)(oraw + (size_t)row * 1024 + 256 * h + 4 * lane);
        float s = (v[0] * v[0] + v[1] * v[1]) + (v[2] * v[2] + v[3] * v[3]); s = wave_sum(s);
        const float r = rsqrtf(s * (1.0f / 256.0f) + EPS);
        const f32x4 g = *(const f32x4*)(a.head_g + 256 * h + 4 * lane);
        const v2u gt = *(const v2u*)(P + (size_t)row * NP + C_GG + 256 * h + 4 * lane);
        v2u w; w.x = pk2(v[0] * r * g[0] * silu_f(bflo(gt.x)), v[1] * r * g[1] * silu_f(bfhi(gt.x))); w.y = pk2(v[2] * r * g[2] * silu_f(bflo(gt.y)), v[3] * r * g[3] * silu_f(bfhi(gt.y)));
        *(v2u*)(mix + (size_t)row * DM + 256 * h + 4 * lane) = w; }
    for (int row0 = gw; row0 < MROWS; row0 += 4 * NGW) {
        v4u m[4][2], g[4][2];
#pragma unroll
        for (int rr = 0; rr < 4; ++rr) { const int row = row0 + rr * NGW; if (row < MROWS) { const v4u* mp = (const v4u*)(mix + (size_t)row * DM + 1024 + 16 * lane); const v4u* gp = (const v4u*)(P + (size_t)row * NP + C_FG + 16 * lane);
            m[rr][0] = mp[0]; m[rr][1] = mp[1]; g[rr][0] = gp[0]; g[rr][1] = gp[1]; } }
#pragma unroll
        for (int rr = 0; rr < 4; ++rr) { const int row = row0 + rr * NGW; if (row < MROWS) { v4u* mp = (v4u*)(mix + (size_t)row * DM + 1024 + 16 * lane);
#pragma unroll
            for (int q = 0; q < 2; ++q) { v4u o;
#pragma unroll
                for (int e = 0; e < 4; ++e) o[e] = pk2(bflo(m[rr][q][e]) * silu_f(bflo(g[rr][q][e])), bfhi(m[rr][q][e]) * silu_f(bfhi(g[rr][q][e])));
                mp[q] = o; } } }
    }
}
__device__ __forceinline__ void phase_s5_naive(const Args& a, int tid, int G) {
    const int lane = tid & 63, wave = tid >> 6; const int gw = blockIdx.x * NWAVES + wave;
    if (gw >= 256) return;
    const int b = gw >> 7, g = gw & 127, p = lane;
    const bf16* UG = (const bf16*)(a.ws + WS_UG); bf16* zb = (bf16*)(a.ws + WS_ZB);
    const float lr = fminf(a.lam_re[g * 64 + p], -1e-4f), li = a.lam_im[g * 64 + p], step = __expf(a.log_step[g]);
    const float mag = __expf(lr * step), lbr = mag * cosf(li * step), lbi = mag * sinf(li * step);
    const float den = lr * lr + li * li, nr = lbr - 1.0f, ni = lbi, cr = (nr * lr + ni * li) / den, ci = (ni * lr - nr * li) / den;
    float bbr[16], bbi[16], ccr[16], cci[16];
#pragma unroll
    for (int c = 0; c < 16; ++c) { const float br = a.b_re[(g * 64 + p) * 16 + c], bi = a.b_im[(g * 64 + p) * 16 + c]; bbr[c] = cr * br - ci * bi; bbi[c] = cr * bi + ci * br;
        ccr[c] = a.c_re[(g * 16 + c) * 64 + p]; cci[c] = a.c_im[(g * 16 + c) * 64 + p]; }
    const float dd = a.s5_d[g * 16 + (lane & 15)];
    float xr = 0.f, xi = 0.f;
    for (int t = 0; t < SEQ; ++t) { const size_t row = (size_t)b * SEQ + t;
        const v4u u0 = *(const v4u*)(UG + row * 4096 + 16 * g), u1 = *(const v4u*)(UG + row * 4096 + 16 * g + 8);
        float u[16];
#pragma unroll
        for (int e = 0; e < 4; ++e) { u[2 * e] = bflo(u0[e]); u[2 * e + 1] = bfhi(u0[e]); u[8 + 2 * e] = bflo(u1[e]); u[8 + 2 * e + 1] = bfhi(u1[e]); }
        float br = 0.f, bi = 0.f;
#pragma unroll
        for (int c = 0; c < 16; ++c) { br += bbr[c] * u[c]; bi += bbi[c] * u[c]; }
        const float nxr = lbr * xr - lbi * xi + br, nxi = lbr * xi + lbi * xr + bi; xr = nxr; xi = nxi;
        float ymine = 0.f, umine = 0.f;
#pragma unroll
        for (int c = 0; c < 16; ++c) { const float y = wave_sum(ccr[c] * xr - cci[c] * xi); if ((lane & 15) == c) { ymine = y; umine = u[c]; } }
        if (lane < 16) { const float y = ymine + dd * umine; zb[row * DM + 16 * g + lane] = (bf16)f2bf(gelu_tanh(y)); }
    }
}

typedef short s5_bf16x8 __attribute__((ext_vector_type(8)));
typedef float s5_f32x16 __attribute__((ext_vector_type(16)));
typedef float s5_f32x2 __attribute__((ext_vector_type(2)));
template <bool PASS2>
__device__ __forceinline__ void s5_pass(const bf16* UG, bf16* zb, LAS unsigned char* xl, int g, int seg0, int lane, const s5_bf16x8 (&Bf)[4], const s5_bf16x8 (&Cf)[4], f32x4 Dv,
                                        float lbr0, float lbi0, float lbr1, float lbi1, s5_f32x2& xr0, s5_f32x2& xi0, s5_f32x2& xr1, s5_f32x2& xi1, int nblk) {
    const int r = lane & 31, hl = lane >> 5, q4 = lane >> 4;
    const int rgA = 4 * (r >> 3) + (r & 3);
    const bf16* ap = UG + ((size_t)((rgA & 1) * SEQ + seg0 + 128 * ((r >> 2) & 1) + (rgA >> 1))) * 4096 + 16 * g + 8 * hl;
    s5_bf16x8 af = *(const s5_bf16x8*)ap;
    for (int blk = 0; blk < nblk; ++blk) {
        const s5_bf16x8 afn = *(const s5_bf16x8*)(ap + (size_t)((blk < nblk - 1 ? blk + 1 : blk) * 8) * 4096);
        v2u uu2[2] = {};
        if constexpr (PASS2) {
#pragma unroll
            for (int nblk = 0; nblk < 2; ++nblk) { const int i = 16 * nblk + (lane & 15), rg = 4 * (i >> 3) + (i & 3); const size_t rowg = (size_t)((rg & 1) * SEQ + seg0 + 128 * ((i >> 2) & 1) + blk * 8 + (rg >> 1));
                uu2[nblk] = *(const v2u*)(UG + rowg * 4096 + 16 * g + 4 * q4); } }
        s5_f32x16 acc[4];
#pragma unroll
        for (int nb = 0; nb < 4; ++nb) { acc[nb] = s5_f32x16{}; acc[nb] = __builtin_amdgcn_mfma_f32_32x32x16_bf16(af, Bf[nb], acc[nb], 0, 0, 0); }
#pragma unroll
        for (int k = 0; k < 8; ++k) {
            const s5_f32x2 b0r = {acc[0][2 * k], acc[0][2 * k + 1]}, b0i = {acc[2][2 * k], acc[2][2 * k + 1]}, b1r = {acc[1][2 * k], acc[1][2 * k + 1]}, b1i = {acc[3][2 * k], acc[3][2 * k + 1]};
            const s5_f32x2 n0r = lbr0 * xr0 - lbi0 * xi0 + b0r, n0i = lbr0 * xi0 + lbi0 * xr0 + b0i;
            const s5_f32x2 n1r = lbr1 * xr1 - lbi1 * xi1 + b1r, n1i = lbr1 * xi1 + lbi1 * xr1 + b1i;
            xr0 = n0r; xi0 = n0i; xr1 = n1r; xi1 = n1i;
            acc[0][2 * k] = n0r.x; acc[0][2 * k + 1] = n0r.y; acc[2][2 * k] = n0i.x; acc[2][2 * k + 1] = n0i.y; acc[1][2 * k] = n1r.x; acc[1][2 * k + 1] = n1r.y; acc[3][2 * k] = n1i.x; acc[3][2 * k + 1] = n1i.y;
        }
        if constexpr (PASS2) {
#pragma unroll
            for (int nb = 0; nb < 4; ++nb)
#pragma unroll
                for (int t = 0; t < 16; t += 2) { const int i = (t & 3) + 8 * (t >> 2) + 4 * hl; const unsigned pw = pk2(acc[nb][t], acc[nb][t + 1]);
                    *(LAS unsigned short*)(xl + i * 272 + (32 * nb + r) * 2) = (unsigned short)pw; *(LAS unsigned short*)(xl + (i + 1) * 272 + (32 * nb + r) * 2) = (unsigned short)(pw >> 16); }
            asm volatile("s_waitcnt lgkmcnt(0)" ::: "memory"); __builtin_amdgcn_wave_barrier();
#pragma unroll
            for (int nblk = 0; nblk < 2; ++nblk) {
                const int i = 16 * nblk + (lane & 15), rg = 4 * (i >> 3) + (i & 3);
                f32x4 y = {0.f, 0.f, 0.f, 0.f};
#pragma unroll
                for (int ks = 0; ks < 4; ++ks) { const s5_bf16x8 xf = *(const LAS s5_bf16x8*)(xl + i * 272 + 64 * ks + 16 * q4); y = __builtin_amdgcn_mfma_f32_16x16x32_bf16(Cf[ks], xf, y, 0, 0, 0); }
                const size_t rowg = (size_t)((rg & 1) * SEQ + seg0 + 128 * ((i >> 2) & 1) + blk * 8 + (rg >> 1));
                const v2u uu = uu2[nblk];
                const float z0 = gelu_tanh(y[0] + Dv[0] * bflo(uu.x)), z1 = gelu_tanh(y[1] + Dv[1] * bfhi(uu.x)), z2 = gelu_tanh(y[2] + Dv[2] * bflo(uu.y)), z3 = gelu_tanh(y[3] + Dv[3] * bfhi(uu.y));
                v2u w; w.x = pk2(z0, z1); w.y = pk2(z2, z3); *(v2u*)(zb + rowg * DM + 16 * g + 4 * q4) = w;
            }
            asm volatile("s_waitcnt lgkmcnt(0)" ::: "memory"); __builtin_amdgcn_wave_barrier();
        }
        af = afn;
    }
}
constexpr size_t WS_S5E = 56 * MiB;
__device__ __forceinline__ void phase_s5(const Args& a, LAS unsigned char* lds, int tid) {
    if (blockIdx.x >= 256) return;
    const int wave0 = __builtin_amdgcn_readfirstlane(tid >> 6);
    const int g = (blockIdx.x & 15) * 8 + wave0, seg_wg = blockIdx.x >> 4;
    const int lane = tid & 63, wave = wave0, r = lane & 31, hl = lane >> 5, q4 = lane >> 4, ch = lane & 15;
    const bf16* UG = (const bf16*)(a.ws + WS_UG); bf16* zb = (bf16*)(a.ws + WS_ZB);
    const float step = __expf(a.log_step[g]);
    float lbr[2], lbi[2]; s5_bf16x8 Bf[4], Cf[4];
#pragma unroll
    for (int s2 = 0; s2 < 2; ++s2) { const int p = r + 32 * s2;
        const float lr = fminf(a.lam_re[g * 64 + p], -1e-4f), li = a.lam_im[g * 64 + p];
        const float mag = __expf(lr * step); lbr[s2] = mag * cosf(li * step); lbi[s2] = mag * sinf(li * step);
        const float den = lr * lr + li * li, nr = lbr[s2] - 1.0f, ni = lbi[s2], cr = (nr * lr + ni * li) / den, ci = (ni * lr - nr * li) / den;
        const f32x4 br0 = *(const f32x4*)(a.b_re + (size_t)(g * 64 + p) * 16 + 8 * hl), br1 = *(const f32x4*)(a.b_re + (size_t)(g * 64 + p) * 16 + 8 * hl + 4);
        const f32x4 bi0 = *(const f32x4*)(a.b_im + (size_t)(g * 64 + p) * 16 + 8 * hl), bi1 = *(const f32x4*)(a.b_im + (size_t)(g * 64 + p) * 16 + 8 * hl + 4);
#pragma unroll
        for (int j = 0; j < 8; ++j) { const float br = j < 4 ? br0[j & 3] : br1[j & 3], bi = j < 4 ? bi0[j & 3] : bi1[j & 3];
            Bf[s2][j] = (short)f2bf(cr * br - ci * bi); Bf[2 + s2][j] = (short)f2bf(cr * bi + ci * br); } }
#pragma unroll
    for (int ks = 0; ks < 4; ++ks) { const int st = (ks & 1) * 32 + 8 * q4; const float* src = (ks < 2 ? a.c_re : a.c_im) + (size_t)(g * 16 + ch) * 64 + st;
        const f32x4 c0 = *(const f32x4*)src, c1 = *(const f32x4*)(src + 4);
#pragma unroll
        for (int j = 0; j < 8; ++j) { const float v = j < 4 ? c0[j & 3] : c1[j & 3]; Cf[ks][j] = (short)f2bf(ks < 2 ? v : -v); } }
    const f32x4 Dv = *(const f32x4*)(a.s5_d + g * 16 + 4 * q4);
    LAS unsigned char* xl = lds + wave * 8704; float* Ef = (float*)(a.ws + WS_S5E) + (size_t)g * 32 * 32 * 8;
    const int seg = seg_wg, subseg = 2 * seg + hl;
    s5_f32x2 xr0 = {0.f, 0.f}, xi0 = {0.f, 0.f}, xr1 = {0.f, 0.f}, xi1 = {0.f, 0.f};
    s5_pass<false>(UG, zb, xl, g, seg * 256, lane, Bf, Cf, Dv, lbr[0], lbi[0], lbr[1], lbi[1], xr0, xi0, xr1, xi1, 16);
    {   unsigned long long* E64 = (unsigned long long*)(Ef + (size_t)(subseg * 32 + r) * 8);
        __hip_atomic_store(E64, ((unsigned long long)__float_as_uint(xr0.y) << 32) | __float_as_uint(xr0.x), __ATOMIC_RELAXED, __HIP_MEMORY_SCOPE_AGENT);
        __hip_atomic_store(E64 + 1, ((unsigned long long)__float_as_uint(xi0.y) << 32) | __float_as_uint(xi0.x), __ATOMIC_RELAXED, __HIP_MEMORY_SCOPE_AGENT);
        __hip_atomic_store(E64 + 2, ((unsigned long long)__float_as_uint(xr1.y) << 32) | __float_as_uint(xr1.x), __ATOMIC_RELAXED, __HIP_MEMORY_SCOPE_AGENT);
        __hip_atomic_store(E64 + 3, ((unsigned long long)__float_as_uint(xi1.y) << 32) | __float_as_uint(xi1.x), __ATOMIC_RELAXED, __HIP_MEMORY_SCOPE_AGENT); }
    asm volatile("s_waitcnt vmcnt(0)" ::: "memory"); __syncthreads();
    unsigned* cnt = (unsigned*)(a.ws + WS_BAR + 18432) + 16 * (blockIdx.x & 15);
    if (tid == 0) { __hip_atomic_fetch_add(cnt, 1u, __ATOMIC_RELAXED, __HIP_MEMORY_SCOPE_AGENT);
        unsigned sp = 0; while (__hip_atomic_load(cnt, __ATOMIC_RELAXED, __HIP_MEMORY_SCOPE_AGENT) < 16u) { __builtin_amdgcn_s_sleep(2); if (++sp > (1u << 20)) break; }
        __builtin_amdgcn_fence(__ATOMIC_ACQUIRE, "agent"); asm volatile("s_waitcnt vmcnt(0)" ::: "memory"); }
    __syncthreads();
    {   float p0r = lbr[0], p0i = lbi[0], p1r = lbr[1], p1i = lbi[1];
#pragma unroll
        for (int s = 0; s < 7; ++s) { const float a0 = p0r * p0r - p0i * p0i, b0 = 2.f * p0r * p0i, a1 = p1r * p1r - p1i * p1i, b1 = 2.f * p1r * p1i; p0r = a0; p0i = b0; p1r = a1; p1i = b1; }
        xr0 = (s5_f32x2){0.f, 0.f}; xi0 = xr0; xr1 = xr0; xi1 = xr0;
        for (int s = 0; s < 2 * seg + 1; ++s) { if (s < subseg) { const f32x4 e0 = *(const f32x4*)(Ef + (size_t)(s * 32 + r) * 8), e1 = *(const f32x4*)(Ef + (size_t)(s * 32 + r) * 8 + 4);
            const s5_f32x2 er0 = {e0[0], e0[1]}, ei0 = {e0[2], e0[3]}, er1 = {e1[0], e1[1]}, ei1 = {e1[2], e1[3]};
            const s5_f32x2 n0r = p0r * xr0 - p0i * xi0 + er0, n0i = p0r * xi0 + p0i * xr0 + ei0, n1r = p1r * xr1 - p1i * xi1 + er1, n1i = p1r * xi1 + p1i * xr1 + ei1;
            xr0 = n0r; xi0 = n0i; xr1 = n1r; xi1 = n1i; } }
        s5_pass<true>(UG, zb, xl, g, seg * 256, lane, Bf, Cf, Dv, lbr[0], lbi[0], lbr[1], lbi[1], xr0, xi0, xr1, xi1, 16);
    }
}
constexpr size_t WS_S5E_DUMMY = 0;

typedef short g_bf16x8 __attribute__((ext_vector_type(8)));
typedef float g_f32x16 __attribute__((ext_vector_type(16)));
constexpr size_t WS_QT = 44 * MiB, WS_OINTRA = 52 * MiB, WS_SINT = 221 * MiB, WS_DECAY = WS_PART2;
__device__ __forceinline__ int g_irow(int reg, int hl) { return (reg & 3) + 8 * (reg >> 2) + 4 * hl; }
__device__ __forceinline__ void gla_pass_a(const Args& a, LAS unsigned char* lds, int unit, int tid) {
    const bf16* P = (const bf16*)(a.ws + WS_P); const float* small = (const float*)(a.ws + WS_SMALL);
    bf16* qtg = (bf16*)(a.ws + WS_QT); unsigned* oin = (unsigned*)(a.ws + WS_OINTRA); bf16* kvt = (bf16*)a.out; float* decay = (float*)(a.ws + WS_DECAY);
    const int bh = unit >> 6, n = unit & 63, b = bh >> 2, h = bh & 3; const size_t R0 = (size_t)b * SEQ + 64 * n;
    LAS bf16* QT = (LAS bf16*)lds; LAS bf16* KT = (LAS bf16*)(lds + 17408); LAS bf16* KH = (LAS bf16*)(lds + 34816); LAS bf16* VT = (LAS bf16*)(lds + 53248); LAS bf16* AT = (LAS bf16*)(lds + 90112); LAS float* PART = (LAS float*)(lds + 99328);
    const int lane = tid & 63, w = __builtin_amdgcn_readfirstlane(tid >> 6), r = lane & 31, hl = lane >> 5;
    __syncthreads();
    {
        const int col = tid & 127, qtr = tid >> 7; const float ab = a.alpha_b[128 * h + col]; float au[16];
#pragma unroll
        for (int rr = 0; rr < 16; ++rr) au[rr] = a.alpha_up[rr * 512 + 128 * h + col];
        bf16 qraw[16], kraw[16];
#pragma unroll
        for (int t = 0; t < 16; ++t) { const size_t row = R0 + 16 * qtr + t; qraw[t] = P[row * NP + C_GQ + 128 * h + col]; kraw[t] = P[row * NP + C_GK + 128 * h + col]; }
        float cs[16]; float run = 0.f;
#pragma unroll
        for (int t = 0; t < 16; ++t) { const size_t row = R0 + 16 * qtr + t; const f32x4* sp = (const f32x4*)(small + row * 32); float z = ab;
#pragma unroll
            for (int q = 0; q < 4; ++q) { const f32x4 s4 = sp[q]; z += s4[0] * au[4 * q] + s4[1] * au[4 * q + 1] + s4[2] * au[4 * q + 2] + s4[3] * au[4 * q + 3]; }
            run += logsigmoid_f(z) * (1.0f / 16.0f); cs[t] = run; }
        PART[qtr * 128 + col] = run;
        {   const int dv = tid & 255, half = tid >> 8;
#pragma unroll 8
            for (int t = 0; t < 32; t += 2) { const int tok = 32 * half + t; const unsigned lo = P[(R0 + tok) * NP + C_GV + 256 * h + dv], hi2 = P[(R0 + tok + 1) * NP + C_GV + 256 * h + dv];
                *(LAS unsigned*)(VT + dv * 72 + tok) = lo | (hi2 << 16); } }
        __syncthreads();
        float pre = 0.f, tot = 0.f;
#pragma unroll
        for (int q = 0; q < 4; ++q) { const float v = PART[q * 128 + col]; tot += v; if (q < qtr) pre += v; }
        const float qscale = 0.08838834764831845f;
#pragma unroll
        for (int t = 0; t < 16; t += 2) { float khv[2];
#pragma unroll
            for (int u2 = 0; u2 < 2; ++u2) { const int tok = 16 * qtr + t + u2; const size_t row = R0 + tok; const float bb = pre + cs[t + u2];
                const float qv = bf2f(qraw[t + u2]) * qscale * __expf(bb), kv = bf2f(kraw[t + u2]);
                const bf16 qb = (bf16)f2bf(qv);
                QT[tok * 136 + col] = qb; KT[tok * 136 + col] = (bf16)f2bf(kv * __expf(-bb)); khv[u2] = kv * __expf(tot - bb); qtg[row * 512 + 128 * h + col] = qb; }
            *(LAS unsigned*)(KH + col * 72 + 16 * qtr + t) = pk2(khv[0], khv[1]); }
        if (qtr == 0) decay[(size_t)unit * 128 + col] = __expf(tot);
    }
    __syncthreads();
    if (w < 4) {
        const int bi = w >> 1, bj = w & 1;
        if (bi == 0 && bj == 1) {
#pragma unroll
            for (int reg = 0; reg < 16; ++reg) AT[g_irow(reg, hl) * 72 + 32 + r] = 0;
        } else {
            g_f32x16 acc = g_f32x16{};
#pragma unroll
            for (int ks = 0; ks < 8; ++ks) { const g_bf16x8 af = *(const LAS g_bf16x8*)(QT + (32 * bi + r) * 136 + 16 * ks + 8 * hl), bf = *(const LAS g_bf16x8*)(KT + (32 * bj + r) * 136 + 16 * ks + 8 * hl);
                acc = __builtin_amdgcn_mfma_f32_32x32x16_bf16(af, bf, acc, 0, 0, 0); }
#pragma unroll
            for (int reg = 0; reg < 16; ++reg) { const int i = 32 * bi + g_irow(reg, hl), j = 32 * bj + r; AT[i * 72 + j] = (bf16)f2bf(j <= i ? acc[reg] : 0.f); }
        }
    }
    __syncthreads();
    {
#pragma unroll
        for (int bi = 0; bi < 2; ++bi) { g_f32x16 acc = g_f32x16{};
#pragma unroll
            for (int ks = 0; ks < 4; ++ks) { if (bi == 0 && ks >= 2) continue;
                const g_bf16x8 af = *(const LAS g_bf16x8*)(AT + (32 * bi + r) * 72 + 16 * ks + 8 * hl), bf = *(const LAS g_bf16x8*)(VT + (32 * w + r) * 72 + 16 * ks + 8 * hl);
                acc = __builtin_amdgcn_mfma_f32_32x32x16_bf16(bf, af, acc, 0, 0, 0); }
            v4u o0, o1;
#pragma unroll
            for (int e = 0; e < 4; ++e) { o0[e] = pk2(acc[2 * e], acc[2 * e + 1]); o1[e] = pk2(acc[8 + 2 * e], acc[8 + 2 * e + 1]); }
            v4u* op = (v4u*)(oin + ((size_t)((unit * 8 + w) * 2 + bi) * 64 + lane) * 8); op[0] = o0; op[1] = o1; }
        g_bf16x8 av[4];
#pragma unroll
        for (int ks = 0; ks < 4; ++ks) av[ks] = *(const LAS g_bf16x8*)(VT + (32 * w + r) * 72 + 16 * ks + 8 * hl);
        LAS unsigned char* slab = lds + w * 4096;
#pragma unroll
        for (int pr = 0; pr < 2; ++pr) {
#pragma unroll
            for (int nbl = 0; nbl < 2; ++nbl) { const int nb = 2 * pr + nbl; g_f32x16 acc = g_f32x16{};
#pragma unroll
                for (int ks = 0; ks < 4; ++ks) { const g_bf16x8 bf = *(const LAS g_bf16x8*)(KH + (32 * nb + r) * 72 + 16 * ks + 8 * hl); acc = __builtin_amdgcn_mfma_f32_32x32x16_bf16(bf, av[ks], acc, 0, 0, 0); }
#pragma unroll
                for (int g4 = 0; g4 < 4; ++g4) { v2u o; o.x = pk2(acc[4 * g4], acc[4 * g4 + 1]); o.y = pk2(acc[4 * g4 + 2], acc[4 * g4 + 3]);
                    *(LAS v2u*)(slab + r * 128 + (((4 * nbl + g4) ^ (r & 7)) * 16) + hl * 8) = o; } }
            asm volatile("s_waitcnt lgkmcnt(0)" ::: "memory"); __builtin_amdgcn_wave_barrier();
#pragma unroll
            for (int i = 0; i < 4; ++i) { const int p = lane + 64 * i, rr = p >> 3, q = p & 7;
                *(v4u*)(kvt + ((size_t)unit * 256 + 32 * w + rr) * 128 + 64 * pr + 8 * q) = *(const LAS v4u*)(slab + rr * 128 + ((q ^ (rr & 7)) * 16)); }
            asm volatile("s_waitcnt lgkmcnt(0)" ::: "memory"); __builtin_amdgcn_wave_barrier();
        }
    }
}
__device__ __forceinline__ void phase_gla_b(const Args& a, int tid, int gw, int NG) {
    const bf16* kvt = (const bf16*)a.out; const float* decay = (const float*)(a.ws + WS_DECAY); bf16* sint = (bf16*)(a.ws + WS_SINT);
    for (size_t qi = (size_t)gw * NTHR + tid; qi < (size_t)2 * 32768; qi += (size_t)NG * NTHR) {
        const size_t idx = qi * 4; const int bh = (int)(idx >> 15), e = (int)(idx & 32767);
        float s0 = 0.f, s1 = 0.f, s2 = 0.f, s3 = 0.f;
#pragma unroll 8
        for (int n = 0; n < 64; ++n) { const size_t unit = (size_t)bh * 64 + n;
            v2u o; o.x = pk2(s0, s1); o.y = pk2(s2, s3); *(v2u*)(sint + unit * 32768 + e) = o;
            const f32x4 d = *(const f32x4*)(decay + unit * 128 + (e & 127)); const v2u kw = *(const v2u*)(kvt + unit * 32768 + e);
            s0 = d[0] * s0 + bflo(kw.x); s1 = d[1] * s1 + bfhi(kw.x); s2 = d[2] * s2 + bflo(kw.y); s3 = d[3] * s3 + bfhi(kw.y); }
    }
}
__device__ __forceinline__ void phase_gla_b2(const Args& a, int tid, int gw, int NG) {
    typedef float f32x2v __attribute__((ext_vector_type(2)));
    const bf16* kvt = (const bf16*)a.out; const float* decay = (const float*)(a.ws + WS_DECAY); bf16* sint = (bf16*)(a.ws + WS_SINT);
    for (size_t pi = (size_t)gw * NTHR + tid; pi < (size_t)4 * 32768; pi += (size_t)NG * NTHR) {
        const size_t idx = pi * 2; const int bh = (int)(idx >> 15), e = (int)(idx & 32767);
        float s0 = 0.f, s1 = 0.f;
#pragma unroll 8
        for (int n = 0; n < 64; ++n) { const size_t unit = (size_t)bh * 64 + n;
            *(unsigned*)(sint + unit * 32768 + e) = pk2(s0, s1);
            const f32x2v d = *(const f32x2v*)(decay + unit * 128 + (e & 127)); const unsigned kw = __builtin_nontemporal_load((const unsigned*)(kvt + unit * 32768 + e));
            s0 = d.x * s0 + bflo(kw); s1 = d.y * s1 + bfhi(kw); }
    }
}
__device__ __forceinline__ void gla_pass_c(const Args& a, LAS unsigned char* lds, int unit, int tid) {
    const bf16* P = (const bf16*)(a.ws + WS_P); const bf16* qtg = (const bf16*)(a.ws + WS_QT); const unsigned* oin = (const unsigned*)(a.ws + WS_OINTRA); const bf16* sint = (const bf16*)(a.ws + WS_SINT); bf16* mix = (bf16*)(a.ws + WS_MIX);
    const int bh = unit >> 6, n = unit & 63, b = bh >> 2, h = bh & 3; const size_t R0 = (size_t)b * SEQ + 64 * n;
    const int lane = tid & 63, w = __builtin_amdgcn_readfirstlane(tid >> 6), r = lane & 31, hl = lane >> 5;
    LAS float* RED = (LAS float*)lds; LAS float* RSTD = RED + 1024;
    g_f32x16 acc[2];
#pragma unroll
    for (int bi = 0; bi < 2; ++bi) { const v4u* op = (const v4u*)(oin + ((size_t)((unit * 8 + w) * 2 + bi) * 64 + lane) * 8); const v4u o0 = op[0], o1 = op[1];
#pragma unroll
        for (int e = 0; e < 4; ++e) { acc[bi][2 * e] = bflo(o0[e]); acc[bi][2 * e + 1] = bfhi(o0[e]); acc[bi][8 + 2 * e] = bflo(o1[e]); acc[bi][8 + 2 * e + 1] = bfhi(o1[e]); } }
    v4u gpre[4]; f32x4 hgv[4];
#pragma unroll
    for (int i = 0; i < 4; ++i) { const int p = tid + 512 * i; gpre[i] = *(const v4u*)(P + (R0 + (p >> 5)) * NP + C_GG + 256 * h + (p & 31) * 8); }
#pragma unroll
    for (int g4 = 0; g4 < 4; ++g4) hgv[g4] = *(const f32x4*)(a.head_g + 256 * h + 32 * w + 8 * g4 + 4 * hl);
#pragma unroll
    for (int ks = 0; ks < 8; ++ks) { const g_bf16x8 sf = *(const g_bf16x8*)(sint + ((size_t)unit * 256 + 32 * w + r) * 128 + 16 * ks + 8 * hl);
#pragma unroll
        for (int bi = 0; bi < 2; ++bi) { const g_bf16x8 qf = *(const g_bf16x8*)(qtg + (R0 + 32 * bi + r) * 512 + 128 * h + 16 * ks + 8 * hl); acc[bi] = __builtin_amdgcn_mfma_f32_32x32x16_bf16(sf, qf, acc[bi], 0, 0, 0); } }
    __syncthreads();
#pragma unroll
    for (int bi = 0; bi < 2; ++bi) { float s = 0.f;
#pragma unroll
        for (int reg = 0; reg < 16; ++reg) s += acc[bi][reg] * acc[bi][reg];
        RED[(w * 2 + hl) * 64 + 32 * bi + r] = s; }
    __syncthreads();
    if (tid < 64) { float t = 0.f;
#pragma unroll
        for (int q = 0; q < 16; ++q) t += RED[q * 64 + tid];
        RSTD[tid] = rsqrtf(t * (1.0f / 256.0f) + EPS); }
    __syncthreads();
    LAS bf16* T = (LAS bf16*)(lds + 8192);
#pragma unroll
    for (int bi = 0; bi < 2; ++bi) { const int tok = 32 * bi + r; const float rs = RSTD[tok];
#pragma unroll
        for (int g4 = 0; g4 < 4; ++g4) { const int dv0 = 32 * w + 8 * g4 + 4 * hl; const f32x4 hg = hgv[g4];
            v2u o; o.x = pk2(acc[bi][4 * g4] * rs * hg[0], acc[bi][4 * g4 + 1] * rs * hg[1]); o.y = pk2(acc[bi][4 * g4 + 2] * rs * hg[2], acc[bi][4 * g4 + 3] * rs * hg[3]);
            *(LAS v2u*)(T + tok * 264 + dv0) = o; } }
    __syncthreads();
#pragma unroll
    for (int i = 0; i < 4; ++i) { const int p = tid + 512 * i, tok = p >> 5, c8 = (p & 31) * 8; const v4u ov = *(const LAS v4u*)(T + tok * 264 + c8); const v4u gv = gpre[i]; v4u o;
#pragma unroll
        for (int e = 0; e < 4; ++e) o[e] = pk2(bflo(ov[e]) * silu_f(bflo(gv[e])), bfhi(ov[e]) * silu_f(bfhi(gv[e])));
        *(v4u*)(mix + (R0 + tok) * DM + 256 * h + c8) = o; }
}
__device__ __forceinline__ void phase_gla_c(const Args& a, LAS unsigned char* lds, int tid, int G) {
    for (int unit = blockIdx.x; unit < 512; unit += G) gla_pass_c(a, lds, unit, tid);
}
__device__ __forceinline__ void phase_final_norm(const Args& a, int tid, int G) {
    const int lane = tid & 63, wave = tid >> 6; const int gw = blockIdx.x * NWAVES + wave, NGW = G * NWAVES;
    const float* part2 = (const float*)(a.ws + WS_PART2);
    for (int m = gw; m < MROWS; m += NGW) {
        float s = (lane < 32) ? part2[(size_t)m * 32 + lane] : 0.f; s = wave_sum(s);
        const float r = rsqrtf(s * (1.0f / DM) + EPS);
        f32x4* xr = (f32x4*)(a.out + (size_t)m * DM) + lane; const f32x4* gr = (const f32x4*)a.final_g + lane;
#pragma unroll
        for (int j = 0; j < 8; ++j) { f32x4 v = xr[64 * j]; const f32x4 g = gr[64 * j]; v[0] *= r * g[0]; v[1] *= r * g[1]; v[2] *= r * g[2]; v[3] *= r * g[3]; xr[64 * j] = v; }
    }
}

constexpr int NPHASE = 11;
__global__ void __launch_bounds__(NTHR, 2) trunk_fwd(Args a) {
    extern __shared__ __attribute__((aligned(16))) unsigned char lds_raw[];
    LAS unsigned char* lds = (LAS unsigned char*)lds_raw;
    cg::grid_group grid = cg::this_grid();
    const int tid = threadIdx.x, G = gridDim.x;
    const int lo = a.ph_lo, hi = a.ph_hi;
#define IN(k) (lo <= (k) && (k) < hi)
#define SEAM(k) do { if (IN(k) && IN((k) + 1)) { if (hi > 1000) grid.sync();   xcd_barrier(bar); } } while (0)
    unsigned char* ws = a.ws;
    volatile LAS unsigned* bst = (volatile LAS unsigned*)(lds + LDS_BYTES - 16);
    if (tid < 4) bst[tid] = 0u;
    __syncthreads();
    XcdBarrier bar; bar.bar = (unsigned*)(ws + WS_BAR); bar.x = 0; bar.st = bst;
    if (hi - lo > 1) bar = xcd_barrier_post((unsigned*)(ws + WS_BAR), bst);
    if (IN(0)) { phase_prologue(a, lds, tid, G); } SEAM(0);
    if (IN(1)) {
        pg8::Gemm g{(const pg8::bf16_t*)(ws + WS_XB), (const pg8::bf16_t*)(ws + WS_WIN), MROWS, NP, DM}; pg8::StaticOrder S; S.init(MROWS, NP, G, (int)blockIdx.x);
        pg8::EpiScaleBf16 E{(pg8::bf16_t*)(ws + WS_P), NP, (const float*)(ws + WS_RSTD0), nullptr, C_SMALL / 256, (float*)(ws + WS_SMALL), (float*)(ws + WS_BAR + 20480), C_FQ / 256};
        pg8::gemm_phase<pg8::EpiScaleBf16, pg8::StaticOrder, true, true>(lds, g, S, E);
        { const int nwg = (MROWS / 256) * (NP / 256), rem = nwg % G, first = rem, nidle = G - first;
          if ((int)blockIdx.x >= first) { __syncthreads(); prologue_late(a, lds, tid, (int)blockIdx.x - first, nidle); } }
    } SEAM(1);
    if (IN(3)) { phase_m1(a, lds, tid, G); } SEAM(3);
    if (IN(4)) { phase_m2(a, lds_raw, tid, G); } SEAM(4);
    if (IN(5)) { phase_gla_c(a, lds, tid, G); } SEAM(5);
    if (IN(6)) {
        pg8::Gemm g{(const pg8::bf16_t*)(ws + WS_MIX), (const pg8::bf16_t*)(ws + WS_WOUT), MROWS, DM, DM}; pg8::StaticOrder S; S.init(MROWS, DM, G, (int)blockIdx.x);
        pg8::EpiResid E{a.x, nullptr, (pg8::bf16_t*)(ws + WS_X1), (float*)(ws + WS_PART1), DM};
        pg8::gemm_phase<pg8::EpiResid, pg8::StaticOrder, true, true>(lds, g, S, E);
    } SEAM(6);
    if (IN(7)) {
        pg8::Gemm g{(const pg8::bf16_t*)(ws + WS_X1), (const pg8::bf16_t*)(ws + WS_WCIN), MROWS, 4096, DM}; pg8::StaticOrder S; S.init(MROWS, 4096, G, (int)blockIdx.x);
        pg8::EpiScaleBf16 E{(pg8::bf16_t*)(ws + WS_UG), 4096, nullptr, (const float*)(ws + WS_PART1), -1, nullptr, nullptr, 0};
        pg8::gemm_phase<pg8::EpiScaleBf16, pg8::StaticOrder, true, true>(lds, g, S, E);
    } SEAM(7);
    if (IN(8)) { phase_s5(a, lds, tid); } SEAM(8);
    if (IN(9)) {
        pg8::Gemm g{(const pg8::bf16_t*)(ws + WS_ZB), (const pg8::bf16_t*)(ws + WS_WGLU), MROWS, DM, DM}; pg8::StaticOrder S; S.init(MROWS, DM, G, (int)blockIdx.x);
        pg8::EpiGlu E{(const pg8::bf16_t*)(ws + WS_ZB), (const pg8::bf16_t*)(ws + WS_UG), a.glu_b, (pg8::bf16_t*)(ws + WS_TB)};
        pg8::gemm_phase<pg8::EpiGlu, pg8::StaticOrder, true, true>(lds, g, S, E);
    } SEAM(9);
    if (IN(10)) {
        pg8::Gemm g{(const pg8::bf16_t*)(ws + WS_TB), (const pg8::bf16_t*)(ws + WS_WCOUT), MROWS, DM, DM}; pg8::StaticOrder S; S.init(MROWS, DM, G, (int)blockIdx.x);
        pg8::EpiFinalNorm E{(const pg8::bf16_t*)(ws + WS_X1), a.out, (float*)(ws + WS_PART2), (unsigned*)(ws + WS_BAR + 16384), a.final_g, DM};
        pg8::gemm_phase<pg8::EpiFinalNorm, pg8::StaticOrder, false, true>(lds, g, S, E);
    }
#undef IN
#undef SEAM
}

#ifndef MK_ONE_LAUNCH
#define MK_ONE_LAUNCH 1
#endif
extern "C" void kernel_launch(void* const* d_in, const int* in_sizes, int n_in, void* d_out, int out_size, void* d_ws, size_t ws_size, hipStream_t stream) {
    static int grid = 0;
    if (grid == 0) {
        int dev = 0, cus = 0, per_cu = 0;
        if (hipGetDevice(&dev) != hipSuccess || hipDeviceGetAttribute(&cus, hipDeviceAttributeMultiprocessorCount, dev) != hipSuccess) { fprintf(stderr, "kernel_launch: device query failed\n"); grid = -1; return; }
        if (hipFuncSetAttribute((const void*)trunk_fwd, hipFuncAttributeMaxDynamicSharedMemorySize, LDS_BYTES) != hipSuccess) { fprintf(stderr, "kernel_launch: hipFuncSetAttribute failed\n"); grid = -1; return; }
        if (hipOccupancyMaxActiveBlocksPerMultiprocessor(&per_cu, (const void*)trunk_fwd, NTHR, LDS_BYTES) != hipSuccess || per_cu < 1) { fprintf(stderr, "kernel_launch: occupancy query says %d\n", per_cu); per_cu = 1; }
        (void)hipGetLastError();
        grid = cus;
        if (ws_size < 256 * MiB) { fprintf(stderr, "kernel_launch: workspace too small (%zu)\n", ws_size); grid = -1; return; }
    }
    if (grid < 0) return;
    if (hipMemsetAsync((char*)d_ws + WS_BAR, 0, 24576, stream) != hipSuccess) { fprintf(stderr, "kernel_launch: memset of barrier words failed\n"); return; }
    Args a{};
    const float** ap = (const float**)&a;
    for (int i = 0; i < 22; ++i) ap[i] = (const float*)d_in[i];
    a.out = (float*)d_out; a.ws = (unsigned char*)d_ws;
#if MK_ONE_LAUNCH
    a.ph_lo = 0; a.ph_hi = NPHASE;
    void* args[] = {&a};
    hipError_t e = hipLaunchCooperativeKernel((const void*)trunk_fwd, dim3(grid), dim3(NTHR), args, LDS_BYTES, stream);
    if (e != hipSuccess) fprintf(stderr, "cooperative launch failed: %s (grid %d)\n", hipGetErrorString(e), grid);
#else
    for (int p = 0; p < NPHASE; ++p) { a.ph_lo = p; a.ph_hi = p + 1; hipLaunchKernelGGL(trunk_fwd, dim3(grid), dim3(NTHR), LDS_BYTES, stream, a); }
#endif
}
```
